# Optimizing an MI355X kernel written in HIP

```python
import jax, jax.numpy as jnp
from jax import lax
import numpy as np

D_MODEL = 1024
BATCH = 8
SEQ = 2048
DEPTH = 1

D_MIX = D_MODEL
D_MLSTM = D_MIX // 2
D_ATTN = D_MIX - D_MLSTM
D_IN_PROJ = 2 * D_MLSTM + 3 * D_ATTN
MLSTM_HEADS = 4
MLSTM_HEAD_DIM = D_MLSTM // MLSTM_HEADS
MLSTM_QKV_BLOCK = 4
MLSTM_CONV = 5
MLSTM_CHUNK = 64
ATTN_HEADS = 8
ATTN_HEAD_DIM = D_ATTN // ATTN_HEADS
ROPE_DIM = ATTN_HEAD_DIM // 4
ROPE_THETA = 500000.0
DILATED_PATTERNS = ((128, 1), (512, 4), (2048, 16))
BAND_BLOCK = 64
N_EXPERTS = 16
EC_CAPACITY = 2
D_EXPERT = 2816
NORM_EPS = 1e-6
NEG_INF = -1e30

kernel_name = "hybrid_mlstm_dilated_attn_ec_moe"


def rms_norm(x, g):
    xf = x.astype(jnp.float32)
    y = xf * lax.rsqrt(jnp.mean(xf * xf, axis=-1, keepdims=True) + NORM_EPS)
    return (y * g.astype(jnp.float32)).astype(x.dtype)


def rope_partial(t, positions):
    half = ROPE_DIM // 2
    inv_freq = ROPE_THETA ** (-2.0 * jnp.arange(half, dtype=jnp.float32) / ROPE_DIM)
    ang = positions.astype(jnp.float32)[:, None] * inv_freq[None, :]
    cos, sin = jnp.cos(ang), jnp.sin(ang)
    t1, t2 = t[..., :half], t[..., half:ROPE_DIM]
    return jnp.concatenate([t1 * cos - t2 * sin, t2 * cos + t1 * sin, t[..., ROPE_DIM:]], axis=-1)


def mlstm_chunkwise(q, k, v, i_pre, f_pre):
    B, H, S, DH = q.shape
    L = MLSTM_CHUNK
    NC = S // L
    qc = q.reshape(B, H, NC, L, DH)
    kc = k.reshape(B, H, NC, L, DH)
    vc = v.reshape(B, H, NC, L, DH)
    ig = i_pre.reshape(B, H, NC, L)
    b = jnp.cumsum(jax.nn.log_sigmoid(f_pre).reshape(B, H, NC, L), axis=-1)
    g = b[..., -1]
    a = g[..., None] - b + ig

    def step(carry, inp):
        C, n, m = carry
        k_c, v_c, a_c, g_c = inp
        m_new = jnp.maximum(g_c + m, a_c.max(-1))
        decay = jnp.exp(g_c + m - m_new)
        w = jnp.exp(a_c - m_new[..., None])
        C_new = decay[..., None, None] * C + jnp.einsum('bhs,bhsd,bhse->bhde', w, v_c, k_c)
        n_new = decay[..., None] * n + jnp.einsum('bhs,bhse->bhe', w, k_c)
        return (C_new, n_new, m_new), (C, n, m)

    init = (jnp.zeros((B, H, DH, DH), jnp.float32), jnp.zeros((B, H, DH), jnp.float32),
            jnp.zeros((B, H), jnp.float32))
    xs = (jnp.moveaxis(kc, 2, 0), jnp.moveaxis(vc, 2, 0), jnp.moveaxis(a, 2, 0), jnp.moveaxis(g, 2, 0))
    _, (C_prev, n_prev, m_prev) = lax.scan(step, init, xs)
    C_prev = jnp.moveaxis(C_prev, 0, 2)
    n_prev = jnp.moveaxis(n_prev, 0, 2)
    m_prev = jnp.moveaxis(m_prev, 0, 2)

    lower = jnp.tril(jnp.ones((L, L), dtype=bool))
    log_D = jnp.where(lower, b[..., :, None] - b[..., None, :] + ig[..., None, :], NEG_INF)
    inter_log = b + m_prev[..., None]
    m_t = jnp.maximum(inter_log, log_D.max(-1))
    W = jnp.exp(log_D - m_t[..., None]) * jnp.einsum('bhctd,bhcsd->bhcts', qc, kc)
    inter_scale = jnp.exp(inter_log - m_t)
    num = (jnp.einsum('bhcts,bhcsd->bhctd', W, vc)
           + inter_scale[..., None] * jnp.einsum('bhcde,bhcte->bhctd', C_prev, qc))
    den = W.sum(-1) + inter_scale * jnp.einsum('bhcte,bhce->bhct', qc, n_prev)
    h = num / jnp.maximum(jnp.abs(den), jnp.exp(-m_t))[..., None]
    return h.reshape(B, H, S, DH)


def mlstm_mixer(x_m, z, conv_w, conv_b, wq, wk, wv, w_if_f, b_if_f, w_if_b, b_if_b, norm_g, skip):
    B, S, _ = x_m.shape
    H, DH = MLSTM_HEADS, MLSTM_HEAD_DIM
    xf = x_m.astype(jnp.float32)
    x_c = lax.conv_general_dilated(
        xf, conv_w.astype(jnp.float32)[:, None, :], window_strides=(1,),
        padding=[(MLSTM_CONV // 2, MLSTM_CONV // 2)], dimension_numbers=('NWC', 'WIO', 'NWC'),
        feature_group_count=D_MLSTM) + conv_b.astype(jnp.float32)
    x_c = jax.nn.silu(x_c)

    def blockdiag(t, w):
        tb = t.reshape(B, S, D_MLSTM // MLSTM_QKV_BLOCK, MLSTM_QKV_BLOCK)
        return jnp.einsum('bsgi,gio->bsgo', tb, w.astype(jnp.float32)).reshape(B, S, D_MLSTM)

    q = blockdiag(x_c, wq)
    k = blockdiag(x_c, wk) * (MLSTM_HEAD_DIM ** -0.5)
    v = blockdiag(xf, wv)
    qkv = jnp.concatenate([q, k, v], axis=-1)

    def heads(t):
        return t.reshape(B, S, H, DH).transpose(0, 2, 1, 3)

    qh, kh, vh = heads(q), heads(k), heads(v)

    def run(w_if, b_if, flip):
        gates = qkv @ w_if.astype(jnp.float32) + b_if.astype(jnp.float32)
        args = (qh, kh, vh, gates[..., :H].transpose(0, 2, 1), gates[..., H:].transpose(0, 2, 1))
        if flip:
            args = tuple(jnp.flip(t, axis=2) for t in args)
        h = mlstm_chunkwise(*args)
        return jnp.flip(h, axis=2) if flip else h

    h = run(w_if_f, b_if_f, False) + run(w_if_b, b_if_b, True)
    h = rms_norm(h.transpose(0, 2, 1, 3), norm_g.reshape(H, DH)).reshape(B, S, D_MLSTM)
    return (h + skip.astype(jnp.float32) * x_c) * jax.nn.silu(z.astype(jnp.float32))


def banded_window_stats(q, k, v, half):
    lead = q.shape[:-2]
    L, D = q.shape[-2], q.shape[-1]
    blk = BAND_BLOCK
    nb = -(-L // blk)
    pad = nb * blk - L
    padw = [(0, 0)] * len(lead)
    qb = jnp.pad(q, padw + [(0, pad), (0, 0)]).reshape(*lead, nb, blk, D)

    def windows(t):
        tp = jnp.pad(t, padw + [(blk, blk + pad), (0, 0)]).reshape(*lead, nb + 2, blk, D)
        return jnp.concatenate([tp[..., :-2, :, :], tp[..., 1:-1, :, :], tp[..., 2:, :, :]], axis=-2)

    kw, vw = windows(k), windows(v)
    qpos = jnp.arange(nb)[:, None] * blk + jnp.arange(blk)[None, :]
    kpos = jnp.arange(nb)[:, None] * blk - blk + jnp.arange(3 * blk)[None, :]
    mask = ((jnp.abs(qpos[:, :, None] - kpos[:, None, :]) <= half)
            & (kpos[:, None, :] >= 0) & (kpos[:, None, :] < L))
    scores = jnp.where(mask, jnp.einsum('...nqd,...nkd->...nqk', qb, kw), NEG_INF)
    m = scores.max(-1)
    p = jnp.exp(scores - m[..., None])
    s = p.sum(-1)
    num = jnp.einsum('...nqk,...nkd->...nqd', p, vw)
    return (m.reshape(*lead, nb * blk)[..., :L], s.reshape(*lead, nb * blk)[..., :L],
            num.reshape(*lead, nb * blk, D)[..., :L, :])


def dilated_branch(q, k, v, dil, half):
    B, H, S, D = q.shape

    def to_res(t):
        return t.reshape(B, H, S // dil, dil, D).swapaxes(2, 3)

    m, s, num = banded_window_stats(to_res(q), to_res(k), to_res(v), half)
    return (m.swapaxes(2, 3).reshape(B, H, S), s.swapaxes(2, 3).reshape(B, H, S),
            num.swapaxes(2, 3).reshape(B, H, S, D))


def dilated_attention_mixer(qa, ka, va):
    B, S, _ = qa.shape

    def heads(t):
        return t.astype(jnp.float32).reshape(B, S, ATTN_HEADS, ATTN_HEAD_DIM).transpose(0, 2, 1, 3)

    pos = jnp.arange(S)
    q = rope_partial(heads(qa), pos) * (ATTN_HEAD_DIM ** -0.5)
    k = rope_partial(heads(ka), pos)
    v = heads(va)
    stats = [dilated_branch(q, k, v, dil, win // (2 * dil)) for win, dil in DILATED_PATTERNS]
    m_all = jnp.stack([st[0] for st in stats])
    w = jnp.exp(m_all - m_all.max(0))
    den = jnp.sum(w * jnp.stack([st[1] for st in stats]), axis=0)
    num = jnp.sum(w[..., None] * jnp.stack([st[2] for st in stats]), axis=0)
    out = num / den[..., None]
    return out.transpose(0, 2, 1, 3).reshape(B, S, D_ATTN)


def expert_choice_ffn(h, w_router, w1, w3, w2):
    B, S, D = h.shape
    cap = EC_CAPACITY * S // N_EXPERTS
    logits = jnp.einsum('bsd,de->bse', h.astype(jnp.float32), w_router.astype(jnp.float32))
    aff = jax.nn.softmax(logits, axis=-1)
    gate, idx = lax.top_k(aff.transpose(0, 2, 1), cap)
    xs = jax.vmap(lambda hb, ib: hb[ib])(h, idx)
    up = jnp.einsum('becd,edf->becf', xs, w1)
    gt = jnp.einsum('becd,edf->becf', xs, w3)
    y = jnp.einsum('becf,efd->becd', jax.nn.silu(up) * gt, w2) * gate[..., None].astype(h.dtype)
    return jax.vmap(lambda yb, ib: jax.ops.segment_sum(
        yb.reshape(-1, D), ib.reshape(-1), num_segments=S))(y, idx)


def setup_inputs(seed: int = 0) -> dict:
    key = jax.random.key(seed)
    ks = jax.random.split(key, 24)

    def nrm(k, shape, scale):
        return jax.random.normal(k, shape, jnp.float32) * scale

    H = MLSTM_HEADS
    nblk = D_MLSTM // MLSTM_QKV_BLOCK
    f_bias = jnp.linspace(3.0, 6.0, H, dtype=jnp.float32)[None, :]
    return {
        "x": nrm(ks[0], (BATCH, SEQ, D_MODEL), 1.0),
        "norm1_g": 1.0 + nrm(ks[1], (DEPTH, D_MODEL), 0.02),
        "w_in": nrm(ks[2], (DEPTH, D_MODEL, D_IN_PROJ), D_MODEL ** -0.5),
        "conv_w": nrm(ks[3], (DEPTH, MLSTM_CONV, D_MLSTM), MLSTM_CONV ** -0.5),
        "conv_b": nrm(ks[4], (DEPTH, D_MLSTM), 0.01),
        "wq_m": nrm(ks[5], (DEPTH, nblk, MLSTM_QKV_BLOCK, MLSTM_QKV_BLOCK), MLSTM_QKV_BLOCK ** -0.5),
        "wk_m": nrm(ks[6], (DEPTH, nblk, MLSTM_QKV_BLOCK, MLSTM_QKV_BLOCK), MLSTM_QKV_BLOCK ** -0.5),
        "wv_m": nrm(ks[7], (DEPTH, nblk, MLSTM_QKV_BLOCK, MLSTM_QKV_BLOCK), MLSTM_QKV_BLOCK ** -0.5),
        "w_if_fwd": nrm(ks[8], (DEPTH, 3 * D_MLSTM, 2 * H), (3 * D_MLSTM) ** -0.5),
        "b_if_fwd": jnp.concatenate([nrm(ks[9], (DEPTH, H), 0.1),
                                     f_bias + nrm(ks[10], (DEPTH, H), 0.1)], axis=-1),
        "w_if_bwd": nrm(ks[11], (DEPTH, 3 * D_MLSTM, 2 * H), (3 * D_MLSTM) ** -0.5),
        "b_if_bwd": jnp.concatenate([nrm(ks[12], (DEPTH, H), 0.1),
                                     f_bias + nrm(ks[13], (DEPTH, H), 0.1)], axis=-1),
        "mlstm_norm_g": 1.0 + nrm(ks[14], (DEPTH, D_MLSTM), 0.02),
        "mlstm_skip": 1.0 + nrm(ks[15], (DEPTH, D_MLSTM), 0.02),
        "attn_norm_g": 1.0 + nrm(ks[16], (DEPTH, D_ATTN), 0.02),
        "w_out": nrm(ks[17], (DEPTH, D_MIX, D_MODEL), D_MIX ** -0.5),
        "norm2_g": 1.0 + nrm(ks[18], (DEPTH, D_MODEL), 0.02),
        "w_router": nrm(ks[19], (DEPTH, D_MODEL, N_EXPERTS), D_MODEL ** -0.5),
        "w1": nrm(ks[20], (DEPTH, N_EXPERTS, D_MODEL, D_EXPERT), D_MODEL ** -0.5),
        "w3": nrm(ks[21], (DEPTH, N_EXPERTS, D_MODEL, D_EXPERT), D_MODEL ** -0.5),
        "w2": nrm(ks[22], (DEPTH, N_EXPERTS, D_EXPERT, D_MODEL), D_EXPERT ** -0.5),
        "norm_f_g": 1.0 + nrm(ks[23], (D_MODEL,), 0.02),
    }


def reference(x, norm1_g, w_in, conv_w, conv_b, wq_m, wk_m, wv_m, w_if_fwd, b_if_fwd,
              w_if_bwd, b_if_bwd, mlstm_norm_g, mlstm_skip, attn_norm_g, w_out, norm2_g,
              w_router, w1, w3, w2, norm_f_g):
    splits = [D_MLSTM, 2 * D_MLSTM, 2 * D_MLSTM + D_ATTN, 2 * D_MLSTM + 2 * D_ATTN]
    for l in range(DEPTH):
        h = rms_norm(x, norm1_g[l])
        proj = h @ w_in[l]
        x_m, z, qa, ka, va = jnp.split(proj, splits, axis=-1)
        y_m = mlstm_mixer(x_m, z, conv_w[l], conv_b[l], wq_m[l], wk_m[l], wv_m[l],
                          w_if_fwd[l], b_if_fwd[l], w_if_bwd[l], b_if_bwd[l],
                          mlstm_norm_g[l], mlstm_skip[l])
        y_a = rms_norm(dilated_attention_mixer(qa, ka, va), attn_norm_g[l])
        mixed = jnp.concatenate([y_m, y_a], axis=-1).astype(x.dtype)
        x = x + mixed @ w_out[l]
        h = rms_norm(x, norm2_g[l])
        x = x + expert_choice_ffn(h, w_router[l], w1[l], w3[l], w2[l])
    return rms_norm(x, norm_f_g)
```

```cpp
#include <hip/hip_runtime.h>
#include <cstdio>
#include <cstdint>
#include <cmath>

constexpr int NB = 8, SEQ = 2048, DMODEL = 1024, NT = NB * SEQ;
constexpr int DML = 512, DAT = 512, DPROJ = 2560;
constexpr int MH = 4, MDH = 128, AH = 8, ADH = 64;
constexpr int NE = 16, CAP = 256, DEXP = 2816;
constexpr float EPS = 1e-6f;

__device__ __forceinline__ float wave_sum(float v) {
#pragma unroll
    for (int o = 1; o < 64; o <<= 1) v += __shfl_xor(v, o);
    return v;
}
__device__ __forceinline__ float siluf(float x) { return x / (1.f + expf(-x)); }
__device__ __forceinline__ float logsigf(float x) { return fminf(x, 0.f) - log1pf(expf(-fabsf(x))); }

__global__ void __launch_bounds__(256) k_rmsnorm(const float* x, const float* __restrict__ g, float* out, int rows) {
    const int lane = threadIdx.x & 63, row = blockIdx.x * 4 + (threadIdx.x >> 6);
    if (row >= rows) return;
    const float4* xr = (const float4*)(x + (size_t)row * DMODEL);
    float4 v[4]; float s = 0.f;
#pragma unroll
    for (int j = 0; j < 4; ++j) { v[j] = xr[lane + 64 * j]; s += v[j].x * v[j].x + v[j].y * v[j].y + v[j].z * v[j].z + v[j].w * v[j].w; }
    s = wave_sum(s);
    const float r = rsqrtf(s * (1.f / DMODEL) + EPS);
    float4* o = (float4*)(out + (size_t)row * DMODEL);
    const float4* gg = (const float4*)g;
#pragma unroll
    for (int j = 0; j < 4; ++j) { float4 w = gg[lane + 64 * j]; float4 y; y.x = v[j].x * r * w.x; y.y = v[j].y * r * w.y; y.z = v[j].z * r * w.z; y.w = v[j].w * r * w.w; o[lane + 64 * j] = y; }
}

template <int MODE>
__global__ void __launch_bounds__(256) k_gemm(const float* __restrict__ A, int lda, const float* __restrict__ Bm, const float* __restrict__ B2, int ldb,
                                              float* __restrict__ C, int ldc, const float* __restrict__ R, int M, int N, int K,
                                              const int* __restrict__ rowidx, const float* __restrict__ rowgate,
                                              size_t strideA, size_t strideB, size_t strideC, int strideIdx) {
    __shared__ __attribute__((aligned(16))) float As[16][65];
    __shared__ __attribute__((aligned(16))) float Bs[16][64];
    __shared__ __attribute__((aligned(16))) float B2s[MODE == 2 ? 16 : 1][64];
    const int z = blockIdx.z;
    A += strideA * z; Bm += strideB * z; if (MODE == 2) B2 += strideB * z; C += strideC * z;
    if (rowidx) rowidx += (size_t)strideIdx * z;
    if (rowgate) rowgate += (size_t)strideIdx * z;
    const int tx = threadIdx.x & 15, ty = threadIdx.x >> 4;
    const int m0 = blockIdx.y * 64, n0 = blockIdx.x * 64;
    float acc[4][4] = {}, acc2[4][4] = {};
    const int ar = threadIdx.x >> 2, ak = (threadIdx.x & 3) * 4;
    size_t arow;
    if (MODE == 2) arow = (size_t)rowidx[m0 + ar]; else arow = (size_t)(m0 + ar);
    const float* ap = A + arow * lda + ak;
    const int bk = threadIdx.x >> 4, bn = (threadIdx.x & 15) * 4;
    for (int k0 = 0; k0 < K; k0 += 16) {
        const float4 av = *(const float4*)(ap + k0);
        As[ak + 0][ar] = av.x; As[ak + 1][ar] = av.y; As[ak + 2][ar] = av.z; As[ak + 3][ar] = av.w;
        *(float4*)&Bs[bk][bn] = *(const float4*)(Bm + (size_t)(k0 + bk) * ldb + n0 + bn);
        if (MODE == 2) *(float4*)&B2s[bk][bn] = *(const float4*)(B2 + (size_t)(k0 + bk) * ldb + n0 + bn);
        __syncthreads();
#pragma unroll
        for (int kk = 0; kk < 16; ++kk) {
            float a[4], b[4], b2[4];
#pragma unroll
            for (int i = 0; i < 4; ++i) a[i] = As[kk][ty * 4 + i];
#pragma unroll
            for (int j = 0; j < 4; ++j) { b[j] = Bs[kk][tx * 4 + j]; if (MODE == 2) b2[j] = B2s[kk][tx * 4 + j]; }
#pragma unroll
            for (int i = 0; i < 4; ++i)
#pragma unroll
                for (int j = 0; j < 4; ++j) { acc[i][j] += a[i] * b[j]; if (MODE == 2) acc2[i][j] += a[i] * b2[j]; }
        }
        __syncthreads();
    }
#pragma unroll
    for (int i = 0; i < 4; ++i) {
        const int r = m0 + ty * 4 + i;
#pragma unroll
        for (int j = 0; j < 4; ++j) {
            const int c = n0 + tx * 4 + j;
            if (MODE == 0) C[(size_t)r * ldc + c] = acc[i][j];
            else if (MODE == 1) C[(size_t)r * ldc + c] = R[(size_t)r * ldc + c] + acc[i][j];
            else if (MODE == 2) C[(size_t)r * ldc + c] = siluf(acc[i][j]) * acc2[i][j];
            else atomicAdd(&C[(size_t)rowidx[r] * ldc + c], rowgate[r] * acc[i][j]);
        }
    }
}

__global__ void __launch_bounds__(512) k_prep(const float* __restrict__ proj, const float* __restrict__ conv_w, const float* __restrict__ conv_b,
                                              const float* __restrict__ wq, const float* __restrict__ wk, const float* __restrict__ wv,
                                              const float* __restrict__ wif_f, const float* __restrict__ bif_f, const float* __restrict__ wif_b, const float* __restrict__ bif_b,
                                              float* __restrict__ xc, float* __restrict__ qm, float* __restrict__ km, float* __restrict__ vm,
                                              float* __restrict__ gI, float* __restrict__ gF,
                                              float* __restrict__ qr, float* __restrict__ kr, float* __restrict__ vr) {
    __shared__ float red[8][16];
    const int t = blockIdx.x, b = t / SEQ, s = t % SEQ, c = threadIdx.x, lane = c & 63, wid = c >> 6;
    const float* pr = proj + (size_t)t * DPROJ;
    float a = conv_b[c];
#pragma unroll
    for (int w = 0; w < 5; ++w) { const int ss = s + w - 2; if (ss >= 0 && ss < SEQ) a += conv_w[w * DML + c] * proj[(size_t)(b * SEQ + ss) * DPROJ + c]; }
    const float xcv = siluf(a);
    const float xmv = pr[c];
    const int g = c >> 2, o = c & 3;
    float q = 0.f, k = 0.f, v = 0.f;
#pragma unroll
    for (int i = 0; i < 4; ++i) {
        const float xci = __shfl(xcv, (lane & ~3) + i), xmi = __shfl(xmv, (lane & ~3) + i);
        q += xci * wq[g * 16 + i * 4 + o]; k += xci * wk[g * 16 + i * 4 + o]; v += xmi * wv[g * 16 + i * 4 + o];
    }
    k *= 0.08838834764831845f;
    xc[(size_t)t * DML + c] = xcv; qm[(size_t)t * DML + c] = q; km[(size_t)t * DML + c] = k; vm[(size_t)t * DML + c] = v;
    float p[16];
#pragma unroll
    for (int j = 0; j < 8; ++j) {
        p[j] = q * wif_f[(size_t)c * 8 + j] + k * wif_f[(size_t)(512 + c) * 8 + j] + v * wif_f[(size_t)(1024 + c) * 8 + j];
        p[8 + j] = q * wif_b[(size_t)c * 8 + j] + k * wif_b[(size_t)(512 + c) * 8 + j] + v * wif_b[(size_t)(1024 + c) * 8 + j];
    }
#pragma unroll
    for (int j = 0; j < 16; ++j) { const float r = wave_sum(p[j]); if (lane == 0) red[wid][j] = r; }
    __syncthreads();
    if (c < 16) {
        float r = 0.f;
        for (int w = 0; w < 8; ++w) r += red[w][c];
        const int dir = c >> 3, j = c & 7;
        r += (dir == 0 ? bif_f[j] : bif_b[j]);
        const int h = j & 3;
        const size_t off = ((size_t)(dir * NB + b) * MH + h) * SEQ + s;
        if (j < 4) gI[off] = r; else gF[off] = logsigf(r);
    }
    {
        const int hh = c >> 6, d = c & 63;
        const float qa = pr[1024 + c], ka = pr[1536 + c], va = pr[2048 + c];
        float qo = qa, ko = ka;
        if (d < 16) {
            const int i = d & 7;
            const float inv_freq = powf(500000.0f, -2.0f * (float)i / 16.0f);
            const float ang = (float)s * inv_freq;
            const float cs = cosf(ang), sn = sinf(ang);
            const float qp = pr[1024 + (c ^ 8)], kp = pr[1536 + (c ^ 8)];
            if (d < 8) { qo = qa * cs - qp * sn; ko = ka * cs - kp * sn; }
            else       { qo = qa * cs + qp * sn; ko = ka * cs + kp * sn; }
        }
        const size_t off = (((size_t)b * AH + hh) * SEQ + s) * ADH + d;
        qr[off] = qo * 0.125f; kr[off] = ko; vr[off] = va;
    }
}

constexpr int ML_LDS_FLOATS = 32 * 128 + 64 * 128 * 2 + 64 * 32 + 64 * 64 + 128 + 64 * 8;
__global__ void __launch_bounds__(256) k_mlstm(const float* __restrict__ qm, const float* __restrict__ km, const float* __restrict__ vm,
                                               const float* __restrict__ gI, const float* __restrict__ gF, float* __restrict__ hout  ) {
    extern __shared__ float sm[];
    float* Cs = sm;
    float* qs = Cs + 32 * 128;
    float* ks = qs + 64 * 128;
    float* vs = ks + 64 * 128;
    float* Ws = vs + 64 * 32;
    float* ns = Ws + 64 * 64;
    float* sc = ns + 128;
    float* s_ig = sc, *s_b = sc + 64, *s_a = sc + 128, *s_mt = sc + 192, *s_isc = sc + 256, *s_den = sc + 320, *s_w = sc + 384, *s_misc = sc + 448;
    const int tid = threadIdx.x;
    const int ds = blockIdx.x & 3, dir = (blockIdx.x >> 2) & 1, h = (blockIdx.x >> 3) & 3, b = blockIdx.x >> 5;
    const float* gi = gI + ((size_t)(dir * NB + b) * MH + h) * SEQ;
    const float* gf = gF + ((size_t)(dir * NB + b) * MH + h) * SEQ;
    for (int i = tid; i < 32 * 128; i += 256) Cs[i] = 0.f;
    if (tid < 128) ns[tid] = 0.f;
    float m_state = 0.f;
    __syncthreads();
    for (int cc = 0; cc < SEQ / 64; ++cc) {
        for (int i = tid; i < 64 * 128; i += 256) {
            const int t = i >> 7, e = i & 127, j = cc * 64 + t, pos = dir ? (SEQ - 1 - j) : j;
            const size_t off = (size_t)(b * SEQ + pos) * DML + h * MDH + e;
            qs[i] = qm[off]; ks[i] = km[off];
        }
        for (int i = tid; i < 64 * 32; i += 256) {
            const int t = i >> 5, d = i & 31, j = cc * 64 + t, pos = dir ? (SEQ - 1 - j) : j;
            vs[i] = vm[(size_t)(b * SEQ + pos) * DML + h * MDH + ds * 32 + d];
        }
        if (tid < 64) { const int j = cc * 64 + tid, pos = dir ? (SEQ - 1 - j) : j; s_ig[tid] = gi[pos]; s_b[tid] = gf[pos]; }
        __syncthreads();
        if (tid == 0) {
            float run = 0.f, pm = -INFINITY, amax = -INFINITY;
            for (int t = 0; t < 64; ++t) { run += s_b[t]; s_b[t] = run; }
            const float g = run;
            for (int t = 0; t < 64; ++t) {
                pm = fmaxf(pm, s_ig[t] - s_b[t]);
                const float mt = fmaxf(s_b[t] + m_state, s_b[t] + pm);
                s_mt[t] = mt; s_isc[t] = expf(s_b[t] + m_state - mt);
                const float a = g - s_b[t] + s_ig[t]; s_a[t] = a; amax = fmaxf(amax, a);
            }
            const float m_new = fmaxf(g + m_state, amax);
            s_misc[0] = m_new; s_misc[1] = expf(g + m_state - m_new);
            for (int t = 0; t < 64; ++t) s_w[t] = expf(s_a[t] - m_new);
        }
        __syncthreads();
        for (int i = tid; i < 64 * 64; i += 256) {
            const int t = i >> 6, s = i & 63;
            float w = 0.f;
            if (s <= t) {
                float dot = 0.f;
                for (int e = 0; e < 128; ++e) dot += qs[t * 128 + e] * ks[s * 128 + e];
                w = expf(s_b[t] - s_b[s] + s_ig[s] - s_mt[t]) * dot;
            }
            Ws[i] = w;
        }
        __syncthreads();
        if (tid < 64) {
            const int t = tid; float d = 0.f;
            for (int s = 0; s <= t; ++s) d += Ws[t * 64 + s];
            float qn = 0.f;
            for (int e = 0; e < 128; ++e) qn += qs[t * 128 + e] * ns[e];
            d += s_isc[t] * qn;
            s_den[t] = fmaxf(fabsf(d), expf(-s_mt[t]));
        }
        __syncthreads();
        for (int i = tid; i < 64 * 32; i += 256) {
            const int t = i >> 5, d = i & 31;
            float num = 0.f;
            for (int s = 0; s <= t; ++s) num += Ws[t * 64 + s] * vs[s * 32 + d];
            float cq = 0.f;
            for (int e = 0; e < 128; ++e) cq += Cs[d * 128 + e] * qs[t * 128 + e];
            num += s_isc[t] * cq;
            const int j = cc * 64 + t, pos = dir ? (SEQ - 1 - j) : j;
            hout[((size_t)dir * NT + (size_t)(b * SEQ + pos)) * DML + h * MDH + ds * 32 + d] = num / s_den[t];
        }
        __syncthreads();
        const float decay = s_misc[1];
        for (int i = tid; i < 32 * 128; i += 256) {
            const int d = i >> 7, e = i & 127;
            float acc = 0.f;
            for (int s = 0; s < 64; ++s) acc += s_w[s] * vs[s * 32 + d] * ks[s * 128 + e];
            Cs[i] = decay * Cs[i] + acc;
        }
        if (tid < 128) {
            float acc = 0.f;
            for (int s = 0; s < 64; ++s) acc += s_w[s] * ks[s * 128 + tid];
            ns[tid] = decay * ns[tid] + acc;
        }
        m_state = s_misc[0];
        __syncthreads();
    }
}

__global__ void __launch_bounds__(256) k_attn(const float* __restrict__ qr, const float* __restrict__ kr, const float* __restrict__ vr, float* __restrict__ ao  ) {
    const int bh = blockIdx.y, b = bh / AH, hh = bh % AH, pos = blockIdx.x * 256 + threadIdx.x;
    const float* kb = kr + (size_t)bh * SEQ * ADH; const float* vb = vr + (size_t)bh * SEQ * ADH;
    float q[64], acc[64];
    const float4* qp = (const float4*)(qr + ((size_t)bh * SEQ + pos) * ADH);
#pragma unroll
    for (int i = 0; i < 16; ++i) { const float4 t = qp[i]; q[4 * i] = t.x; q[4 * i + 1] = t.y; q[4 * i + 2] = t.z; q[4 * i + 3] = t.w; }
#pragma unroll
    for (int i = 0; i < 64; ++i) acc[i] = 0.f;
    float m = -INFINITY, l = 0.f;
    for (int br = 0; br < 3; ++br) {
        const int dil = br == 0 ? 1 : (br == 1 ? 4 : 16);
        for (int j = -64; j <= 64; ++j) {
            const int p = pos + dil * j;
            if (p < 0 || p >= SEQ) continue;
            const float4* kp = (const float4*)(kb + (size_t)p * ADH);
            float s = 0.f;
#pragma unroll
            for (int i = 0; i < 16; ++i) { const float4 t = kp[i]; s += q[4 * i] * t.x + q[4 * i + 1] * t.y + q[4 * i + 2] * t.z + q[4 * i + 3] * t.w; }
            const float mn = fmaxf(m, s), al = expf(m - mn), pe = expf(s - mn);
            l = l * al + pe; m = mn;
            const float4* vp = (const float4*)(vb + (size_t)p * ADH);
#pragma unroll
            for (int i = 0; i < 16; ++i) { const float4 t = vp[i]; acc[4 * i] = acc[4 * i] * al + pe * t.x; acc[4 * i + 1] = acc[4 * i + 1] * al + pe * t.y; acc[4 * i + 2] = acc[4 * i + 2] * al + pe * t.z; acc[4 * i + 3] = acc[4 * i + 3] * al + pe * t.w; }
        }
    }
    const float inv = 1.f / l;
    float4* op = (float4*)(ao + (size_t)(b * SEQ + pos) * DAT + hh * ADH);
#pragma unroll
    for (int i = 0; i < 16; ++i) { float4 t; t.x = acc[4 * i] * inv; t.y = acc[4 * i + 1] * inv; t.z = acc[4 * i + 2] * inv; t.w = acc[4 * i + 3] * inv; op[i] = t; }
}

__global__ void __launch_bounds__(512) k_mix(const float* __restrict__ hfb, const float* __restrict__ xc, const float* __restrict__ proj, const float* __restrict__ ao,
                                             const float* __restrict__ mnorm_g, const float* __restrict__ mskip, const float* __restrict__ anorm_g, float* __restrict__ mixed) {
    __shared__ float red[8];
    const int t = blockIdx.x, c = threadIdx.x, lane = c & 63, wid = c >> 6;
    const float hs = hfb[(size_t)t * DML + c] + hfb[((size_t)NT + t) * DML + c];
    float s = wave_sum(hs * hs);
    if (lane == 0) red[wid] = s;
    __syncthreads();
    const float hsum = red[wid & ~1] + red[wid | 1];
    const float hn = hs * rsqrtf(hsum * (1.f / MDH) + EPS) * mnorm_g[c];
    const float z = proj[(size_t)t * DPROJ + 512 + c];
    mixed[(size_t)t * DMODEL + c] = (hn + mskip[c] * xc[(size_t)t * DML + c]) * siluf(z);
    __syncthreads();
    const float a = ao[(size_t)t * DAT + c];
    s = wave_sum(a * a);
    if (lane == 0) red[wid] = s;
    __syncthreads();
    float tot = 0.f;
#pragma unroll
    for (int w = 0; w < 8; ++w) tot += red[w];
    mixed[(size_t)t * DMODEL + 512 + c] = a * rsqrtf(tot * (1.f / DAT) + EPS) * anorm_g[c];
}

__global__ void __launch_bounds__(256) k_router(const float* __restrict__ x2, const float* __restrict__ g2, const float* __restrict__ wr, float* __restrict__ h2, float* __restrict__ aff) {
    const int lane = threadIdx.x & 63, row = blockIdx.x * 4 + (threadIdx.x >> 6);
    const float4* xr = (const float4*)(x2 + (size_t)row * DMODEL);
    float4 v[4]; float s = 0.f;
#pragma unroll
    for (int j = 0; j < 4; ++j) { v[j] = xr[lane + 64 * j]; s += v[j].x * v[j].x + v[j].y * v[j].y + v[j].z * v[j].z + v[j].w * v[j].w; }
    s = wave_sum(s);
    const float r = rsqrtf(s * (1.f / DMODEL) + EPS);
    float lg[16];
#pragma unroll
    for (int e = 0; e < 16; ++e) lg[e] = 0.f;
    float4* o = (float4*)(h2 + (size_t)row * DMODEL);
#pragma unroll
    for (int j = 0; j < 4; ++j) {
        const float4 w = ((const float4*)g2)[lane + 64 * j];
        float4 y; y.x = v[j].x * r * w.x; y.y = v[j].y * r * w.y; y.z = v[j].z * r * w.z; y.w = v[j].w * r * w.w;
        o[lane + 64 * j] = y;
        const int k0 = (lane + 64 * j) * 4;
#pragma unroll
        for (int e = 0; e < 16; ++e) lg[e] += y.x * wr[(size_t)(k0 + 0) * NE + e] + y.y * wr[(size_t)(k0 + 1) * NE + e] + y.z * wr[(size_t)(k0 + 2) * NE + e] + y.w * wr[(size_t)(k0 + 3) * NE + e];
    }
    float mx = -INFINITY;
#pragma unroll
    for (int e = 0; e < 16; ++e) { lg[e] = wave_sum(lg[e]); mx = fmaxf(mx, lg[e]); }
    float den = 0.f;
#pragma unroll
    for (int e = 0; e < 16; ++e) { lg[e] = expf(lg[e] - mx); den += lg[e]; }
    if (lane < 16) {
        float val = 0.f;
#pragma unroll
        for (int e = 0; e < 16; ++e) if (lane == e) val = lg[e];
        aff[(size_t)row * NE + lane] = val / den;
    }
}

__global__ void __launch_bounds__(256) k_topk(const float* __restrict__ aff, int* __restrict__ sel_tok, float* __restrict__ sel_gate) {
    __shared__ float a[SEQ];
    const int be = blockIdx.x, b = be / NE, e = be % NE;
    for (int i = threadIdx.x; i < SEQ; i += 256) a[i] = aff[(size_t)(b * SEQ + i) * NE + e];
    __syncthreads();
    for (int i = threadIdx.x; i < SEQ; i += 256) {
        const float ai = a[i]; int rank = 0;
        for (int j = 0; j < SEQ; ++j) { const float aj = a[j]; rank += (aj > ai || (aj == ai && j < i)) ? 1 : 0; }
        if (rank < CAP) { sel_tok[(size_t)(e * NB + b) * CAP + rank] = b * SEQ + i; sel_gate[(size_t)(e * NB + b) * CAP + rank] = ai; }
    }
}


extern "C" void kernel_launch(void* const* d_in, const int* in_sizes, int n_in, void* d_out, int out_size, void* d_ws, size_t ws_size, hipStream_t stream) {
    const float* x = (const float*)d_in[0];
    const float* norm1_g = (const float*)d_in[1];
    const float* w_in = (const float*)d_in[2];
    const float* conv_w = (const float*)d_in[3];
    const float* conv_b = (const float*)d_in[4];
    const float* wq_m = (const float*)d_in[5];
    const float* wk_m = (const float*)d_in[6];
    const float* wv_m = (const float*)d_in[7];
    const float* w_if_f = (const float*)d_in[8];
    const float* b_if_f = (const float*)d_in[9];
    const float* w_if_b = (const float*)d_in[10];
    const float* b_if_b = (const float*)d_in[11];
    const float* mnorm_g = (const float*)d_in[12];
    const float* mskip = (const float*)d_in[13];
    const float* anorm_g = (const float*)d_in[14];
    const float* w_out = (const float*)d_in[15];
    const float* norm2_g = (const float*)d_in[16];
    const float* w_router = (const float*)d_in[17];
    const float* w1 = (const float*)d_in[18];
    const float* w3 = (const float*)d_in[19];
    const float* w2 = (const float*)d_in[20];
    const float* normf_g = (const float*)d_in[21];
    float* out = (float*)d_out;

    float* ws = (float*)d_ws;
    size_t off = 0;
    auto take = [&](size_t n) { float* p = ws + off; off += (n + 63) & ~(size_t)63; return p; };
    float* hn = take((size_t)NT * DMODEL);
    float* proj = take((size_t)NT * DPROJ);
    float* xc = take((size_t)NT * DML);
    float* qm = take((size_t)NT * DML);
    float* km = take((size_t)NT * DML);
    float* vm = take((size_t)NT * DML);
    float* gI = take((size_t)2 * NB * MH * SEQ);
    float* gF = take((size_t)2 * NB * MH * SEQ);
    float* qr = take((size_t)NT * DAT);
    float* kr = take((size_t)NT * DAT);
    float* vr = take((size_t)NT * DAT);
    float* hfb = take((size_t)2 * NT * DML);
    float* ao = take((size_t)NT * DAT);
    const size_t overlay_end = off;
    float* aff = take((size_t)NT * NE);
    int* sel_tok = (int*)take((size_t)NE * NB * CAP);
    float* sel_gate = take((size_t)NE * NB * CAP);
    float* Hbuf = proj;
    if ((size_t)(proj - ws) + (size_t)NE * NB * CAP * DEXP > overlay_end || off * 4 > ws_size) { fprintf(stderr, "workspace layout problem: need %zu have %zu\n", off * 4, ws_size); return; }
    float* mixed = hn;
    float* h2 = hn;

    k_rmsnorm<<<NT / 4, 256, 0, stream>>>(x, norm1_g, hn, NT);
    k_gemm<0><<<dim3(DPROJ / 64, NT / 64, 1), 256, 0, stream>>>(hn, DMODEL, w_in, nullptr, DPROJ, proj, DPROJ, nullptr, NT, DPROJ, DMODEL, nullptr, nullptr, 0, 0, 0, 0);
    k_prep<<<NT, 512, 0, stream>>>(proj, conv_w, conv_b, wq_m, wk_m, wv_m, w_if_f, b_if_f, w_if_b, b_if_b, xc, qm, km, vm, gI, gF, qr, kr, vr);
    static bool attr_set = false;
    if (!attr_set) { hipFuncSetAttribute((const void*)k_mlstm, hipFuncAttributeMaxDynamicSharedMemorySize, ML_LDS_FLOATS * 4); attr_set = true; }
    k_mlstm<<<NB * MH * 2 * 4, 256, ML_LDS_FLOATS * 4, stream>>>(qm, km, vm, gI, gF, hfb);
    k_attn<<<dim3(SEQ / 256, NB * AH), 256, 0, stream>>>(qr, kr, vr, ao);
    k_mix<<<NT, 512, 0, stream>>>(hfb, xc, proj, ao, mnorm_g, mskip, anorm_g, mixed);
    k_gemm<1><<<dim3(DMODEL / 64, NT / 64, 1), 256, 0, stream>>>(mixed, DMODEL, w_out, nullptr, DMODEL, out, DMODEL, x, NT, DMODEL, DMODEL, nullptr, nullptr, 0, 0, 0, 0);
    k_router<<<NT / 4, 256, 0, stream>>>(out, norm2_g, w_router, h2, aff);
    k_topk<<<NB * NE, 256, 0, stream>>>(aff, sel_tok, sel_gate);
    k_gemm<2><<<dim3(DEXP / 64, (NB * CAP) / 64, NE), 256, 0, stream>>>(h2, DMODEL, w1, w3, DEXP, Hbuf, DEXP, nullptr, NB * CAP, DEXP, DMODEL, sel_tok, nullptr,
                                                                        0, (size_t)DMODEL * DEXP, (size_t)NB * CAP * DEXP, NB * CAP);
    k_gemm<3><<<dim3(DMODEL / 64, (NB * CAP) / 64, NE), 256, 0, stream>>>(Hbuf, DEXP, w2, nullptr, DMODEL, out, DMODEL, nullptr, NB * CAP, DMODEL, DEXP, sel_tok, sel_gate,
                                                                         (size_t)NB * CAP * DEXP, (size_t)DEXP * DMODEL, 0, NB * CAP);
    k_rmsnorm<<<NT / 4, 256, 0, stream>>>(out, normf_g, out, NT);
}
```

```cpp
#include <hip/hip_runtime.h>
#include <cstdio>
#include <cstdint>
#include <cmath>

namespace pg8 {
#define PG8_LAS __attribute__((address_space(3)))
typedef unsigned short bf16_t;
typedef short bf16x8 __attribute__((ext_vector_type(8)));
typedef float f32x4 __attribute__((ext_vector_type(4)));
typedef float f32x2 __attribute__((ext_vector_type(2)));
typedef unsigned u32x4 __attribute__((ext_vector_type(4)));
constexpr int BM = 256, BK = 64, HALF = 128, HTB = HALF * BK * 2  , STAGE_BYTES = 8 * HTB, NXCD = 8, WGM = 8;

__host__ __device__ __forceinline__ int lds_byte(int r, int c) { const int st = (r >> 4) * 2 + (c >> 5), rr = r & 15, cc = c & 31, ob = rr * 64 + cc * 2; return st * 1024 + (ob ^ (((ob >> 9) & 1) << 5)); }
__host__ __device__ __forceinline__ void stage_rc(int b, int& R, int& C) { const int st = b / 1024, sb = b % 1024, swz = sb ^ (((sb >> 9) & 1) << 5); R = (st >> 1) * 16 + swz / 64; C = (st & 1) * 32 + (swz % 64) / 2; }
__host__ __device__ __forceinline__ int perm32(int rho) { const int n = rho >> 4, i = rho & 15; return 8 * (i >> 2) + 4 * n + (i & 3); }

typedef int v8i_t __attribute__((ext_vector_type(8)));
typedef int v4i_t __attribute__((ext_vector_type(4)));
__device__ __forceinline__ v8i_t cat32(bf16x8 a, bf16x8 b) { const v4i_t x = __builtin_bit_cast(v4i_t, a), y = __builtin_bit_cast(v4i_t, b); return (v8i_t){x[0], x[1], x[2], x[3], y[0], y[1], y[2], y[3]}; }
struct Unit { int pm, pn; };
struct Gemm { const bf16_t* A; const bf16_t* Bt; int M, N, K; const int* rowidx; int wscale; };

struct StaticOrder {
    int nM, nN, nwg, G, c;
    __host__ __device__ void init(int M, int N, int G_, int c_) { nM = M / BM; nN = N / BM; nwg = nM * nN; G = G_; c = c_; }
    __host__ __device__ bool next(int i, Unit& u) const {
        const long L = (long)i * G + c; if (L >= nwg) return false;
        int wgid = (int)L; { const int q = nwg / NXCD, r = nwg % NXCD, xcd = wgid % NXCD, off = wgid / NXCD; wgid = (xcd < r ? xcd * (q + 1) : r * (q + 1) + (xcd - r) * q) + off; }
        const int nig = WGM * nN, gid = wgid / nig, fm = gid * WGM, gsz = (nM - fm) < WGM ? (nM - fm) : WGM;
        u.pm = fm + ((wgid % nig) % gsz); u.pn = (wgid % nig) / gsz; return true;
    }
    __device__ __forceinline__ void a_ready(const Unit&) const {}
    __device__ __forceinline__ void done(const Unit&) const {}
};


__device__ __forceinline__ unsigned cvt_pk_bf16(float lo, float hi) { unsigned r; asm volatile("v_cvt_pk_bf16_f32 %0, %1, %2" : "=v"(r) : "v"(lo), "v"(hi)); return r; }
__device__ __forceinline__ float fast_silu(float x) { return x * __builtin_amdgcn_rcpf(1.0f + __builtin_amdgcn_exp2f(-1.4426950408889634f * x)); }

struct EpiStoreBf16 {
    static constexpr int NSTORE = 0; static constexpr bool PERM = true, AFTER_DRAIN = false;
    bf16_t* O; int ldc;
    __device__ __forceinline__ void operator()(const f32x4 (&acc)[2][2][4][2], const Unit& u, int wr, int wc, int fr, int fq) const {
        const int row0 = u.pm * BM + wr * 64 + fr, col0 = u.pn * BM + wc * 32 + 8 * fq;
#pragma unroll
        for (int ai = 0; ai < 2; ++ai)
#pragma unroll
            for (int m = 0; m < 4; ++m) { bf16_t* rowp = O + (size_t)(row0 + ai * HALF + m * 16) * ldc + col0;
#pragma unroll
                for (int bj = 0; bj < 2; ++bj) { const f32x4 v0 = acc[ai][bj][m][0], v1 = acc[ai][bj][m][1];
                    u32x4 w; w.x = cvt_pk_bf16(v0[0], v0[1]); w.y = cvt_pk_bf16(v0[2], v0[3]); w.z = cvt_pk_bf16(v1[0], v1[1]); w.w = cvt_pk_bf16(v1[2], v1[3]);
                    *(u32x4*)(rowp + bj * HALF) = w; } }
    }
};
struct EpiInProj {
    static constexpr int NSTORE = 0; static constexpr bool PERM = true, AFTER_DRAIN = false;
    bf16_t* O; int ldc; bf16_t* QKVo; size_t kind_stride; const float* rope;
    __device__ __forceinline__ void operator()(const f32x4 (&acc)[2][2][4][2], const Unit& u, int wr, int wc, int fr, int fq) const {
        const int row0 = u.pm * BM + wr * 64 + fr;
        if (u.pn < 4) {
            const int col0 = u.pn * BM + wc * 32 + 8 * fq;
#pragma unroll
            for (int ai = 0; ai < 2; ++ai)
#pragma unroll
                for (int m = 0; m < 4; ++m) { bf16_t* rowp = O + (size_t)(row0 + ai * HALF + m * 16) * ldc + col0;
#pragma unroll
                    for (int bj = 0; bj < 2; ++bj) { const f32x4 v0 = acc[ai][bj][m][0], v1 = acc[ai][bj][m][1];
                        u32x4 w; w.x = cvt_pk_bf16(v0[0], v0[1]); w.y = cvt_pk_bf16(v0[2], v0[3]); w.z = cvt_pk_bf16(v1[0], v1[1]); w.w = cvt_pk_bf16(v1[2], v1[3]);
                        *(u32x4*)(rowp + bj * HALF) = w; } }
            return;
        }
        const int kind = (u.pn - 4) >> 1;
        bf16_t* dst = QKVo + (size_t)kind * kind_stride;
        const float scl = kind == 0 ? 0.125f : 1.0f;
        const bool roped = kind < 2 && (wc & 1) == 0;
        const int d0 = 32 * (wc & 1) + 8 * fq;
#pragma unroll
        for (int ai = 0; ai < 2; ++ai)
#pragma unroll
            for (int m = 0; m < 4; ++m) {
                const int row = row0 + ai * HALF + m * 16, b = row >> 11, sq = row & 2047;
                const float sgn = fq == 0 ? -1.f : 1.f;
#pragma unroll
                for (int bj = 0; bj < 2; ++bj) {
                    const int hh = ((u.pn & 1) << 2) + 2 * bj + (wc >> 1);
                    u32x4 w;
#pragma unroll
                    for (int n = 0; n < 2; ++n) {
                        f32x4 v = acc[ai][bj][m][n];
                        if (roped) {
                            f32x4 p;
#pragma unroll
                            for (int i = 0; i < 4; ++i) p[i] = __shfl_xor(v[i], 16);
                            if (fq < 2) { const f32x4 cs = *(const f32x4*)(rope + sq * 16 + 4 * n), sn = *(const f32x4*)(rope + sq * 16 + 8 + 4 * n); v = v * cs + p * (sn * sgn); }
                        }
                        v = v * scl;
                        if (n == 0) { w.x = cvt_pk_bf16(v[0], v[1]); w.y = cvt_pk_bf16(v[2], v[3]); } else { w.z = cvt_pk_bf16(v[0], v[1]); w.w = cvt_pk_bf16(v[2], v[3]); }
                    }
                    *(u32x4*)(dst + (((size_t)b * 8 + hh) * 2048 + sq) * 64 + d0) = w;
                }
                __builtin_amdgcn_sched_barrier(0);
            }
    }
};
struct EpiRes {
    static constexpr bool PERM = false, AFTER_DRAIN = false;
    const float* base; float* out; int ldc;
    __device__ __forceinline__ void operator()(const f32x4 (&acc)[2][2][4][2], const Unit& u, int wr, int wc, int fr, int fq) const {
        const int row0 = u.pm * BM + wr * 64 + fr, col0 = u.pn * BM + wc * 32 + 4 * fq;
#pragma unroll
        for (int ai = 0; ai < 2; ++ai)
#pragma unroll
            for (int m = 0; m < 4; ++m) { const size_t off = (size_t)(row0 + ai * HALF + m * 16) * ldc + col0;
#pragma unroll
                for (int bj = 0; bj < 2; ++bj)
#pragma unroll
                    for (int n = 0; n < 2; ++n) { const f32x4 bs = *(const f32x4*)(base + off + bj * HALF + n * 16); *(f32x4*)(out + off + bj * HALF + n * 16) = bs + acc[ai][bj][m][n]; } }
    }
};
struct EpiSwiGLU {
    static constexpr int NSTORE = 8; static constexpr bool PERM = true, AFTER_DRAIN = false;
    unsigned char* H; int ldc; int tiles_per_expert;
    __device__ __forceinline__ void operator()(const f32x4 (&acc)[2][2][4][2], const Unit& u, int wr, int wc, int fr, int fq) const {
        const int row0 = u.pm * BM + wr * 64 + fr, col0 = (u.pn % tiles_per_expert) * HALF + wc * 32 + 8 * fq;
#pragma unroll
        for (int ai = 0; ai < 2; ++ai)
#pragma unroll
            for (int m = 0; m < 4; ++m) { unsigned char* rowp = H + (size_t)(row0 + ai * HALF + m * 16) * ldc + col0;
                float h[8];
#pragma unroll
                for (int n = 0; n < 2; ++n)
#pragma unroll
                    for (int i = 0; i < 4; i += 2) {
                        const f32x2 y = {acc[ai][0][m][n][i], acc[ai][0][m][n][i + 1]}, gp = {acc[ai][1][m][n][i], acc[ai][1][m][n][i + 1]};
                        f32x2 d = {__builtin_amdgcn_exp2f(-y[0]), __builtin_amdgcn_exp2f(-y[1])}; d = d + 1.0f;
                        const f32x2 r = {__builtin_amdgcn_rcpf(d[0]), __builtin_amdgcn_rcpf(d[1])};
                        const f32x2 o = (y * gp) * r; h[n * 4 + i] = o[0]; h[n * 4 + i + 1] = o[1]; }
                int w0 = 0, w1 = 0;
                w0 = __builtin_amdgcn_cvt_pk_fp8_f32(h[0], h[1], w0, false); w0 = __builtin_amdgcn_cvt_pk_fp8_f32(h[2], h[3], w0, true);
                w1 = __builtin_amdgcn_cvt_pk_fp8_f32(h[4], h[5], w1, false); w1 = __builtin_amdgcn_cvt_pk_fp8_f32(h[6], h[7], w1, true);
                *(unsigned long long*)rowp = (unsigned long long)(unsigned)w0 | ((unsigned long long)(unsigned)w1 << 32);
                __builtin_amdgcn_sched_barrier(0); }
    }
};
struct EpiNull {
    static constexpr int NSTORE = 0; static constexpr bool PERM = true, AFTER_DRAIN = false;
    __device__ __forceinline__ void operator()(const f32x4 (&acc)[2][2][4][2], const Unit& u, int wr, int wc, int fr, int fq) const {
#pragma unroll
        for (int ai = 0; ai < 2; ++ai)
#pragma unroll
            for (int bj = 0; bj < 2; ++bj)
#pragma unroll
                for (int m = 0; m < 4; ++m) asm volatile("" :: "v"(acc[ai][bj][m][0]), "v"(acc[ai][bj][m][1]));
    }
};
struct EpiDown {
    static constexpr int NSTORE = 0; static constexpr bool PERM = true, AFTER_DRAIN = false;
    bf16_t* Y; int ldc; const float* gate;
    __device__ __forceinline__ void operator()(const f32x4 (&acc)[2][2][4][2], const Unit& u, int wr, int wc, int fr, int fq) const {
        const int row0 = u.pm * BM + wr * 64 + fr, col0 = (u.pn & 3) * BM + wc * 32 + 8 * fq;
#pragma unroll
        for (int ai = 0; ai < 2; ++ai)
#pragma unroll
            for (int m = 0; m < 4; ++m) { const int row = row0 + ai * HALF + m * 16; const float gt = gate[row]; bf16_t* rowp = Y + (size_t)row * ldc + col0;
#pragma unroll
                for (int bj = 0; bj < 2; ++bj) { const f32x4 v0 = acc[ai][bj][m][0] * gt, v1 = acc[ai][bj][m][1] * gt;
                    u32x4 w; w.x = cvt_pk_bf16(v0[0], v0[1]); w.y = cvt_pk_bf16(v0[2], v0[3]); w.z = cvt_pk_bf16(v1[0], v1[1]); w.w = cvt_pk_bf16(v1[2], v1[3]);
                    *(u32x4*)(rowp + bj * HALF) = w; }
                asm volatile("" ::: "memory"); }
    }
};
struct MoeUpOrder {
    int x, lc, seg, i0, n;
    __device__ void init(int c, int seg_) { x = c & 7; lc = c >> 3; seg = seg_; const int n0 = lc < 16 ? 6 : 5; i0 = seg ? n0 : 0; n = seg ? 11 - n0 : n0; }
    __device__ bool next(int i, Unit& u) const { if (i >= n) return false; const int L = (i0 + i) * 32 + lc, e = 2 * x + L / 176, w = L % 176; u.pm = e * 8 + (w & 7); u.pn = e * 22 + (w >> 3); return true; }
    __device__ __forceinline__ void a_ready(const Unit&) const {}
    __device__ __forceinline__ void done(const Unit&) const {}
};
struct MoeDownOrder {
    int x, lc;
    __device__ void init(int c) { x = c & 7; lc = c >> 3; }
    __device__ bool next(int i, Unit& u) const { if (i >= 2) return false; const int e = 2 * x + i; u.pm = e * 8 + (lc & 7); u.pn = e * 4 + (lc >> 3); return true; }
    __device__ __forceinline__ void a_ready(const Unit&) const {}
    __device__ __forceinline__ void done(const Unit&) const {}
};

template <bool F8> struct Frag;
template <> struct Frag<false> { bf16x8 k[2]; };
template <> struct Frag<true> { v8i_t v; };
template <class Epi, class Sched, bool ALIGN_EPI = false, bool SP2 = true, bool GATHER = false, bool F8 = false>
__device__ __forceinline__ void gemm_phase(PG8_LAS unsigned char* lds, const Gemm g, const Sched& S, const Epi& E, const int tid_in) {
    int tid_ = tid_in; asm volatile("" : "+v"(tid_));
    const int tid = tid_, wid = __builtin_amdgcn_readfirstlane(tid >> 6), lane = tid & 63, wr = wid >> 2, wc = wid & 3, fr = lane & 15, fq = lane >> 4;
    const int K = g.K, KB = F8 ? K : 2 * K  , nt = KB / (BK * 2);
    unsigned voffA[2], voffB[2]; int RA[2]; unsigned CA2[2];
    unsigned gc[2][2];
#pragma unroll
    for (int i = 0; i < 2; ++i) { int R, C; stage_rc(tid * 16 + i * 8192, R, C); const int Rb = Epi::PERM ? ((R & ~31) + perm32(R & 31)) : R;
        voffA[i] = (unsigned)(R * KB + C * 2); voffB[i] = (unsigned)(Rb * KB + C * 2); RA[i] = R; CA2[i] = (unsigned)C * 2u; }
    const size_t kstep = (size_t)(BK * 2);
    const size_t hstep = (size_t)HALF * KB;
    const size_t hstepA = GATHER ? (size_t)0 : hstep;
    const size_t tstep = 2 * hstep;
    const unsigned ldsw = (unsigned)wid * 1024u;
    const int aoff = lds_byte(wr * 64 + fr, fq * 8), boff = lds_byte(wc * 32 + fr, fq * 8);
    PG8_LAS unsigned char* ldsAr = lds + aoff; PG8_LAS unsigned char* ldsBr = lds + 4 * HTB + boff;
    asm volatile("" : "+v"(ldsAr), "+v"(ldsBr));
#define PG8_SA(b, h) (((b) * 2 + (h)) * HTB)
#define PG8_SB(b, h) ((4 + (b) * 2 + (h)) * HTB)
#define PG8_STAGE(bufoff, gbase, voff) do { _Pragma("unroll") for (int _i = 0; _i < 2; ++_i) \
        __builtin_amdgcn_global_load_lds((const unsigned*)((const char*)(gbase) + (voff)[_i]), (PG8_LAS unsigned*)(lds + (bufoff) + ldsw + _i * 8192), 16, 0, 0); } while (0)
#define PG8_GLOAD(dst, u) do { _Pragma("unroll") for (int _h = 0; _h < 2; ++_h) _Pragma("unroll") for (int _i = 0; _i < 2; ++_i) \
        dst[_h][_i] = (unsigned)g.rowidx[(u).pm * BM + _h * HALF + RA[_i]] * (unsigned)KB + CA2[_i]; } while (0)
#define PG8_STAGE_A(bufoff, aptr, h, usenext) do { if constexpr (GATHER) { PG8_STAGE(bufoff, aptr, gc[h]); } \
        else { PG8_STAGE(bufoff, (aptr) + (h) * hstepA, voffA); } } while (0)
#define PG8_LD1(d, p) do { if constexpr (F8) { (d).v = cat32(*(const PG8_LAS bf16x8*)(p), *(const PG8_LAS bf16x8*)((p) + 1024)); } else { (d).k[0] = *(const PG8_LAS bf16x8*)(p); (d).k[1] = *(const PG8_LAS bf16x8*)((p) + 1024); } } while (0)
#define PG8_LDA(dst, b, h) do { _Pragma("unroll") for (int m = 0; m < 4; ++m) PG8_LD1(dst[m], ldsAr + PG8_SA(b, h) + m * 2048); } while (0)
#define PG8_LDB(dst, b, h) do { _Pragma("unroll") for (int n = 0; n < 2; ++n) PG8_LD1(dst[n], ldsBr + ((b) * 2 + (h)) * HTB + n * 2048); } while (0)
#define PG8_SUB(v, o) ((f32x4){(v)[(o)], (v)[(o) + 1], (v)[(o) + 2], (v)[(o) + 3]})
#define PG8_INS(v, r, o) do { (v)[(o)] = (r)[0]; (v)[(o) + 1] = (r)[1]; (v)[(o) + 2] = (r)[2]; (v)[(o) + 3] = (r)[3]; } while (0)
#define PG8_MMA(ai, bj, At, Bt) do { __builtin_amdgcn_s_setprio(1); \
        _Pragma("unroll") for (int m = 0; m < 4; ++m) _Pragma("unroll") for (int n = 0; n < 2; ++n) { \
            f32x4 c_ = PG8_SUB(accq[ai][bj][m >> 1], 8 * (m & 1) + 4 * n); \
            if constexpr (F8) { c_ = __builtin_amdgcn_mfma_scale_f32_16x16x128_f8f6f4(Bt[n].v, At[m].v, c_, 0, 0, 0, g.wscale, 0, 0x7f7f7f7f); } \
            else { _Pragma("unroll") for (int k = 0; k < 2; ++k) c_ = __builtin_amdgcn_mfma_f32_16x16x32_bf16(Bt[n].k[k], At[m].k[k], c_, 0, 0, 0); } \
            PG8_INS(accq[ai][bj][m >> 1], c_, 8 * (m & 1) + 4 * n); } \
        __builtin_amdgcn_s_setprio(0); } while (0)
#define PG8_WAIT_V(n) asm volatile("s_waitcnt vmcnt(" #n ")" ::: "memory")
#define PG8_WAIT_VN(n) asm volatile("s_waitcnt vmcnt(%0)" :: "n"(n) : "memory")
#define PG8_WAIT_L(n) asm volatile("s_waitcnt lgkmcnt(" #n ")" ::: "memory")
#define PG8_BAR __builtin_amdgcn_s_barrier()
#define PG8_SCHED __builtin_amdgcn_sched_barrier(0)
    Unit cur, nxt; int ui = 0;
    if (!S.next(0, cur)) return;
    typedef float f32x16_t __attribute__((ext_vector_type(16)));
    f32x16_t accq[2][2][2];
    Frag<F8> At[4], B0[2], B1[2];
    const char* cA = GATHER ? (const char*)g.A : (const char*)g.A + (size_t)cur.pm * tstep; const char* cB = (const char*)g.Bt + (size_t)cur.pn * tstep;
    if constexpr (GATHER) { PG8_GLOAD(gc, cur); asm volatile("s_waitcnt vmcnt(0)" ::: "memory"); }
    S.a_ready(cur);
    if constexpr (SP2) {
        PG8_STAGE(PG8_SB(0, 0), cB, voffB); PG8_STAGE(PG8_SB(0, 1), cB + hstep, voffB); PG8_STAGE_A(PG8_SA(0, 0), cA, 0, false); PG8_STAGE_A(PG8_SA(0, 1), cA, 1, false);
        if (wr == 1) PG8_BAR;
        PG8_WAIT_V(2); PG8_BAR;
        PG8_STAGE(PG8_SB(1, 0), cB + kstep, voffB); PG8_STAGE_A(PG8_SA(1, 0), cA + kstep, 0, false); PG8_STAGE(PG8_SB(1, 1), cB + hstep + kstep, voffB);
        PG8_WAIT_V(6); PG8_BAR;
    } else {
        PG8_STAGE(PG8_SB(0, 0), cB, voffB); PG8_STAGE(PG8_SA(0, 0), cA, voffA); PG8_STAGE(PG8_SB(0, 1), cB + hstep, voffB); PG8_STAGE(PG8_SA(0, 1), cA + hstep, voffA);
        if (wr == 1) PG8_BAR;
        PG8_WAIT_V(4); PG8_BAR;
        PG8_STAGE(PG8_SB(1, 0), cB + kstep, voffB); PG8_STAGE(PG8_SA(1, 0), cA + kstep, voffA); PG8_STAGE(PG8_SB(1, 1), cB + hstep + kstep, voffB);
        PG8_WAIT_V(6); PG8_BAR;
    }
    PG8_SCHED;
#pragma unroll
    for (int a = 0; a < 2; ++a)
#pragma unroll
        for (int b = 0; b < 2; ++b)
#pragma unroll
            for (int m = 0; m < 2; ++m)
#pragma unroll
                for (int i = 0; i < 16; ++i) accq[a][b][m][i] = 0.f;
    for (;;) {
        const bool has_next = S.next(ui + 1, nxt);
        const char* nA = GATHER ? (const char*)g.A : (has_next ? (const char*)g.A + (size_t)nxt.pm * tstep : cA); const char* nB = has_next ? (const char*)g.Bt + (size_t)nxt.pn * tstep : cB;
#pragma unroll 1
        for (int t = 0; t < nt; t += 2) {
            const bool last = (t == nt - 2);
            const char* a1 = cA + (size_t)(t + 1) * kstep;
            const char* a2 = last ? nA : cA + (size_t)(t + 2) * kstep; const char* b2 = last ? nB : cB + (size_t)(t + 2) * kstep;
            const char* a3 = a2 + kstep; const char* b3 = b2 + kstep;
            if (last && has_next) S.a_ready(nxt);
            if constexpr (SP2) {
            const bool fresh = Epi::NSTORE > 0 && t == 0 && ui > 0;
            PG8_LDB(B0, 0, 0); PG8_LDB(B1, 0, 1); PG8_SCHED; PG8_LDA(At, 0, 0); PG8_STAGE_A(PG8_SA(1, 1), a1, 1, false);
            if (fresh) PG8_WAIT_VN(8 + Epi::NSTORE); else PG8_WAIT_V(8);
            PG8_WAIT_L(0); PG8_BAR; PG8_MMA(0, 0, At, B0); PG8_MMA(0, 1, At, B1); PG8_BAR; PG8_SCHED;
            PG8_LDA(At, 0, 1); PG8_STAGE(PG8_SB(0, 0), b2, voffB); PG8_STAGE(PG8_SB(0, 1), b2 + hstep, voffB); PG8_STAGE_A(PG8_SA(0, 0), a2, 0, last);
            if (fresh) PG8_WAIT_VN(8 + Epi::NSTORE); else PG8_WAIT_V(8);
            PG8_WAIT_L(0); PG8_BAR; PG8_MMA(1, 0, At, B0); PG8_MMA(1, 1, At, B1); PG8_BAR; PG8_SCHED;
            PG8_LDB(B0, 1, 0); PG8_LDB(B1, 1, 1); PG8_SCHED; PG8_LDA(At, 1, 0); PG8_STAGE_A(PG8_SA(0, 1), a2, 1, last);
            PG8_WAIT_V(8); PG8_WAIT_L(0); PG8_BAR; PG8_MMA(0, 0, At, B0); PG8_MMA(0, 1, At, B1); PG8_BAR; PG8_SCHED;
            PG8_LDA(At, 1, 1); PG8_STAGE(PG8_SB(1, 0), b3, voffB); PG8_STAGE(PG8_SB(1, 1), b3 + hstep, voffB); PG8_STAGE_A(PG8_SA(1, 0), a3, 0, last);
            PG8_WAIT_V(8); PG8_WAIT_L(0); PG8_BAR; PG8_MMA(1, 0, At, B0); PG8_MMA(1, 1, At, B1); PG8_BAR; PG8_SCHED;
            } else {
            PG8_LDB(B0, 0, 0); PG8_SCHED; PG8_LDA(At, 0, 0); PG8_STAGE(PG8_SA(1, 1), a1 + hstep, voffA);
            PG8_WAIT_L(8); PG8_BAR; PG8_WAIT_L(0); PG8_MMA(0, 0, At, B0); PG8_BAR; PG8_SCHED;
            PG8_LDB(B1, 0, 1); PG8_STAGE(PG8_SB(0, 0), b2, voffB);
            PG8_BAR; PG8_WAIT_L(0); PG8_MMA(0, 1, At, B1); PG8_BAR;
            PG8_LDA(At, 0, 1); PG8_STAGE(PG8_SA(0, 0), a2, voffA);
            PG8_BAR; PG8_WAIT_L(0); PG8_MMA(1, 0, At, B0); PG8_BAR; PG8_SCHED;
            PG8_STAGE(PG8_SB(0, 1), b2 + hstep, voffB);
            PG8_WAIT_V(6); PG8_BAR; PG8_MMA(1, 1, At, B1); PG8_BAR;
            PG8_LDB(B0, 1, 0); PG8_SCHED; PG8_LDA(At, 1, 0); PG8_STAGE(PG8_SA(0, 1), a2 + hstep, voffA);
            PG8_WAIT_L(8); PG8_BAR; PG8_WAIT_L(0); PG8_MMA(0, 0, At, B0); PG8_BAR; PG8_SCHED;
            PG8_LDB(B1, 1, 1); PG8_STAGE(PG8_SB(1, 0), b3, voffB);
            PG8_BAR; PG8_WAIT_L(0); PG8_MMA(0, 1, At, B1); PG8_BAR;
            PG8_LDA(At, 1, 1); PG8_STAGE(PG8_SA(1, 0), a3, voffA);
            PG8_BAR; PG8_WAIT_L(0); PG8_MMA(1, 0, At, B0); PG8_BAR; PG8_SCHED;
            PG8_STAGE(PG8_SB(1, 1), b3 + hstep, voffB);
            PG8_WAIT_V(6); PG8_BAR; PG8_MMA(1, 1, At, B1); PG8_BAR;
            }
        }
        if constexpr (ALIGN_EPI) { if (wr == 0) PG8_BAR; }
        if constexpr (!Epi::AFTER_DRAIN) { f32x4 acc[2][2][4][2];
            _Pragma("unroll") for (int a = 0; a < 2; ++a) _Pragma("unroll") for (int b = 0; b < 2; ++b) _Pragma("unroll") for (int m = 0; m < 4; ++m) _Pragma("unroll") for (int n = 0; n < 2; ++n) acc[a][b][m][n] = PG8_SUB(accq[a][b][m >> 1], 8 * (m & 1) + 4 * n);
            int te = tid_in; asm volatile("" : "+v"(te));
            E(acc, cur, wr, wc, te & 15, (te & 63) >> 4); S.done(cur); }
        if (!has_next) break;
#pragma unroll
        for (int a = 0; a < 2; ++a)
#pragma unroll
            for (int b = 0; b < 2; ++b)
#pragma unroll
                for (int m = 0; m < 2; ++m)
#pragma unroll
                    for (int i = 0; i < 16; ++i) accq[a][b][m][i] = 0.f;
        cur = nxt; cA = nA; cB = nB; ++ui;
        if constexpr (ALIGN_EPI) { if (wr == 1) PG8_BAR; }
    }
    PG8_WAIT_V(0);
    if constexpr (!ALIGN_EPI) { if (wr == 0) PG8_BAR; }
    PG8_BAR;

#undef PG8_SA
#undef PG8_SB
#undef PG8_STAGE
#undef PG8_GLOAD
#undef PG8_STAGE_A
#undef PG8_LD1
#undef PG8_LDA
#undef PG8_LDB
#undef PG8_SUB
#undef PG8_INS
#undef PG8_MMA
#undef PG8_WAIT_V
#undef PG8_WAIT_VN
#undef PG8_WAIT_L
#undef PG8_BAR
#undef PG8_SCHED
}
}


constexpr int NB = 8, SEQ = 2048, DMODEL = 1024, NT = NB * SEQ;
constexpr int DML = 512, DAT = 512, DPROJ = 2560;
constexpr int MH = 4, MDH = 128, AH = 8, ADH = 64;
constexpr int NE = 16, CAP = 256, DEXP = 2816, NPAIR = NE * NB * CAP;
constexpr float EPS = 1e-6f;
constexpr int NWAVES = 8, NTHR = 512;

constexpr size_t MiB = 1u << 20;
constexpr size_t WS_CTL = 0, CTL_ZERO_BYTES = 32768;
constexpr size_t WS_WIN = 1 * MiB;
constexpr size_t WS_WOUT = WS_WIN + (size_t)DPROJ * DMODEL * 2;
constexpr size_t WS_W13 = WS_WOUT + (size_t)DMODEL * DMODEL * 2;
constexpr size_t WS_W2 = WS_W13 + (size_t)NE * 2 * DEXP * DMODEL;
constexpr size_t WS_XN = WS_W2 + (size_t)NE * DMODEL * DEXP;
constexpr size_t WS_PROJ = WS_XN + (size_t)NT * DMODEL * 2;
constexpr size_t WS_AFF = WS_PROJ + (size_t)NT * DPROJ * 2;
constexpr size_t WS_SLOT = WS_AFF + (size_t)NT * NE * 4;
constexpr size_t WS_SELT = WS_SLOT + (size_t)NT * NE * 4;
constexpr size_t WS_SELG = WS_SELT + (size_t)NPAIR * 4;
constexpr size_t WS_GI = WS_SELG + (size_t)NPAIR * 4;
constexpr size_t WS_GF = WS_GI + (size_t)2 * NB * MH * SEQ * 4;
constexpr size_t WS_ROPE = WS_GF + (size_t)2 * NB * MH * SEQ * 4;
constexpr size_t WS_WT = WS_ROPE + (size_t)SEQ * 16 * 4;
constexpr size_t WS_MIX0 = WS_WT + 65536;
constexpr size_t WS_XC = WS_MIX0;
constexpr size_t WS_QM = WS_XC + (size_t)NT * DML * 2;
constexpr size_t WS_KM = WS_QM + (size_t)NT * DML * 2;
constexpr size_t WS_VM = WS_KM + (size_t)NT * DML * 2;
constexpr size_t WS_QR = WS_VM + (size_t)NT * DML * 2;
constexpr size_t WS_KR = WS_QR + (size_t)NT * DAT * 2;
constexpr size_t WS_VR = WS_KR + (size_t)NT * DAT * 2;
constexpr size_t WS_HFB = WS_VR + (size_t)NT * DAT * 2;
constexpr size_t WS_OPART = WS_HFB + (size_t)2 * NT * DML * 4;
constexpr size_t WS_OSTAT = WS_OPART + (size_t)3 * NT * DAT * 2;
constexpr size_t WS_MIX1 = WS_OSTAT + (size_t)3 * NT * AH * 2 * 4;
constexpr size_t WS_YO = WS_HFB;
constexpr size_t WS_H = WS_MIX0;
constexpr size_t WS_Y = WS_PROJ;
constexpr size_t WS_END = (WS_MIX1 > WS_H + (size_t)NPAIR * DEXP) ? WS_MIX1 : WS_H + (size_t)NPAIR * DEXP;
static_assert((size_t)NPAIR * DMODEL * 2 <= (size_t)NT * DPROJ * 2, "Y fits in proj");
static_assert(WS_H + (size_t)NPAIR * DEXP <= WS_HFB && (size_t)NT * DMODEL * 2 <= (size_t)2 * NT * DML * 4, "y lives in hfb, clear of H");
static_assert(WS_END <= (size_t)736 * MiB, "d_ws map must stay below 4x the largest input");
constexpr int CW_TMO = 0, CW_QHEAD = 64, CW_MDONE = 128, CW_P1DONE = 192, CW_ADONE = 256, CW_BAR = 4096;
static_assert((CW_BAR + 3456) * 4 <= (int)CTL_ZERO_BYTES, "control words inside the per-call memset");
constexpr int CVT_EARLY = (DMODEL / 64) * (DPROJ / 64) + (DMODEL / 64) * (DMODEL / 64);
constexpr int CVT_MOE = NE * (2 * (DMODEL / 64) * (DEXP / 64) + (DEXP / 64) * (DMODEL / 64)), CVT_BATCH = 8, CVT_NBATCH = CVT_MOE / CVT_BATCH;
static_assert(CVT_MOE % CVT_BATCH == 0, "conversion batches");

constexpr int RING_OFF = 0, RING_BYTES = 155648;
constexpr int LDSCTL_OFF = RING_BYTES, MISC_OFF = LDSCTL_OFF + 320;
constexpr int LDS_BYTES = 160 * 1024;

#define GAS __attribute__((address_space(1)))
#define LAS __attribute__((address_space(3)))
typedef unsigned short bf16;
typedef unsigned v4u __attribute__((ext_vector_type(4)));
typedef float f32x4 __attribute__((ext_vector_type(4)));
typedef short bf16x8 __attribute__((ext_vector_type(8)));
typedef GAS unsigned gu32;
typedef GAS unsigned long long gu64;
#define RLX_AGENT __ATOMIC_RELAXED, __HIP_MEMORY_SCOPE_AGENT
#define LDS_WAIT() asm volatile("s_waitcnt lgkmcnt(0)" ::: "memory")
#define VM_WAIT() asm volatile("s_waitcnt vmcnt(0)" ::: "memory")
__device__ __forceinline__ unsigned long long rt() { return __builtin_amdgcn_s_memrealtime(); }
__device__ __forceinline__ unsigned f2bf(float f) { unsigned u = __builtin_bit_cast(unsigned, f); return (u + 0x7fffu + ((u >> 16) & 1u)) >> 16; }
__device__ __forceinline__ unsigned pk2(float lo, float hi) { return f2bf(lo) | (f2bf(hi) << 16); }

#define XB_TMO      128
#define XB_XCNT(j)  (256  + 64 * (j))
#define XB_XSUB(j)  (1280 + 64 * (j))
#define XB_XGEN(j)  (2304 + 64 * (j))
#define XB_TOP      3328
#define XB_TOPGEN   3392
#define XCD_BAR_WORDS 3456
#define XB_SPIN_CAP (1u << 18)

__device__ __forceinline__ unsigned xb_ld(unsigned* p)              { return __hip_atomic_load(p, __ATOMIC_RELAXED, __HIP_MEMORY_SCOPE_AGENT); }
__device__ __forceinline__ unsigned xb_add(unsigned* p, unsigned v) { return __hip_atomic_fetch_add(p, v, __ATOMIC_RELAXED, __HIP_MEMORY_SCOPE_AGENT); }
__device__ __forceinline__ unsigned xb_xcc_id() { return (unsigned)__builtin_amdgcn_s_getreg((3 << 11) | 20) & 0xFu; }
#define XB_SPIN(cond, bar) do { unsigned _sp = 0; while (cond) { __builtin_amdgcn_s_sleep(1); \
    if ((++_sp & 255u) == 0u) { if (xb_ld(&(bar)[XB_TMO])) break; if (_sp > XB_SPIN_CAP) { atomicAdd(&(bar)[XB_TMO], 1u); break; } } } } while (0)

struct XcdBarrier {
    unsigned* bar; unsigned x;
    volatile LAS unsigned* st;
};

__device__ __forceinline__ XcdBarrier xcd_barrier_post(unsigned* bar, volatile LAS unsigned* st) {
    XcdBarrier b; b.bar = bar; b.x = xb_xcc_id(); b.st = st;
    if (threadIdx.x == 0) (void)xb_add(&bar[XB_XCNT(b.x)], 1u);
    return b;
}
__device__ __forceinline__ void xcd_barrier_complete(unsigned* bar, unsigned x, unsigned& nloc, unsigned& nx) {
    const unsigned G = gridDim.x * gridDim.y * gridDim.z;
    unsigned sum, cnt, mine, sp = 0u;
    for (;;) {
        sum = 0u; cnt = 0u; mine = 0u;
#pragma unroll
        for (unsigned j = 0; j < 16; ++j) { const unsigned c = xb_ld(&bar[XB_XCNT(j)]); sum += c; cnt += (c > 0u) ? 1u : 0u; mine = (j == x) ? c : mine; }
        if (sum == G) break;
        __builtin_amdgcn_s_sleep(1);
        if ((++sp & 255u) == 0u) { if (xb_ld(&bar[XB_TMO])) break; if (sp > XB_SPIN_CAP) { atomicAdd(&bar[XB_TMO], 1u); break; } }
    }
    nloc = mine > 0u ? mine : 1u; nx = cnt > 0u ? cnt : 1u;
}

__device__ __forceinline__ void xcd_barrier(const XcdBarrier& b) {
    asm volatile("s_waitcnt vmcnt(0)" ::: "memory");
    __syncthreads();
    if (threadIdx.x == 0) {
        unsigned* bar = b.bar;
        __builtin_amdgcn_s_waitcnt(0);
        unsigned nloc = b.st[0], nx = b.st[1];
        if (nloc == 0u) { xcd_barrier_complete(bar, b.x, nloc, nx); b.st[0] = nloc; b.st[1] = nx; }
        const unsigned old = xb_add(&bar[XB_XSUB(b.x)], 1u);
        const unsigned gen = old / nloc;
        if (old + 1u == (gen + 1u) * nloc) {
            __builtin_amdgcn_fence(__ATOMIC_RELEASE, "agent");
            asm volatile("s_waitcnt vmcnt(0)" ::: "memory");
            const unsigned og = xb_add(&bar[XB_TOP], 1u);
            const unsigned tg = og / nx;
            if (og + 1u == (tg + 1u) * nx) xb_add(&bar[XB_TOPGEN], 1u);
            else XB_SPIN(xb_ld(&bar[XB_TOPGEN]) == tg, bar);
            __builtin_amdgcn_fence(__ATOMIC_ACQUIRE, "agent");
            xb_add(&bar[XB_XGEN(b.x)], 1u);
            asm volatile("s_waitcnt vmcnt(0)" ::: "memory");
        } else {
            XB_SPIN(xb_ld(&bar[XB_XGEN(b.x)]) == gen, bar);
            __builtin_amdgcn_fence(__ATOMIC_ACQUIRE, "agent");
            asm volatile("s_waitcnt vmcnt(0)" ::: "memory");
        }
    }
    __syncthreads();
}


__device__ __forceinline__ float bf2f(unsigned short u) { return __uint_as_float((unsigned)u << 16); }
__device__ __forceinline__ float wave_sum(float v) {
#pragma unroll
    for (int o = 1; o < 64; o <<= 1) v += __shfl_xor(v, o);
    return v;
}
__device__ __forceinline__ float siluf(float x) { return x / (1.f + expf(-x)); }
__device__ __forceinline__ float logsigf(float x) { return fminf(x, 0.f) - log1pf(expf(-fabsf(x))); }

struct Args {
    const float* in[22]; float* out; unsigned char* ws; int ph_lo, ph_hi, li, pad;
};
struct Frame { LAS unsigned char* lds; int tid, lane, wave, G, bx; };

__device__ __forceinline__ void cvt_load(const float* W, int ldw, int k0, int n0, int lane, f32x4 (&r)[16]) {
    const int n4 = lane & 15, rp = lane >> 4;
#pragma unroll
    for (int it = 0; it < 8; ++it) {
        const float* p = W + (size_t)(k0 + 8 * it + 2 * rp) * ldw + n0 + 4 * n4;
        r[2 * it] = *(const GAS f32x4*)p; r[2 * it + 1] = *(const GAS f32x4*)(p + ldw);
    }
}
__device__ __forceinline__ void cvt_store(const f32x4 (&r)[16], unsigned char* dst  , int ldd  , LAS unsigned* scr, int lane) {
    const int n4 = lane & 15, rp = lane >> 4;
#pragma unroll
    for (int it = 0; it < 8; ++it) {
        const int kp = 4 * it + rp;
#pragma unroll
        for (int i = 0; i < 4; ++i) { const int n = 4 * n4 + i; scr[n * 32 + (((kp >> 2) ^ (n4 & 7)) << 2) + (kp & 3)] = pk2(r[2 * it][i], r[2 * it + 1][i]); }
    }
    LDS_WAIT(); asm volatile("" ::: "memory");
    const int c = lane & 7;
#pragma unroll
    for (int it = 0; it < 8; ++it) {
        const int n = 8 * it + (lane >> 3);
        const v4u o = *(const LAS v4u*)(scr + n * 32 + ((c ^ ((n >> 2) & 7)) << 2));
        *(GAS v4u*)(dst + (size_t)n * ldd + 16 * c) = o;
    }
    LDS_WAIT(); asm volatile("" ::: "memory");
}
__device__ __forceinline__ void cvt8_load(const float* W, int ldw, int k0, int n0, int lane, f32x4 (&r)[16]) {
    const int n4 = lane & 15, rp = lane >> 4;
#pragma unroll
    for (int it = 0; it < 4; ++it) {
        const float* p = W + (size_t)(k0 + 16 * it + 4 * rp) * ldw + n0 + 4 * n4;
#pragma unroll
        for (int q = 0; q < 4; ++q) r[4 * it + q] = __builtin_nontemporal_load((const GAS f32x4*)(p + (size_t)q * ldw));
    }
}
__device__ __forceinline__ void cvt8_store(const f32x4 (&r)[16], unsigned char* dst, int ldd, LAS unsigned* scr, int lane, float sc) {
    const int n4 = lane & 15, rp = lane >> 4;
#pragma unroll
    for (int it = 0; it < 4; ++it) {
        const int kq = 4 * it + rp;
#pragma unroll
        for (int i = 0; i < 4; ++i) { int w = 0; w = __builtin_amdgcn_cvt_pk_fp8_f32(r[4 * it][i] * sc, r[4 * it + 1][i] * sc, w, false); w = __builtin_amdgcn_cvt_pk_fp8_f32(r[4 * it + 2][i] * sc, r[4 * it + 3][i] * sc, w, true);
            scr[(4 * n4 + i) * 17 + kq] = (unsigned)w; }
    }
    LDS_WAIT(); asm volatile("" ::: "memory");
    const int c = lane & 3;
#pragma unroll
    for (int j = 0; j < 4; ++j) {
        const int n = 16 * j + (lane >> 2);
        const v4u o = {scr[n * 17 + 4 * c], scr[n * 17 + 4 * c + 1], scr[n * 17 + 4 * c + 2], scr[n * 17 + 4 * c + 3]};
        *(GAS v4u*)(dst + (size_t)n * ldd + 16 * c) = o;
    }
    LDS_WAIT(); asm volatile("" ::: "memory");
}
struct CvtItem { const float* W; int ldw, k0, n0; unsigned char* dst; int ldd; int f8; float sc; };
__device__ __forceinline__ bool cvt_item(const Args& a, int it, CvtItem& c) {
    unsigned char* ws = a.ws;
    constexpr int I_IN = (DMODEL / 64) * (DPROJ / 64), I_OUT = (DMODEL / 64) * (DMODEL / 64), I_W1 = (DMODEL / 64) * (DEXP / 64), I_W2 = (DEXP / 64) * (DMODEL / 64);
    constexpr int NITEMS = I_IN + I_OUT + NE * (2 * I_W1 + I_W2);
    if (it >= NITEMS) return false;
    if (it < I_IN) { const int nb = DPROJ / 64, kb = it / nb, n0 = (it % nb) * 64; c = {a.in[2], DPROJ, kb * 64, n0, ws + WS_WIN + ((size_t)n0 * DMODEL + kb * 64) * 2, DMODEL * 2, 0, 1.f}; return true; }
    it -= I_IN;
    if (it < I_OUT) { const int nb = DMODEL / 64, kb = it / nb, n0 = (it % nb) * 64; c = {a.in[15], DMODEL, kb * 64, n0, ws + WS_WOUT + ((size_t)n0 * DMODEL + kb * 64) * 2, DMODEL * 2, 0, 1.f}; return true; }
    it -= I_OUT;
    const int per_e = 2 * I_W1 + I_W2, e = it / per_e; it %= per_e;
    if (it < 2 * I_W1) { const int which = it / I_W1; it %= I_W1; const int nb = DEXP / 64, kb = it / nb, n0 = (it % nb) * 64;
        const float* W = a.in[which ? 19 : 18] + (size_t)e * DMODEL * DEXP;
        const size_t drow = (size_t)e * 2 * DEXP + (size_t)(n0 / 128) * 256 + (n0 % 128) + (which ? 128 : 0);
        c = {W, DEXP, kb * 64, n0, ws + WS_W13 + drow * DMODEL + kb * 64, DMODEL, 1, which ? 32.f * 0.6931471805599453f : 32.f * 1.4426950408889634f}; return true; }
    it -= 2 * I_W1;
    { const int nb = DMODEL / 64, kb = it / nb, n0 = (it % nb) * 64; const float* W = a.in[20] + (size_t)e * DEXP * DMODEL;
      c = {W, DMODEL, kb * 64, n0, ws + WS_W2 + ((size_t)e * DMODEL + n0) * DEXP + kb * 64, DEXP, 1, 64.f}; return true; }
}
__device__ __forceinline__ void p0_prologue(const Args& a, Frame& F) {
    LAS unsigned* scr = (LAS unsigned*)(F.lds + RING_OFF + F.wave * 8192);
    const int gw = F.bx * NWAVES + F.wave, NGW = F.G * NWAVES;
    {
        const float* x = a.in[0]; const float* g1 = a.in[1]; bf16* XN = (bf16*)(a.ws + WS_XN);
        f32x4 gq[4];
#pragma unroll
        for (int j = 0; j < 4; ++j) gq[j] = ((const GAS f32x4*)g1)[F.lane + 64 * j];
        f32x4 nx[4];
        if (gw < NT) {
#pragma unroll
            for (int j = 0; j < 4; ++j) nx[j] = ((const GAS f32x4*)(x + (size_t)gw * DMODEL) + F.lane)[64 * j]; }
        for (int m = gw; m < NT; m += NGW) {
            f32x4 v[4]; float s = 0.f;
#pragma unroll
            for (int j = 0; j < 4; ++j) v[j] = nx[j];
            if (m + NGW < NT) {
#pragma unroll
                for (int j = 0; j < 4; ++j) nx[j] = ((const GAS f32x4*)(x + (size_t)(m + NGW) * DMODEL) + F.lane)[64 * j]; }
#pragma unroll
            for (int j = 0; j < 4; ++j) s += (v[j].x * v[j].x + v[j].y * v[j].y) + (v[j].z * v[j].z + v[j].w * v[j].w);
            const float r = rsqrtf(wave_sum(s) * (1.f / DMODEL) + EPS);
            GAS unsigned long long* o8 = (GAS unsigned long long*)(XN + (size_t)m * DMODEL) + F.lane;
#pragma unroll
            for (int j = 0; j < 4; ++j) { const f32x4 w = gq[j];
                o8[64 * j] = (unsigned long long)pk2(v[j].x * r * w.x, v[j].y * r * w.y) | ((unsigned long long)pk2(v[j].z * r * w.z, v[j].w * r * w.w) << 32); }
        }
    }
    { float* rope = (float*)(a.ws + WS_ROPE);
      for (int i = F.bx * NTHR + F.tid; i < SEQ * 8; i += F.G * NTHR) { const int sidx = i >> 3, k = i & 7; const float ang = (float)sidx * powf(500000.0f, -2.0f * (float)k / 16.0f); rope[sidx * 16 + k] = cosf(ang); rope[sidx * 16 + 8 + k] = sinf(ang); } }
    { unsigned char* img = a.ws + WS_WT; const float* wf = a.in[8]; const float* wb = a.in[10];
      for (int i = F.bx * NTHR + F.tid; i < 16 * 1536; i += F.G * NTHR) { const int n = i / 1536, k = i % 1536; *(bf16*)(img + n * 3088 + k * 2) = (bf16)f2bf(n < 8 ? wf[(size_t)k * 8 + n] : wb[(size_t)k * 8 + n - 8]); } }
    CvtItem cur, nxt; f32x4 ra[16], rb[16];
#define CVT_LOAD(c, r) do { if ((c).f8) cvt8_load((c).W, (c).ldw, (c).k0, (c).n0, F.lane, r); else cvt_load((c).W, (c).ldw, (c).k0, (c).n0, F.lane, r); } while (0)
#define CVT_STORE(c, r) do { if ((c).f8) cvt8_store(r, (c).dst, (c).ldd, scr, F.lane, (c).sc); else cvt_store(r, (c).dst, (c).ldd, scr, F.lane); } while (0)
    int it = gw; bool have = it < CVT_EARLY && cvt_item(a, it, cur);
    if (have) CVT_LOAD(cur, ra);
    while (have) {
        const bool hn = (it + NGW < CVT_EARLY) && cvt_item(a, it + NGW, nxt);
        if (hn) CVT_LOAD(nxt, rb);
        CVT_STORE(cur, ra);
        it += NGW; have = hn; if (!have) break;
        cur = nxt;
        const bool hn2 = (it + NGW < CVT_EARLY) && cvt_item(a, it + NGW, nxt);
        if (hn2) CVT_LOAD(nxt, ra);
        CVT_STORE(cur, rb);
        it += NGW; have = hn2; cur = nxt;
    }
}
__device__ __forceinline__ bool cvt_batch(const Args& a, Frame& F, int stop_word, unsigned stop_target, int stop_word2 = -1, unsigned stop_target2 = 0u, int qword = CW_QHEAD) {
    gu32* ctl = (gu32*)(a.ws + WS_CTL);
    volatile LAS unsigned* bq = (volatile LAS unsigned*)(F.lds + LDSCTL_OFF + 64);
    LAS unsigned* scr = (LAS unsigned*)(F.lds + RING_OFF + F.wave * 8192);
    __syncthreads();
    if (F.tid == 0) {
        unsigned v = 0xffffffffu;
        bool stop = stop_word >= 0 && __hip_atomic_load(ctl + stop_word, RLX_AGENT) >= stop_target;
        if (stop && stop_word2 >= 0) stop = __hip_atomic_load(ctl + stop_word2, RLX_AGENT) >= stop_target2;
        if (!stop) v = __hip_atomic_fetch_add(ctl + qword, 1u, RLX_AGENT);
        bq[0] = v;
    }
    __syncthreads();
    const unsigned batch = bq[0];
    if (batch >= (unsigned)CVT_NBATCH) return false;
    const int it0 = CVT_EARLY + (int)batch * CVT_BATCH + F.wave;
    CvtItem c0; f32x4 ra[16];
    cvt_item(a, it0, c0); CVT_LOAD(c0, ra);
    CVT_STORE(c0, ra);
    return true;
}
#ifndef NATT
#define NATT 128
#endif
__device__ __forceinline__ void cvt_stream(const Args& a, Frame& F, int stop_word, unsigned stop_target, int stop_word2 = -1, unsigned stop_target2 = 0u, int qword = CW_QHEAD) {
    gu32* ctl = (gu32*)(a.ws + WS_CTL);
    volatile LAS unsigned* bq = (volatile LAS unsigned*)(F.lds + LDSCTL_OFF + 64);
    LAS unsigned* scr = (LAS unsigned*)(F.lds + RING_OFF + F.wave * 8192);
    unsigned vq = 0xffffffffu, f1 = 0u, f2 = 0u;
#define CVT_FETCH() do { bool stop_ = stop_word >= 0 && f1 >= stop_target && (stop_word2 < 0 || f2 >= stop_target2); \
        vq = stop_ ? 0xffffffffu : __hip_atomic_fetch_add(ctl + qword, 1u, RLX_AGENT); \
        if (stop_word >= 0) f1 = __hip_atomic_load(ctl + stop_word, RLX_AGENT); if (stop_word2 >= 0) f2 = __hip_atomic_load(ctl + stop_word2, RLX_AGENT); } while (0)
    __syncthreads();
    if (F.tid == 0) { CVT_FETCH(); bq[0] = vq; CVT_FETCH(); }
    __syncthreads();
    CvtItem ca, cb; f32x4 ra[16], rb[16];
    const unsigned b0 = bq[0];
    if (b0 >= (unsigned)CVT_NBATCH) return;
    cvt_item(a, CVT_EARLY + (int)b0 * CVT_BATCH + F.wave, ca); CVT_LOAD(ca, ra);
    for (;;) {
        if (F.tid == 0) { bq[1] = vq; CVT_FETCH(); }
        __syncthreads();
        const unsigned b1 = bq[1]; const bool h1 = b1 < (unsigned)CVT_NBATCH;
        if (h1) { cvt_item(a, CVT_EARLY + (int)b1 * CVT_BATCH + F.wave, cb); CVT_LOAD(cb, rb); }
        CVT_STORE(ca, ra);
        if (!h1) break;
        if (F.tid == 0) { bq[0] = vq; CVT_FETCH(); }
        __syncthreads();
        const unsigned b2 = bq[0]; const bool h2 = b2 < (unsigned)CVT_NBATCH;
        if (h2) { cvt_item(a, CVT_EARLY + (int)b2 * CVT_BATCH + F.wave, ca); CVT_LOAD(ca, ra); }
        CVT_STORE(cb, rb);
        if (!h2) break;
    }
#undef CVT_FETCH
}
#ifndef CVT_PIPE
#define CVT_PIPE 0
#endif
__device__ __forceinline__ void cvt_run(const Args& a, Frame& F, int stop_word, unsigned stop_target, int stop_word2 = -1, unsigned stop_target2 = 0u, int qword = CW_QHEAD) {
    if (CVT_PIPE) cvt_stream(a, F, stop_word, stop_target, stop_word2, stop_target2, qword);
    else { while (cvt_batch(a, F, stop_word, stop_target, stop_word2, stop_target2, qword)) {} }
}
#undef CVT_LOAD
#undef CVT_STORE

constexpr int P2_STR = 3088;
constexpr int P2_WT = 0, P2_TILE = 16 * P2_STR, P2_PART = 32 * P2_STR, P2_WQKV = P2_PART + 8192, P2_CONV = P2_WQKV + 3 * 2048 * 4;
static_assert(P2_CONV + 6 * 512 * 4 <= RING_BYTES, "prep LDS map");
__device__ __forceinline__ float bflo(unsigned u) { return __uint_as_float(u << 16); }
__device__ __forceinline__ float bfhi(unsigned u) { return __uint_as_float(u & 0xffff0000u); }
__device__ __forceinline__ void p2_prep(const Args& a, Frame& F) {
    LAS unsigned char* L = F.lds + RING_OFF;
    const bf16* proj = (const bf16*)(a.ws + WS_PROJ);
    const float* conv_w = a.in[3]; const float* conv_b = a.in[4]; const float* wq = a.in[5]; const float* wk = a.in[6]; const float* wv = a.in[7];
    const float* wif_f = a.in[8]; const float* bif_f = a.in[9]; const float* wif_b = a.in[10]; const float* bif_b = a.in[11];
    bf16* xc = (bf16*)(a.ws + WS_XC); bf16* qm = (bf16*)(a.ws + WS_QM); bf16* km = (bf16*)(a.ws + WS_KM); bf16* vm = (bf16*)(a.ws + WS_VM);
    float* gI = (float*)(a.ws + WS_GI); float* gF = (float*)(a.ws + WS_GF); const float* rope = (const float*)(a.ws + WS_ROPE);
    bf16* qr = (bf16*)(a.ws + WS_QR); bf16* kr = (bf16*)(a.ws + WS_KR); bf16* vr = (bf16*)(a.ws + WS_VR);
    const int tid = F.tid, lane = F.lane, w = F.wave, c0 = 8 * lane, c16 = lane & 15, g = lane >> 4;
    LAS float* wqkv = (LAS float*)(L + P2_WQKV); LAS float* convl = (LAS float*)(L + P2_CONV); LAS float* part = (LAS float*)(L + P2_PART);
    __syncthreads();
    {
        const v4u* img = (const v4u*)(a.ws + WS_WT);
        v4u wi[7]; f32x4 wa[3], wb2[3], wc[3], cv[2];
#pragma unroll
        for (int i = 0; i < 7; ++i) { const int idx = tid + NTHR * i; wi[i] = idx < 16 * P2_STR / 16 ? img[idx] : (v4u){0u, 0u, 0u, 0u}; }
        wa[0] = ((const f32x4*)wq)[tid]; wb2[0] = ((const f32x4*)wk)[tid]; wc[0] = ((const f32x4*)wv)[tid];
        cv[0] = ((const f32x4*)conv_w)[tid]; cv[1] = tid < 128 ? ((const f32x4*)conv_w)[512 + tid] : ((const f32x4*)conv_b)[(tid - 128) & 127];
#pragma unroll
        for (int i = 0; i < 7; ++i) { const int idx = tid + NTHR * i; if (idx < 16 * P2_STR / 16) *(LAS v4u*)(L + P2_WT + idx * 16) = wi[i]; }
        ((LAS f32x4*)wqkv)[tid] = wa[0]; ((LAS f32x4*)wqkv)[512 + tid] = wb2[0] * 0.08838834764831845f; ((LAS f32x4*)wqkv)[1024 + tid] = wc[0];
        ((LAS f32x4*)convl)[tid] = cv[0];
        if (tid < 128) ((LAS f32x4*)convl)[512 + tid] = cv[1]; else if (tid < 256) ((LAS f32x4*)convl)[640 + tid - 128] = cv[1];
    }
    __syncthreads();
    float cw[5][8], cb[8];
#pragma unroll
    for (int t5 = 0; t5 < 5; ++t5) { const f32x4 x0 = *(const LAS f32x4*)(convl + t5 * 512 + c0), x1 = *(const LAS f32x4*)(convl + t5 * 512 + c0 + 4);
#pragma unroll
        for (int i = 0; i < 4; ++i) { cw[t5][i] = x0[i]; cw[t5][4 + i] = x1[i]; } }
    { const f32x4 x0 = *(const LAS f32x4*)(convl + 2560 + c0), x1 = *(const LAS f32x4*)(convl + 2560 + c0 + 4);
#pragma unroll
      for (int i = 0; i < 4; ++i) { cb[i] = x0[i]; cb[4 + i] = x1[i]; } }
    for (int tile = F.bx; tile < NT / 64; tile += F.G) {
        const int t0 = tile * 64, b = t0 / SEQ, s0 = t0 % SEQ;
        v4u xr[12];
#pragma unroll
        for (int i = 0; i < 12; ++i) { const int sx = s0 + 8 * w - 2 + i; xr[i] = (sx >= 0 && sx < SEQ) ? *(const v4u*)(proj + (size_t)(b * SEQ + sx) * DPROJ + c0) : (v4u){0u, 0u, 0u, 0u}; }
#pragma unroll
        for (int rnd = 0; rnd < 4; ++rnd) {
#pragma unroll
            for (int tt = 0; tt < 2; ++tt) {
                const int ti = 2 * rnd + tt;
                float xcv[8], xmv[8];
#pragma unroll
                for (int i = 0; i < 4; ++i) {
                    float a0 = cb[2 * i], a1 = cb[2 * i + 1];
#pragma unroll
                    for (int t5 = 0; t5 < 5; ++t5) { a0 += cw[t5][2 * i] * bflo(xr[ti + t5][i]); a1 += cw[t5][2 * i + 1] * bfhi(xr[ti + t5][i]); }
                    xcv[2 * i] = a0 * __builtin_amdgcn_rcpf(1.f + __expf(-a0)); xcv[2 * i + 1] = a1 * __builtin_amdgcn_rcpf(1.f + __expf(-a1));
                    xmv[2 * i] = bflo(xr[ti + 2][i]); xmv[2 * i + 1] = bfhi(xr[ti + 2][i]);
                }
                float qv[8], kv[8], vv[8];
#pragma unroll
                for (int grp = 0; grp < 2; ++grp) {
                    const LAS f32x4* wp = (const LAS f32x4*)(wqkv + (2 * lane + grp) * 16);
                    f32x4 q4 = {0.f, 0.f, 0.f, 0.f}, k4 = q4, v4 = q4;
#pragma unroll
                    for (int i = 0; i < 4; ++i) { q4 += wp[i] * xcv[4 * grp + i]; k4 += wp[512 + i] * xcv[4 * grp + i]; v4 += wp[1024 + i] * xmv[4 * grp + i]; }
#pragma unroll
                    for (int o = 0; o < 4; ++o) { qv[4 * grp + o] = q4[o]; kv[4 * grp + o] = k4[o]; vv[4 * grp + o] = v4[o]; }
                }
                const v4u xcp = {pk2(xcv[0], xcv[1]), pk2(xcv[2], xcv[3]), pk2(xcv[4], xcv[5]), pk2(xcv[6], xcv[7])};
                const v4u qp = {pk2(qv[0], qv[1]), pk2(qv[2], qv[3]), pk2(qv[4], qv[5]), pk2(qv[6], qv[7])};
                const v4u kp = {pk2(kv[0], kv[1]), pk2(kv[2], kv[3]), pk2(kv[4], kv[5]), pk2(kv[6], kv[7])};
                const v4u vp = {pk2(vv[0], vv[1]), pk2(vv[2], vv[3]), pk2(vv[4], vv[5]), pk2(vv[6], vv[7])};
                const size_t go = (size_t)(t0 + 8 * w + ti) * DML + c0;
                *(v4u*)(xc + go) = xcp; *(v4u*)(qm + go) = qp; *(v4u*)(km + go) = kp; *(v4u*)(vm + go) = vp;
                LAS unsigned char* tr = L + P2_TILE + (2 * w + tt) * P2_STR + c0 * 2;
                *(LAS v4u*)tr = qp; *(LAS v4u*)(tr + 1024) = kp; *(LAS v4u*)(tr + 2048) = vp;
            }
            __syncthreads();
            f32x4 D = {0.f, 0.f, 0.f, 0.f};
#pragma unroll
            for (int kk = 0; kk < 6; ++kk) { const int ks = 6 * w + kk;
                const bf16x8 A = *(const LAS bf16x8*)(L + P2_TILE + c16 * P2_STR + (32 * ks + 8 * g) * 2);
                const bf16x8 B = *(const LAS bf16x8*)(L + P2_WT + c16 * P2_STR + (32 * ks + 8 * g) * 2);
                D = __builtin_amdgcn_mfma_f32_16x16x32_bf16(A, B, D, 0, 0, 0); }
#pragma unroll
            for (int r = 0; r < 4; ++r) part[w * 256 + (4 * g + r) * 16 + c16] = D[r];
            __syncthreads();
            if (tid < 256) {
                const int row = tid >> 4, n = tid & 15;
                float sm = 0.f;
#pragma unroll
                for (int ww = 0; ww < 8; ++ww) sm += part[ww * 256 + tid];
                const int dirn = n >> 3, j = n & 7, hh = j & 3;
                sm += dirn ? bif_b[j] : bif_f[j];
                const int sx = s0 + 8 * (row >> 1) + 2 * rnd + (row & 1);
                const size_t off = ((size_t)(dirn * NB + b) * MH + hh) * SEQ + sx;
                if (j < 4) gI[off] = sm; else gF[off] = logsigf(sm);
            }
        }
    }
}

typedef short s16x4 __attribute__((ext_vector_type(4)));
typedef short v4i16_t __attribute__((ext_vector_type(4)));
constexpr int ML_STR = 288, ML_TILE = 64 * ML_STR, ML_WSTR = 144;
constexpr int ML_Q = 0, ML_K = ML_TILE, ML_V = 2 * ML_TILE, ML_W = 3 * ML_TILE, ML_PSUM = ML_W + 64 * ML_WSTR, ML_QN = ML_PSUM + 1024, ML_NBUF = ML_QN + 256, ML_SCR = ML_NBUF + 1024;
static_assert(ML_SCR + 8 * 1024 <= RING_BYTES, "mlstm LDS map");
__device__ __forceinline__ unsigned cvtpk2(float lo, float hi) { unsigned r; asm volatile("v_cvt_pk_bf16_f32 %0, %1, %2" : "=v"(r) : "v"(lo), "v"(hi)); return r; }
__device__ __forceinline__ s16x4 trr(LAS unsigned char* p) { return __builtin_bit_cast(s16x4, __builtin_amdgcn_ds_read_tr16_b64_v4i16((LAS v4i16_t*)p)); }
__device__ __forceinline__ bf16x8 cat8(s16x4 a, s16x4 b) { return (bf16x8){a[0], a[1], a[2], a[3], b[0], b[1], b[2], b[3]}; }
__device__ __forceinline__ float scan_add(float x, int lane) {
#pragma unroll
    for (int o = 1; o < 64; o <<= 1) { const float v = __shfl_up(x, o); if (lane >= o) x += v; }
    return x;
}
__device__ __forceinline__ float scan_max(float x, int lane) {
#pragma unroll
    for (int o = 1; o < 64; o <<= 1) { const float v = __shfl_up(x, o); if (lane >= o) x = fmaxf(x, v); }
    return x;
}
constexpr int ML_SCAL = ML_SCR + 8 * 1024;
constexpr int ML_CH = ML_SCAL + 4 * 2048 * 4;
static_assert(ML_CH + 4 * 32 * 4 <= RING_BYTES, "mlstm LDS map 2");
template <int MLV>
__device__ __forceinline__ void mlstm_item(const Args& a, Frame& F, int item) {
    const int dir = item & 1, h = (item >> 1) & 3, b = item >> 3;
    LAS unsigned char* L = F.lds + RING_OFF;
    const int tid = F.tid, w = F.wave; int lane = F.lane, c16 = lane & 15, g = lane >> 4;
    const bf16* qm = (const bf16*)(a.ws + WS_QM); const bf16* km = (const bf16*)(a.ws + WS_KM); const bf16* vm = (const bf16*)(a.ws + WS_VM);
    const float* gi = (const float*)(a.ws + WS_GI) + ((size_t)(dir * NB + b) * MH + h) * SEQ;
    const float* gf = (const float*)(a.ws + WS_GF) + ((size_t)(dir * NB + b) * MH + h) * SEQ;
    bf16* hout = (bf16*)(a.ws + WS_HFB) + (size_t)dir * NT * DML;
    LAS float* scr = (LAS float*)(L + ML_SCR + w * 1024);
    LAS float* Psum = (LAS float*)(L + ML_PSUM); LAS float* qn = (LAS float*)(L + ML_QN); LAS float* nbuf = (LAS float*)(L + ML_NBUF);
    LAS float* s_isc = (LAS float*)(L + ML_SCAL); LAS float* s_rt = s_isc + 2048; LAS float* s_u = s_isc + 4096; LAS float* s_emt = s_isc + 6144;
    LAS float* c_decay = (LAS float*)(L + ML_CH); LAS float* c_f = c_decay + 32; LAS float* c_cref = c_decay + 64; LAS float* c_gtot = c_decay + 96;
    int srow = tid >> 3, spart = tid & 7;
#define hoff ((size_t)h * MDH + 16 * spart)
    f32x4 Cacc[8];
#pragma unroll
    for (int te = 0; te < 8; ++te) Cacc[te] = (f32x4){0.f, 0.f, 0.f, 0.f};
    v4u rq[2], rk[2], rv[2];
    __syncthreads();
    { const int pos = dir ? (SEQ - 1 - srow) : srow; const size_t ro = (size_t)(b * SEQ + pos) * DML + hoff;
      rq[0] = *(const v4u*)(qm + ro); rq[1] = *(const v4u*)(qm + ro + 8); rk[0] = *(const v4u*)(km + ro); rk[1] = *(const v4u*)(km + ro + 8); rv[0] = *(const v4u*)(vm + ro); rv[1] = *(const v4u*)(vm + ro + 8); }
#pragma unroll
    for (int q = 0; q < 4; ++q) {
        const int cc = 4 * w + q, j = cc * 64 + lane, pos = dir ? (SEQ - 1 - j) : j;
        const float ig = gi[pos], lf = gf[pos];
        const float bb = scan_add(lf, lane), x = ig - bb, pm = scan_max(x, lane);
        s_emt[j] = bb; s_u[j] = x; s_rt[j] = pm;
        if (lane == 63) { c_cref[cc] = pm; c_gtot[cc] = bb; }
    }
    if (tid < 256) nbuf[tid] = 0.f;
    __syncthreads();
    {
        float m_prev = 0.f, mp0 = 0.f, mp1 = 0.f, mp2 = 0.f, mp3 = 0.f;
#pragma unroll 1
        for (int cc = 0; cc < 32; ++cc) {
            const float cr = c_cref[cc], gt = c_gtot[cc];
            const int q = cc - 4 * w;
            mp0 = (q == 0) ? m_prev : mp0; mp1 = (q == 1) ? m_prev : mp1; mp2 = (q == 2) ? m_prev : mp2; mp3 = (q == 3) ? m_prev : mp3;
            m_prev = gt + fmaxf(m_prev, cr);
        }
        const float mp[4] = {mp0, mp1, mp2, mp3};
#pragma unroll
        for (int q = 0; q < 4; ++q) {
            const int cc = 4 * w + q, j = cc * 64 + lane;
            const float bb = s_emt[j], x = s_u[j], pm = s_rt[j], cr = c_cref[cc];
            const float mx = fmaxf(mp[q], pm);
            s_isc[j] = expf(mp[q] - mx); s_rt[j] = expf(cr - mx); s_u[j] = expf(x - cr); s_emt[j] = expf(-(bb + mx));
            if (lane == 0) { const float M = fmaxf(mp[q], cr); c_decay[cc] = expf(mp[q] - M); c_f[cc] = expf(cr - M); }
        }
    }
    __syncthreads();
#define ML_STAGE(ccn) do { const float us = s_u[(ccn) * 64 + srow]; \
        _Pragma("unroll") for (int i = 0; i < 2; ++i) { \
            *(LAS v4u*)(L + ML_Q + srow * ML_STR + spart * 32 + 16 * i) = rq[i]; *(LAS v4u*)(L + ML_V + srow * ML_STR + spart * 32 + 16 * i) = rv[i]; \
            v4u o; _Pragma("unroll") for (int j = 0; j < 4; ++j) o[j] = cvtpk2(__uint_as_float(rk[i][j] << 16) * us, __uint_as_float(rk[i][j] & 0xffff0000u) * us); \
            *(LAS v4u*)(L + ML_K + srow * ML_STR + spart * 32 + 16 * i) = o; } } while (0)
    ML_STAGE(0);
    { const int j = 64 + srow, pos = dir ? (SEQ - 1 - j) : j; const size_t ro = (size_t)(b * SEQ + pos) * DML + hoff;
      rq[0] = *(const v4u*)(qm + ro); rq[1] = *(const v4u*)(qm + ro + 8); rk[0] = *(const v4u*)(km + ro); rk[1] = *(const v4u*)(km + ro + 8); rv[0] = *(const v4u*)(vm + ro); rv[1] = *(const v4u*)(vm + ro + 8); }
    __syncthreads();
    for (int cc = 0; cc < SEQ / 64; ++cc) {
        asm volatile("" : "+v"(lane), "+v"(c16), "+v"(g), "+v"(srow), "+v"(spart));
        const int p = cc & 1;
        const bool more = (cc + 1 < SEQ / 64);
        const float decay = c_decay[cc], ff = c_f[cc];
        f32x4 O[4];
#pragma unroll
        for (int ti = 0; ti < 4; ++ti) O[ti] = (f32x4){0.f, 0.f, 0.f, 0.f};
        if constexpr (!(MLV & 8)) {
            bf16x8 Cb[4];
#pragma unroll
            for (int ks = 0; ks < 4; ++ks) { v4u t; t.x = cvtpk2(Cacc[2 * ks][0], Cacc[2 * ks][1]); t.y = cvtpk2(Cacc[2 * ks][2], Cacc[2 * ks][3]); t.z = cvtpk2(Cacc[2 * ks + 1][0], Cacc[2 * ks + 1][1]); t.w = cvtpk2(Cacc[2 * ks + 1][2], Cacc[2 * ks + 1][3]); Cb[ks] = __builtin_bit_cast(bf16x8, t); }
            f32x4 IV[4];
#pragma unroll
            for (int kh2 = 0; kh2 < 2; ++kh2) {
                bf16x8 QA[4][2];
#pragma unroll
                for (int ti = 0; ti < 4; ++ti)
#pragma unroll
                    for (int k2 = 0; k2 < 2; ++k2) QA[ti][k2] = *(const LAS bf16x8*)(L + ML_Q + (16 * ti + c16) * ML_STR + (32 * (2 * kh2 + k2) + 8 * g) * 2);
                __builtin_amdgcn_sched_barrier(0);
#pragma unroll
                for (int k2 = 0; k2 < 2; ++k2)
#pragma unroll
                    for (int ti = 0; ti < 4; ++ti) O[ti] = __builtin_amdgcn_mfma_f32_16x16x32_bf16(QA[ti][k2], Cb[2 * kh2 + k2], O[ti], 0, 0, 0);
                __builtin_amdgcn_sched_barrier(0);
            }
#pragma unroll
            for (int ti = 0; ti < 4; ++ti) IV[ti] = *(const LAS f32x4*)(s_isc + cc * 64 + 16 * ti + 4 * g);
#pragma unroll
            for (int ti = 0; ti < 4; ++ti) O[ti] = O[ti] * IV[ti];
            __builtin_amdgcn_sched_barrier(0);
        }
        if constexpr (!(MLV & 2)) {
            const int ti = w >> 1, t = 16 * ti + c16; const float rtv = s_rt[cc * 64 + t];
            const int si0 = 2 * (w & 1);
            bf16x8 KA[2][4], QB[4];
#pragma unroll
            for (int ks = 0; ks < 4; ++ks) { QB[ks] = *(const LAS bf16x8*)(L + ML_Q + (16 * ti + c16) * ML_STR + (32 * ks + 8 * g) * 2);
#pragma unroll
                for (int sj = 0; sj < 2; ++sj) KA[sj][ks] = *(const LAS bf16x8*)(L + ML_K + (16 * (si0 + sj) + c16) * ML_STR + (32 * ks + 8 * g) * 2); }
            __builtin_amdgcn_sched_barrier(0);
            f32x4 Dt[2] = {{0.f, 0.f, 0.f, 0.f}, {0.f, 0.f, 0.f, 0.f}};
#pragma unroll
            for (int ks = 0; ks < 4; ++ks)
#pragma unroll
                for (int sj = 0; sj < 2; ++sj) Dt[sj] = __builtin_amdgcn_mfma_f32_16x16x32_bf16(KA[sj][ks], QB[ks], Dt[sj], 0, 0, 0);
#pragma unroll
            for (int sj = 0; sj < 2; ++sj) {
                const int si = si0 + sj;
                f32x4 D = Dt[sj]; float ps = 0.f;
#pragma unroll
                for (int r = 0; r < 4; ++r) { const int sx = 16 * si + 4 * g + r; const float v = (si <= ti && sx <= t) ? D[r] : 0.f; D[r] = v; ps += v; }
                *(LAS unsigned long long*)(L + ML_W + t * ML_WSTR + (16 * si + 4 * g) * 2) = (unsigned long long)cvtpk2(D[0] * rtv, D[1] * rtv) | ((unsigned long long)cvtpk2(D[2] * rtv, D[3] * rtv) << 32);
                ps += __shfl_xor(ps, 16); ps += __shfl_xor(ps, 32);
                if (g == 0) Psum[t * 4 + si] = ps;
            }
            __builtin_amdgcn_sched_barrier(0);
        }
        {
            const LAS unsigned char* qp = L + ML_Q + srow * ML_STR + spart * 32;
            const v4u q0 = *(const LAS v4u*)qp, q1 = *(const LAS v4u*)(qp + 16);
            const LAS f32x4* np = (const LAS f32x4*)(nbuf + p * 128 + 16 * spart);
            const f32x4 n0 = np[0], n1 = np[1], n2 = np[2], n3 = np[3];
            float d = 0.f;
            d += __uint_as_float(q0[0] << 16) * n0[0] + __uint_as_float(q0[0] & 0xffff0000u) * n0[1] + __uint_as_float(q0[1] << 16) * n0[2] + __uint_as_float(q0[1] & 0xffff0000u) * n0[3];
            d += __uint_as_float(q0[2] << 16) * n1[0] + __uint_as_float(q0[2] & 0xffff0000u) * n1[1] + __uint_as_float(q0[3] << 16) * n1[2] + __uint_as_float(q0[3] & 0xffff0000u) * n1[3];
            d += __uint_as_float(q1[0] << 16) * n2[0] + __uint_as_float(q1[0] & 0xffff0000u) * n2[1] + __uint_as_float(q1[1] << 16) * n2[2] + __uint_as_float(q1[1] & 0xffff0000u) * n2[3];
            d += __uint_as_float(q1[2] << 16) * n3[0] + __uint_as_float(q1[2] & 0xffff0000u) * n3[1] + __uint_as_float(q1[3] << 16) * n3[2] + __uint_as_float(q1[3] & 0xffff0000u) * n3[3];
            d += __shfl_xor(d, 1); d += __shfl_xor(d, 2); d += __shfl_xor(d, 4);
            if (spart == 0) qn[srow] = d;
        }
        bf16x8 Vf[2];
        {
            const int q4 = c16 >> 2, p4 = c16 & 3;
#pragma unroll
            for (int ks = 0; ks < 2; ++ks) {
                LAS unsigned char* vp = L + ML_V + (32 * ks + 4 * g + q4) * ML_STR + (16 * w + 4 * p4) * 2;
                Vf[ks] = cat8(trr(vp), trr(vp + 16 * ML_STR));
            }
            f32x4 dn = {0.f, 0.f, 0.f, 0.f};
            { unsigned one2 = 0x3F803F80u; asm volatile("" : "+v"(one2)); const bf16x8 ones = __builtin_bit_cast(bf16x8, (v4u){one2, one2, one2, one2});
              LAS unsigned char* kw = L + ML_K + (4 * g + q4) * ML_STR + (32 * (w >> 1) + 8 * p4 + 4 * (w & 1)) * 2;
              const bf16x8 A0 = cat8(trr(kw), trr(kw + 16 * ML_STR)), A1 = cat8(trr(kw + 32 * ML_STR), trr(kw + 48 * ML_STR));
              dn = __builtin_amdgcn_mfma_f32_16x16x32_bf16(A0, ones, dn, 0, 0, 0); dn = __builtin_amdgcn_mfma_f32_16x16x32_bf16(A1, ones, dn, 0, 0, 0); }
            if constexpr (!(MLV & 4))
#pragma unroll
            for (int th = 0; th < 4; ++th) {
                bf16x8 KT[2][2];
#pragma unroll
                for (int t2 = 0; t2 < 2; ++t2)
#pragma unroll
                    for (int ks = 0; ks < 2; ++ks) { const int te = 2 * th + t2; LAS unsigned char* kp = L + ML_K + (32 * ks + 4 * g + q4) * ML_STR + (32 * (te >> 1) + 8 * p4 + 4 * (te & 1)) * 2; KT[t2][ks] = cat8(trr(kp), trr(kp + 16 * ML_STR)); }
                __builtin_amdgcn_sched_barrier(0);
                f32x4 dC[2];
#pragma unroll
                for (int t2 = 0; t2 < 2; ++t2) dC[t2] = __builtin_amdgcn_mfma_f32_16x16x32_bf16(KT[t2][0], Vf[0], (f32x4){0.f, 0.f, 0.f, 0.f}, 0, 0, 0);
#pragma unroll
                for (int t2 = 0; t2 < 2; ++t2) dC[t2] = __builtin_amdgcn_mfma_f32_16x16x32_bf16(KT[t2][1], Vf[1], dC[t2], 0, 0, 0);
#pragma unroll
                for (int t2 = 0; t2 < 2; ++t2) Cacc[2 * th + t2] = Cacc[2 * th + t2] * decay + dC[t2] * ff;
            }
            __builtin_amdgcn_sched_barrier(0);
            if (c16 == 0) { const int ne = 32 * (w >> 1) + 8 * g + 4 * (w & 1); const f32x4 nold = *(const LAS f32x4*)(nbuf + p * 128 + ne); *(LAS f32x4*)(nbuf + (p ^ 1) * 128 + ne) = nold * decay + dn * ff; }
        }
        __syncthreads();
        {
            bf16x8 WA[4][2];
#pragma unroll
            for (int ti = 0; ti < 4; ++ti)
#pragma unroll
                for (int ks = 0; ks < 2; ++ks) if (ks <= (ti >> 1)) { const LAS unsigned char* wp = L + ML_W + (16 * ti + c16) * ML_WSTR + (32 * ks + 4 * g) * 2; WA[ti][ks] = cat8(*(const LAS s16x4*)wp, *(const LAS s16x4*)(wp + 32)); }
            __builtin_amdgcn_sched_barrier(0);
#pragma unroll
            for (int ks = 0; ks < 2; ++ks)
#pragma unroll
                for (int ti = 0; ti < 4; ++ti) if (ks <= (ti >> 1)) O[ti] = __builtin_amdgcn_mfma_f32_16x16x32_bf16(WA[ti][ks], Vf[ks], O[ti], 0, 0, 0);
        }
        {
            const f32x4 pv = *(const LAS f32x4*)(Psum + 4 * lane);
            const float den = s_rt[cc * 64 + lane] * ((pv[0] + pv[1]) + (pv[2] + pv[3])) + s_isc[cc * 64 + lane] * qn[lane];
            scr[lane] = 1.f / fmaxf(fabsf(den), s_emt[cc * 64 + lane]);
#pragma unroll
            for (int ti = 0; ti < 4; ++ti) {
                const f32x4 rd = *(const LAS f32x4*)(scr + 16 * ti + 4 * g);
#pragma unroll
                for (int r = 0; r < 4; ++r) { const int j = cc * 64 + 16 * ti + 4 * g + r, pos = dir ? (SEQ - 1 - j) : j;
                    if constexpr (MLV & 1) { asm volatile("" :: "v"(O[ti][r] * rd[r])); } else hout[(size_t)(b * SEQ + pos) * DML + h * MDH + 16 * w + c16] = (bf16)f2bf(O[ti][r] * rd[r]); }
            }
        }
        if (more) { ML_STAGE(cc + 1); }
        if (cc + 2 < SEQ / 64) { const int j = (cc + 2) * 64 + srow, pos = dir ? (SEQ - 1 - j) : j; const size_t ro = (size_t)(b * SEQ + pos) * DML + hoff;
            rq[0] = *(const v4u*)(qm + ro); rq[1] = *(const v4u*)(qm + ro + 8); rk[0] = *(const v4u*)(km + ro); rk[1] = *(const v4u*)(km + ro + 8); rv[0] = *(const v4u*)(vm + ro); rv[1] = *(const v4u*)(vm + ro + 8); }
        __syncthreads();
    }
#undef ML_STAGE
#undef hoff
}
__device__ __forceinline__ void p3_mlstm(const Args& a, Frame& F) {
    bool any = false;
    for (int item = F.bx; item < NB * MH * 2; item += F.G) { mlstm_item<0>(a, F, item); any = true;
        __syncthreads();
        if (F.tid == 0) __hip_atomic_fetch_add((gu32*)(a.ws + WS_CTL) + CW_MDONE, 1u, RLX_AGENT); }
    if (any && F.G == 256) cvt_run(a, F, CW_MDONE, (unsigned)(NB * MH * 2), CW_ADONE, (unsigned)NATT);
    __syncthreads();
}
typedef float f32x16 __attribute__((ext_vector_type(16)));
__device__ __forceinline__ unsigned cvtpk(float lo, float hi) { unsigned r; asm volatile("v_cvt_pk_bf16_f32 %0, %1, %2" : "=v"(r) : "v"(lo), "v"(hi)); return r; }
#ifndef ATT_VAR
#define ATT_VAR 0
#endif
template <int VAR>
__device__ __forceinline__ void attn_task(const bf16* __restrict__ Qa, const bf16* __restrict__ Ka, const bf16* __restrict__ Va, bf16* __restrict__ opart, float* __restrict__ ostat,
                                          int task, LAS unsigned char* vl  , int lane) {
    const int bh = task / 192, rem = task % 192, br = rem >> 6, tt = rem & 63;
    const int dsh = 2 * br, dil = 1 << dsh;
    const int Lb = 64 >> dsh;
    const int r = tt / Lb, gq = tt % Lb;
    const int r32 = lane & 31, h = lane >> 5;
    const size_t base = (size_t)bh * SEQ * ADH;
    const int qtok = r + dil * (32 * gq + r32);
    bf16x8 qf[4];
#pragma unroll
    for (int sx = 0; sx < 4; ++sx) qf[sx] = *(const bf16x8*)(Qa + base + (size_t)qtok * ADH + 16 * sx + 8 * h);
    f32x16 sacc[5]; v4u vreg[5][4]; bool valid[5];
#pragma unroll
    for (int kb = 0; kb < 5; ++kb) {
        const int jb = gq - 2 + kb; valid[kb] = (jb >= 0 && jb < Lb);
#pragma unroll
        for (int i = 0; i < 16; ++i) sacc[kb][i] = 0.f;
        if (valid[kb]) {
            const int ktok = r + dil * (32 * jb + r32);
            bf16x8 kf[4];
#pragma unroll
            for (int sx = 0; sx < 4; ++sx) kf[sx] = *(const bf16x8*)(Ka + base + (size_t)ktok * ADH + 16 * sx + 8 * h);
#pragma unroll
            for (int i = 0; i < 4; ++i) { const int vtok = r + dil * (32 * jb + 8 * i + (lane >> 3)); if constexpr (!(VAR & 1)) vreg[kb][i] = *(const v4u*)(Va + base + (size_t)vtok * ADH + 8 * (lane & 7)); else vreg[kb][i] = (v4u){0u, 0u, 0u, 0u}; }
#pragma unroll
            for (int sx = 0; sx < 4; ++sx) sacc[kb] = __builtin_amdgcn_mfma_f32_32x32x16_bf16(kf[sx], qf[sx], sacc[kb], 0, 0, 0);
        }
    }
    float m = -INFINITY;
#pragma unroll
    for (int kb = 0; kb < 5; ++kb) if (valid[kb]) {
#pragma unroll
        for (int rg = 0; rg < 16; ++rg) {
            const int kk = (rg & 3) + 8 * (rg >> 2) + 4 * h;
            float sv = sacc[kb][rg];
            if (kb == 0) sv = (kk >= r32) ? sv : -INFINITY;
            if (kb == 4) sv = (kk <= r32) ? sv : -INFINITY;
            sacc[kb][rg] = sv; m = fmaxf(m, sv);
        }
    }
    m = fmaxf(m, __shfl_xor(m, 32));
    float l = 0.f; const float mb = m * 1.4426950408889634f;
    bf16x8 pf[5][2];
#pragma unroll
    for (int kb = 0; kb < 5; ++kb) if (valid[kb]) {
        float p[16];
#pragma unroll
        for (int rg = 0; rg < 16; ++rg) { if constexpr (VAR & 2) p[rg] = sacc[kb][rg] * 1.4426950408889634f - mb; else p[rg] = __builtin_amdgcn_exp2f(sacc[kb][rg] * 1.4426950408889634f - mb); l += p[rg]; }
#pragma unroll
        for (int sp = 0; sp < 2; ++sp) { v4u w; w.x = cvtpk(p[8 * sp], p[8 * sp + 1]); w.y = cvtpk(p[8 * sp + 2], p[8 * sp + 3]); w.z = cvtpk(p[8 * sp + 4], p[8 * sp + 5]); w.w = cvtpk(p[8 * sp + 6], p[8 * sp + 7]); pf[kb][sp] = __builtin_bit_cast(bf16x8, w); }
    }
    l += __shfl_xor(l, 32);
    f32x16 o0, o1;
#pragma unroll
    for (int i = 0; i < 16; ++i) { o0[i] = 0.f; o1[i] = 0.f; }
    const int row0 = lane >> 3, ch16 = lane & 7;
    const int woff = row0 * 128 + (((ch16 >> 1) ^ (((row0 >> 1) & 1) << 1)) * 32) + (ch16 & 1) * 16;
    const int q4 = (lane & 15) >> 2, sw = (q4 >> 1) & 1, dhalf = (lane >> 4) & 1;
    const int rb = (4 * h + q4) * 128 + dhalf * 32 + (lane & 3) * 8;
    const int rb0 = rb + (sw ? 64 : 0), rb1 = rb + (sw ? 0 : 64);
#pragma unroll
    for (int kb = 0; kb < 5; ++kb) if (valid[kb] && !(VAR & 1)) {
#pragma unroll
        for (int i = 0; i < 4; ++i) *(LAS v4u*)(vl + woff + 1024 * i) = vreg[kb][i];
#pragma unroll
        for (int sp = 0; sp < 2; ++sp) {
            const s16x4 a00 = __builtin_bit_cast(s16x4, __builtin_amdgcn_ds_read_tr16_b64_v4i16((LAS v4i16_t*)(vl + rb0 + (16 * sp) * 128)));
            const s16x4 a01 = __builtin_bit_cast(s16x4, __builtin_amdgcn_ds_read_tr16_b64_v4i16((LAS v4i16_t*)(vl + rb0 + (16 * sp + 8) * 128)));
            const s16x4 a10 = __builtin_bit_cast(s16x4, __builtin_amdgcn_ds_read_tr16_b64_v4i16((LAS v4i16_t*)(vl + rb1 + (16 * sp) * 128)));
            const s16x4 a11 = __builtin_bit_cast(s16x4, __builtin_amdgcn_ds_read_tr16_b64_v4i16((LAS v4i16_t*)(vl + rb1 + (16 * sp + 8) * 128)));
            const bf16x8 A0 = {a00[0], a00[1], a00[2], a00[3], a01[0], a01[1], a01[2], a01[3]};
            const bf16x8 A1 = {a10[0], a10[1], a10[2], a10[3], a11[0], a11[1], a11[2], a11[3]};
            o0 = __builtin_amdgcn_mfma_f32_32x32x16_bf16(A0, pf[kb][sp], o0, 0, 0, 0);
            o1 = __builtin_amdgcn_mfma_f32_32x32x16_bf16(A1, pf[kb][sp], o1, 0, 0, 0);
        }
        asm volatile("s_waitcnt lgkmcnt(0)" ::: "memory");
    }
    if constexpr (VAR & 1) { asm volatile("" :: "v"(pf[0][0]), "v"(pf[1][1]), "v"(pf[2][0]), "v"(pf[3][1]), "v"(pf[4][0])); }
    if constexpr (VAR & 4) { asm volatile("" :: "v"(o0), "v"(o1), "v"(l), "v"(m)); return; }
    const float inv = 1.f / l;
    const int b = bh / AH, hh = bh % AH;
    const size_t tok = (size_t)b * SEQ + qtok;
    {
        LAS unsigned char* ol = vl + r32 * 144 + 8 * h;
#pragma unroll
        for (int g4 = 0; g4 < 4; ++g4) {
            *(LAS unsigned long long*)(ol + 16 * g4) = (unsigned long long)cvtpk(o0[4 * g4] * inv, o0[4 * g4 + 1] * inv) | ((unsigned long long)cvtpk(o0[4 * g4 + 2] * inv, o0[4 * g4 + 3] * inv) << 32);
            *(LAS unsigned long long*)(ol + 64 + 16 * g4) = (unsigned long long)cvtpk(o1[4 * g4] * inv, o1[4 * g4 + 1] * inv) | ((unsigned long long)cvtpk(o1[4 * g4 + 2] * inv, o1[4 * g4 + 3] * inv) << 32);
        }
        const int qrow = lane >> 1, half = lane & 1;
        const int qtok2 = r + dil * (32 * gq + qrow);
        bf16* op = opart + ((size_t)br * NT + (size_t)b * SEQ + qtok2) * DAT + hh * ADH + 32 * half;
#pragma unroll
        for (int i = 0; i < 4; ++i) *(v4u*)(op + 8 * i) = *(const LAS v4u*)(vl + qrow * 144 + 64 * half + 16 * i);
        asm volatile("s_waitcnt lgkmcnt(0)" ::: "memory");
    }
    if (h == 0) { float* st = ostat + (((size_t)br * NT + tok) * AH + hh) * 2; st[0] = m; st[1] = l; }
}
constexpr int AT_K = 0, AT_V = 49152, AT_O = 98304, AT_OSZ = 4608;
static_assert(AT_O + 8 * AT_OSZ <= RING_BYTES, "attention LDS map");
struct AtGeo { int bh, br, dsh, Lb, jbs, nblk, resb, gq0, jsh, jmk; };
__device__ __forceinline__ AtGeo at_geo(int it) {
    AtGeo g; g.bh = it / 24; const int rem = it % 24; g.br = rem >> 3; const int sub = rem & 7; g.dsh = 2 * g.br; g.Lb = 64 >> g.dsh;
    g.gq0 = (g.br == 0) ? 8 * sub : (g.br == 1 ? 8 * (sub & 1) : 0);
    g.resb = (g.br == 0) ? 0 : (g.br == 1 ? (sub >> 1) : 2 * sub);
    g.jsh = (g.br == 2) ? 2 : 4; g.jmk = (g.br == 2) ? 3 : 15;
    const int lo = g.gq0 - 2 < 0 ? 0 : g.gq0 - 2, hi = g.gq0 + 10 > g.Lb ? g.Lb : g.gq0 + 10;
    g.jbs = (g.br == 2) ? 0 : lo; g.nblk = (g.br == 2) ? 8 : hi - lo;
    return g;
}
__device__ __forceinline__ void at_load_q(const AtGeo& g, const bf16* __restrict__ Qa, int w, int lane, bf16x8 (&qf)[4]) {
    const int r32 = lane & 31, h = lane >> 5;
    const int qtok = g.resb + (w >> g.jsh) + ((32 * (g.gq0 + (w & g.jmk)) + r32) << g.dsh);
    const bf16* qp = Qa + (size_t)g.bh * SEQ * ADH + (size_t)qtok * ADH + 8 * h;
#pragma unroll
    for (int sx = 0; sx < 4; ++sx) qf[sx] = *(const bf16x8*)(qp + 16 * sx);
}
__device__ __forceinline__ void at_load_kv(const AtGeo& g, const bf16* __restrict__ Ka, const bf16* __restrict__ Va, int tid, v4u (&kr)[6], v4u (&vr)[6]) {
    const size_t base = (size_t)g.bh * SEQ * ADH;
    const int rrow = tid >> 3, ch = tid & 7, last = 32 * g.nblk - 1;
#pragma unroll
    for (int i = 0; i < 6; ++i) { int row = rrow + 64 * i; row = row > last ? last : row;
        const int sl = row >> 5;
        const int tok = g.resb + (sl >> g.jsh) + ((32 * (g.jbs + (sl & g.jmk)) + (row & 31)) << g.dsh);
        const size_t off = base + (size_t)tok * ADH + 8 * ch; kr[i] = *(const v4u*)(Ka + off); vr[i] = *(const v4u*)(Va + off); }
}
__device__ __forceinline__ void at_stage(LAS unsigned char* L, int tid, const v4u (&kr)[6], const v4u (&vr)[6]) {
    const int rrow = tid >> 3, ch = tid & 7, r32 = rrow & 31;
    LAS unsigned char* kp = L + AT_K + rrow * 128 + ((ch ^ ((rrow >> 1) & 7)) << 4);
    LAS unsigned char* vp = L + AT_V + (rrow >> 5) * 4096 + r32 * 128 + (((ch >> 1) ^ (((r32 >> 1) & 1) << 1)) * 32) + (ch & 1) * 16;
#pragma unroll
    for (int i = 0; i < 6; ++i) { *(LAS v4u*)(kp + 8192 * i) = kr[i]; *(LAS v4u*)(vp + 8192 * i) = vr[i]; }
}
__device__ __forceinline__ void at_compute(const AtGeo& g, const AtGeo& gn, const bf16* __restrict__ Qa, LAS unsigned char* L, bf16x8 (&qf)[4], bf16* __restrict__ opart, float* __restrict__ ostat, int w, int lane) {
    const int r32 = lane & 31, h = lane >> 5;
    const int res = g.resb + (w >> g.jsh), gq = g.gq0 + (w & g.jmk);
    f32x16 sacc[5]; bool valid[5]; int slot[5];
#pragma unroll
    for (int kb = 0; kb < 5; ++kb) {
        const int jb = gq - 2 + kb; valid[kb] = (jb >= 0 && jb < g.Lb);
        const int jbc = jb < 0 ? 0 : (jb >= g.Lb ? g.Lb - 1 : jb);
        slot[kb] = ((w >> g.jsh) << 2) + jbc - g.jbs;
#pragma unroll
        for (int i = 0; i < 16; ++i) sacc[kb][i] = 0.f;
        const LAS unsigned char* kp = L + AT_K + slot[kb] * 4096 + r32 * 128;
#pragma unroll
        for (int sx = 0; sx < 4; ++sx) { const bf16x8 kf = *(const LAS bf16x8*)(kp + (((2 * sx + h) ^ ((r32 >> 1) & 7)) << 4)); sacc[kb] = __builtin_amdgcn_mfma_f32_32x32x16_bf16(kf, qf[sx], sacc[kb], 0, 0, 0); }
    }
    __builtin_amdgcn_sched_barrier(0);
    at_load_q(gn, Qa, w, lane, qf);
    __builtin_amdgcn_sched_barrier(0);
    float m = -INFINITY;
#pragma unroll
    for (int kb = 0; kb < 5; ++kb) {
#pragma unroll
        for (int rg = 0; rg < 16; ++rg) {
            const int kk = (rg & 3) + 8 * (rg >> 2) + 4 * h;
            float sv = valid[kb] ? sacc[kb][rg] : -INFINITY;
            if (kb == 0) sv = (kk >= r32) ? sv : -INFINITY;
            if (kb == 4) sv = (kk <= r32) ? sv : -INFINITY;
            sacc[kb][rg] = sv; m = fmaxf(m, sv);
        }
    }
    m = fmaxf(m, __shfl_xor(m, 32));
    float l = 0.f; const float mb = m * 1.4426950408889634f;
    bf16x8 pf[5][2];
#pragma unroll
    for (int kb = 0; kb < 5; ++kb) {
        float p[16];
#pragma unroll
        for (int rg = 0; rg < 16; ++rg) { p[rg] = __builtin_amdgcn_exp2f(sacc[kb][rg] * 1.4426950408889634f - mb); l += p[rg]; }
#pragma unroll
        for (int sp = 0; sp < 2; ++sp) { v4u wv; wv.x = cvtpk(p[8 * sp], p[8 * sp + 1]); wv.y = cvtpk(p[8 * sp + 2], p[8 * sp + 3]); wv.z = cvtpk(p[8 * sp + 4], p[8 * sp + 5]); wv.w = cvtpk(p[8 * sp + 6], p[8 * sp + 7]); pf[kb][sp] = __builtin_bit_cast(bf16x8, wv); }
    }
    l += __shfl_xor(l, 32);
    f32x16 o0, o1;
#pragma unroll
    for (int i = 0; i < 16; ++i) { o0[i] = 0.f; o1[i] = 0.f; }
    int lane2 = lane; asm volatile("" : "+v"(lane2));
    const int q4 = (lane2 & 15) >> 2, sw = (q4 >> 1) & 1, dhalf = (lane2 >> 4) & 1;
    const int rb = (4 * (lane2 >> 5) + q4) * 128 + dhalf * 32 + (lane2 & 3) * 8;
    const int rb0 = rb + (sw ? 64 : 0), rb1 = rb + (sw ? 0 : 64);
#pragma unroll
    for (int kb = 0; kb < 5; ++kb) {
        LAS unsigned char* vb = L + AT_V + slot[kb] * 4096;
#pragma unroll
        for (int sp = 0; sp < 2; ++sp) {
            const s16x4 a00 = __builtin_bit_cast(s16x4, __builtin_amdgcn_ds_read_tr16_b64_v4i16((LAS v4i16_t*)(vb + rb0 + (16 * sp) * 128)));
            const s16x4 a01 = __builtin_bit_cast(s16x4, __builtin_amdgcn_ds_read_tr16_b64_v4i16((LAS v4i16_t*)(vb + rb0 + (16 * sp + 8) * 128)));
            const s16x4 a10 = __builtin_bit_cast(s16x4, __builtin_amdgcn_ds_read_tr16_b64_v4i16((LAS v4i16_t*)(vb + rb1 + (16 * sp) * 128)));
            const s16x4 a11 = __builtin_bit_cast(s16x4, __builtin_amdgcn_ds_read_tr16_b64_v4i16((LAS v4i16_t*)(vb + rb1 + (16 * sp + 8) * 128)));
            const bf16x8 A0 = {a00[0], a00[1], a00[2], a00[3], a01[0], a01[1], a01[2], a01[3]};
            const bf16x8 A1 = {a10[0], a10[1], a10[2], a10[3], a11[0], a11[1], a11[2], a11[3]};
            o0 = __builtin_amdgcn_mfma_f32_32x32x16_bf16(A0, pf[kb][sp], o0, 0, 0, 0);
            o1 = __builtin_amdgcn_mfma_f32_32x32x16_bf16(A1, pf[kb][sp], o1, 0, 0, 0);
        }
    }
    const float inv = 1.f / l;
    const int b = g.bh / AH, hh = g.bh % AH;
    LAS unsigned char* vl = L + AT_O + w * AT_OSZ;
    {
        LAS unsigned char* ol = vl + r32 * 144 + 8 * h;
#pragma unroll
        for (int g4 = 0; g4 < 4; ++g4) {
            *(LAS unsigned long long*)(ol + 16 * g4) = (unsigned long long)cvtpk(o0[4 * g4] * inv, o0[4 * g4 + 1] * inv) | ((unsigned long long)cvtpk(o0[4 * g4 + 2] * inv, o0[4 * g4 + 3] * inv) << 32);
            *(LAS unsigned long long*)(ol + 64 + 16 * g4) = (unsigned long long)cvtpk(o1[4 * g4] * inv, o1[4 * g4 + 1] * inv) | ((unsigned long long)cvtpk(o1[4 * g4 + 2] * inv, o1[4 * g4 + 3] * inv) << 32);
        }
        const int qrow = lane >> 1, half = lane & 1;
        const int qtok2 = res + ((32 * gq + qrow) << g.dsh);
        bf16* op = opart + ((size_t)g.br * NT + (size_t)b * SEQ + qtok2) * DAT + hh * ADH + 32 * half;
#pragma unroll
        for (int i = 0; i < 4; ++i) *(v4u*)(op + 8 * i) = *(const LAS v4u*)(vl + qrow * 144 + 64 * half + 16 * i);
    }
    if (h == 0) { const size_t tok = (size_t)b * SEQ + res + ((32 * gq + r32) << g.dsh); float* st = ostat + (((size_t)g.br * NT + tok) * AH + hh) * 2; st[0] = m; st[1] = l; }
}
__device__ __forceinline__ void p3_attn_coop(const Args& a, Frame& F, int abx, int aG) {
    const bf16* qr = (const bf16*)(a.ws + WS_QR); const bf16* kr = (const bf16*)(a.ws + WS_KR); const bf16* vr = (const bf16*)(a.ws + WS_VR);
    bf16* opart = (bf16*)(a.ws + WS_OPART); float* ostat = (float*)(a.ws + WS_OSTAT);
    LAS unsigned char* L = F.lds + RING_OFF;
    constexpr int NITEM = NB * AH * 24;
    v4u kreg[6], vreg[6]; bf16x8 qf[4];
    int it = abx;
    if (it >= NITEM) return;
    AtGeo g = at_geo(it);
    at_load_q(g, qr, F.wave, F.lane, qf);
    at_load_kv(g, kr, vr, F.tid, kreg, vreg);
    __syncthreads();
    for (;;) {
        int tid = F.tid; asm volatile("" : "+v"(tid));
        at_stage(L, tid, kreg, vreg);
        __syncthreads();
        const int itn = it + aG; const bool more = itn < NITEM;
        const AtGeo gn = at_geo(more ? itn : it);
        at_load_kv(gn, kr, vr, tid, kreg, vreg);
        __builtin_amdgcn_sched_barrier(0);
        at_compute(g, gn, qr, L, qf, opart, ostat, F.wave, tid & 63);
        __syncthreads();
        if (!more) break;
        it = itn; g = gn;
    }
}
template <int VAR>
__device__ __forceinline__ void p3_attn_var(const Args& a, Frame& F) {
    const bf16* qr = (const bf16*)(a.ws + WS_QR); const bf16* kr = (const bf16*)(a.ws + WS_KR); const bf16* vr = (const bf16*)(a.ws + WS_VR);
    bf16* opart = (bf16*)(a.ws + WS_OPART); float* ostat = (float*)(a.ws + WS_OSTAT);
    LAS unsigned char* vl = F.lds + RING_OFF + F.wave * 8192;
    const int abx = (F.G == 256) ? F.bx - 64 : F.bx, aG = (F.G == 256) ? 192 : F.G;
    if (abx < 0) return;
    for (int task = abx * NWAVES + F.wave; task < NB * AH * 192; task += aG * NWAVES) attn_task<VAR>(qr, kr, vr, opart, ostat, task, vl, F.lane);
}
__device__ __forceinline__ void p3_attn(const Args& a, Frame& F) {
    const bf16* qr = (const bf16*)(a.ws + WS_QR); const bf16* kr = (const bf16*)(a.ws + WS_KR); const bf16* vr = (const bf16*)(a.ws + WS_VR);
    bf16* opart = (bf16*)(a.ws + WS_OPART); float* ostat = (float*)(a.ws + WS_OSTAT);
    LAS unsigned char* vl = F.lds + RING_OFF + F.wave * 8192;
    const int abx = (F.G == 256) ? F.bx - 64 : F.bx, aG = (F.G == 256) ? NATT : F.G;
    if (abx < 0) return;
    if (F.G == 256) { if (abx < NATT) { p3_attn_coop(a, F, abx, aG); __syncthreads(); if (F.tid == 0) __hip_atomic_fetch_add((gu32*)(a.ws + WS_CTL) + CW_ADONE, 1u, RLX_AGENT); } }
    else for (int task = abx * NWAVES + F.wave; task < NB * AH * 192; task += aG * NWAVES) attn_task<0>(qr, kr, vr, opart, ostat, task, vl, F.lane);
    if (F.G == 256) cvt_run(a, F, CW_MDONE, (unsigned)(NB * MH * 2), CW_ADONE, (unsigned)NATT);
}
struct MixIn { v4u fp, bp; v4u xcp, zp, op[3]; float mm[3], ll[3]; };
__device__ __forceinline__ MixIn mix_load(const bf16* hfb, const bf16* xc, const bf16* proj, const bf16* opart, const float* ostat, int t, int c0, int hh) {
    MixIn r;
    r.fp = *(const v4u*)(hfb + (size_t)t * DML + c0); r.bp = *(const v4u*)(hfb + ((size_t)NT + t) * DML + c0);
    r.xcp = *(const v4u*)(xc + (size_t)t * DML + c0); r.zp = *(const v4u*)(proj + (size_t)t * DPROJ + 512 + c0);
#pragma unroll
    for (int br = 0; br < 3; ++br) { r.op[br] = *(const v4u*)(opart + ((size_t)br * NT + t) * DAT + c0); const float* st = ostat + (((size_t)br * NT + t) * AH + hh) * 2; r.mm[br] = st[0]; r.ll[br] = st[1]; }
    return r;
}
__device__ __forceinline__ void p4_mix(const Args& a, Frame& F) {
    const bf16* hfb = (const bf16*)(a.ws + WS_HFB); const bf16* xc = (const bf16*)(a.ws + WS_XC); const bf16* proj = (const bf16*)(a.ws + WS_PROJ);
    const bf16* opart = (const bf16*)(a.ws + WS_OPART); const float* ostat = (const float*)(a.ws + WS_OSTAT);
    const float* mnorm_g = a.in[12]; const float* mskip = a.in[13]; const float* anorm_g = a.in[14];
    bf16* mixed = (bf16*)(a.ws + WS_XN);
    const int lane = F.lane, c0 = 8 * lane, hh = lane >> 3;
    float mg[8], sk[8], ag[8];
#pragma unroll
    for (int i = 0; i < 8; ++i) { mg[i] = mnorm_g[c0 + i]; sk[i] = mskip[c0 + i]; ag[i] = anorm_g[c0 + i]; }
    const int tstep = F.G * NWAVES;
    MixIn cur = mix_load(hfb, xc, proj, opart, ostat, F.bx * NWAVES + F.wave, c0, hh);
    for (int t = F.bx * NWAVES + F.wave; t < NT; t += tstep) {
        const MixIn in = cur;
        if (t + tstep < NT) cur = mix_load(hfb, xc, proj, opart, ostat, t + tstep, c0, hh);
        const v4u fp = in.fp, bp = in.bp; const v4u xcp = in.xcp, zp = in.zp;
        v4u op[3]; float mm[3], ll[3];
#pragma unroll
        for (int br = 0; br < 3; ++br) { op[br] = in.op[br]; mm[br] = in.mm[br]; ll[br] = in.ll[br]; }
        float hs[8];
#pragma unroll
        for (int i = 0; i < 4; ++i) { hs[2 * i] = bflo(fp[i]) + bflo(bp[i]); hs[2 * i + 1] = bfhi(fp[i]) + bfhi(bp[i]); }
        float ss = 0.f;
#pragma unroll
        for (int i = 0; i < 8; ++i) ss += hs[i] * hs[i];
        ss += __shfl_xor(ss, 1); ss += __shfl_xor(ss, 2); ss += __shfl_xor(ss, 4); ss += __shfl_xor(ss, 8);
        const float rn = rsqrtf(ss * (1.f / MDH) + EPS);
        float ym[8];
#pragma unroll
        for (int i = 0; i < 8; ++i) {
            const float xcv = (i & 1) ? bfhi(xcp[i >> 1]) : bflo(xcp[i >> 1]), z = (i & 1) ? bfhi(zp[i >> 1]) : bflo(zp[i >> 1]);
            ym[i] = (hs[i] * rn * mg[i] + sk[i] * xcv) * (z / (1.f + __expf(-z)));
        }
        *(v4u*)(mixed + (size_t)t * DMODEL + c0) = (v4u){pk2(ym[0], ym[1]), pk2(ym[2], ym[3]), pk2(ym[4], ym[5]), pk2(ym[6], ym[7])};
        const float M = fmaxf(mm[0], fmaxf(mm[1], mm[2]));
        const float w0 = __expf(mm[0] - M) * ll[0], w1 = __expf(mm[1] - M) * ll[1], w2 = __expf(mm[2] - M) * ll[2];
        const float rden = 1.f / (w0 + w1 + w2);
        float av[8]; float s2 = 0.f;
#pragma unroll
        for (int i = 0; i < 8; ++i) {
            const float o0 = (i & 1) ? bfhi(op[0][i >> 1]) : bflo(op[0][i >> 1]), o1 = (i & 1) ? bfhi(op[1][i >> 1]) : bflo(op[1][i >> 1]), o2 = (i & 1) ? bfhi(op[2][i >> 1]) : bflo(op[2][i >> 1]);
            av[i] = (w0 * o0 + w1 * o1 + w2 * o2) * rden; s2 += av[i] * av[i];
        }
        s2 = wave_sum(s2);
        const float ra = rsqrtf(s2 * (1.f / DAT) + EPS);
        *(v4u*)(mixed + (size_t)t * DMODEL + 512 + c0) = (v4u){pk2(av[0] * ra * ag[0], av[1] * ra * ag[1]), pk2(av[2] * ra * ag[2], av[3] * ra * ag[3]), pk2(av[4] * ra * ag[4], av[5] * ra * ag[5]), pk2(av[6] * ra * ag[6], av[7] * ra * ag[7])};
    }
}
constexpr int RT_STR = 1040;
constexpr int RT_W = 0, RT_G2 = 16 * RT_STR * 4, RT_P = RT_G2 + 4096, RT_SS = RT_P + 8 * 256 * 4;
static_assert(RT_SS + 8 * 16 * 4 <= RING_BYTES, "router LDS map");
__device__ __forceinline__ void p6_router(const Args& a, Frame& F) {
    const float* x0 = a.in[0]; const bf16* yo = (const bf16*)(a.ws + WS_YO); const float* g2 = a.in[16]; const float* wr = a.in[17];
    unsigned char* h2 = a.ws + WS_XN; float* aff = (float*)(a.ws + WS_AFF); int* slot = (int*)(a.ws + WS_SLOT);
    LAS unsigned char* L = F.lds + RING_OFF;
    LAS float* Wl = (LAS float*)(L + RT_W); LAS float* g2l = (LAS float*)(L + RT_G2); LAS float* Pb = (LAS float*)(L + RT_P); LAS float* SSb = (LAS float*)(L + RT_SS);
    int tid_ = F.tid; asm volatile("" : "+v"(tid_));
    const int tid = tid_, lane = F.lane, w = F.wave, c16 = lane & 15, g = lane >> 4;
    __syncthreads();
    { f32x4 wv8[8]; float gk8[8];
#pragma unroll
      for (int i = 0; i < 8; ++i) { const int idx = tid + NTHR * i; wv8[i] = ((const GAS f32x4*)wr)[idx]; gk8[i] = g2[idx >> 2]; }
#pragma unroll
      for (int i = 0; i < 8; ++i) { const int idx = tid + NTHR * i, k = idx >> 2, e0 = (idx & 3) * 4;
#pragma unroll
          for (int j = 0; j < 4; ++j) Wl[(e0 + j) * RT_STR + k] = wv8[i][j] * gk8[i]; }
      g2l[2 * tid] = g2[2 * tid]; g2l[2 * tid + 1] = g2[2 * tid + 1]; }
    __syncthreads();
    const int tl = w >> 1, kh = w & 1;
    for (int t64 = F.bx; t64 < NT / 64; t64 += F.G) {
        const int r0 = t64 * 64 + 16 * tl;
        const float* xp = x0 + (size_t)(r0 + c16) * DMODEL + 512 * kh + 4 * g;
        const bf16* yp = yo + (size_t)(r0 + c16) * DMODEL + 512 * kh + 4 * g;
        f32x4 xa[32];
#pragma unroll
        for (int sx = 0; sx < 32; ++sx) xa[sx] = *(const f32x4*)(xp + 16 * sx);
#pragma unroll
        for (int blk = 0; blk < 4; ++blk) {
            unsigned long long yv[8];
#pragma unroll
            for (int i = 0; i < 8; ++i) yv[i] = *(const unsigned long long*)(yp + 16 * (8 * blk + i));
#pragma unroll
            for (int i = 0; i < 8; ++i) { const unsigned lo = (unsigned)yv[i], hi = (unsigned)(yv[i] >> 32);
                xa[8 * blk + i] += (f32x4){__uint_as_float(lo << 16), __uint_as_float(lo & 0xffff0000u), __uint_as_float(hi << 16), __uint_as_float(hi & 0xffff0000u)}; }
            __builtin_amdgcn_sched_barrier(0);
        }
        float ss = 0.f; f32x4 D = {0.f, 0.f, 0.f, 0.f};
        const LAS float* wrow = Wl + c16 * RT_STR + 512 * kh + 4 * g;
#pragma unroll
        for (int sx = 0; sx < 32; ++sx) {
            const f32x4 wb = *(const LAS f32x4*)(wrow + 16 * sx);
#pragma unroll
            for (int i = 0; i < 4; ++i) { D = __builtin_amdgcn_mfma_f32_16x16x4f32(xa[sx][i], wb[i], D, 0, 0, 0); ss += xa[sx][i] * xa[sx][i]; }
        }
        ss += __shfl_xor(ss, 16); ss += __shfl_xor(ss, 32);
#pragma unroll
        for (int r = 0; r < 4; ++r) Pb[w * 256 + (4 * g + r) * 16 + c16] = D[r];
        if (g == 0) SSb[w * 16 + c16] = ss;
        __syncthreads();
        const int w0 = w & ~1;
        const float rt = rsqrtf((SSb[w0 * 16 + c16] + SSb[(w0 + 1) * 16 + c16]) * (1.f / DMODEL) + EPS);
        unsigned char* hp = h2 + (size_t)(r0 + c16) * DMODEL + 512 * kh + 4 * g;
#pragma unroll
        for (int sx = 0; sx < 32; ++sx) { const f32x4 g4 = *(const LAS f32x4*)(g2l + 512 * kh + 16 * sx + 4 * g); const f32x4 y = xa[sx] * g4 * rt;
            int w8 = 0; w8 = __builtin_amdgcn_cvt_pk_fp8_f32(y.x, y.y, w8, false); w8 = __builtin_amdgcn_cvt_pk_fp8_f32(y.z, y.w, w8, true);
            *(int*)(hp + 16 * sx) = w8; }
        if (kh == 0) {
#pragma unroll
            for (int r = 0; r < 4; ++r) {
                const int tk = 4 * g + r;
                const float rr = rsqrtf((SSb[w0 * 16 + tk] + SSb[(w0 + 1) * 16 + tk]) * (1.f / DMODEL) + EPS);
                const float z = (Pb[w0 * 256 + tk * 16 + c16] + Pb[(w0 + 1) * 256 + tk * 16 + c16]) * rr;
                float mx = z;
                mx = fmaxf(mx, __shfl_xor(mx, 1)); mx = fmaxf(mx, __shfl_xor(mx, 2)); mx = fmaxf(mx, __shfl_xor(mx, 4)); mx = fmaxf(mx, __shfl_xor(mx, 8));
                const float ex = expf(z - mx);
                float den = ex;
                den += __shfl_xor(den, 1); den += __shfl_xor(den, 2); den += __shfl_xor(den, 4); den += __shfl_xor(den, 8);
                aff[(size_t)(r0 + tk) * NE + c16] = ex / den;
                slot[(size_t)(r0 + tk) * NE + c16] = -1;
            }
        }
        __syncthreads();
    }
}
__device__ __forceinline__ void p7_topk(const Args& a, Frame& F) {
    LAS unsigned* hist = (LAS unsigned*)(F.lds + RING_OFF);
    LAS unsigned* wsum = hist + 256;
    LAS unsigned* bc = hist + 272;
    const float* aff = (const float*)(a.ws + WS_AFF); int* slot = (int*)(a.ws + WS_SLOT); int* sel_tok = (int*)(a.ws + WS_SELT); float* sel_gate = (float*)(a.ws + WS_SELG);
    const int tid = F.tid, lane = F.lane, w = F.wave;
    for (int be = F.bx; be < NB * NE; be += F.G) {
        const int b = be / NE, e = be % NE;
        unsigned key[4];
#pragma unroll
        for (int j = 0; j < 4; ++j) key[j] = __float_as_uint(aff[(size_t)(b * SEQ + 4 * tid + j) * NE + e]);
        unsigned prefix = 0u, mask = 0u, need = CAP;
#pragma unroll
        for (int pass = 0; pass < 4; ++pass) {
            const int shift = 24 - 8 * pass;
            __syncthreads();
            if (tid < 256) hist[tid] = 0u;
            __syncthreads();
#pragma unroll
            for (int j = 0; j < 4; ++j) if ((key[j] & mask) == prefix) __hip_atomic_fetch_add(&hist[(key[j] >> shift) & 255u], 1u, __ATOMIC_RELAXED, __HIP_MEMORY_SCOPE_WORKGROUP);
            __syncthreads();
            if (w == 0) {
                const unsigned c0 = hist[4 * lane], c1 = hist[4 * lane + 1], c2 = hist[4 * lane + 2], c3 = hist[4 * lane + 3];
                const unsigned sl = c0 + c1 + c2 + c3;
                unsigned inc = sl;
#pragma unroll
                for (int o = 1; o < 64; o <<= 1) { const unsigned v = __shfl_down(inc, o); if (lane + o < 64) inc += v; }
                unsigned run = inc - sl;
                const unsigned cc[4] = {c3, c2, c1, c0};
#pragma unroll
                for (int q = 0; q < 4; ++q) { if (run < need && run + cc[q] >= need) { bc[0] = (unsigned)(4 * lane + 3 - q); bc[1] = need - run; } run += cc[q]; }
            }
            __syncthreads();
            prefix |= bc[0] << shift; mask |= 255u << shift; need = bc[1];
        }
        unsigned loc = 0u; unsigned gtf[4], eqf[4];
#pragma unroll
        for (int j = 0; j < 4; ++j) { gtf[j] = key[j] > prefix ? 1u : 0u; eqf[j] = key[j] == prefix ? 1u : 0u; loc += gtf[j] + (eqf[j] << 16); }
        unsigned inc = loc;
#pragma unroll
        for (int o = 1; o < 64; o <<= 1) { const unsigned v = __shfl_up(inc, o); if (lane >= o) inc += v; }
        if (lane == 63) wsum[w] = inc;
        __syncthreads();
        unsigned base = 0u;
#pragma unroll
        for (int ww = 0; ww < 8; ++ww) if (ww < w) base += wsum[ww];
        unsigned run = base + inc - loc;
#pragma unroll
        for (int j = 0; j < 4; ++j) {
            const unsigned gb = run & 0xffffu, eb = run >> 16;
            const bool sel = gtf[j] || (eqf[j] && eb < need);
            if (sel) { const unsigned sl = gb + (eb < need ? eb : need); const int tok = b * SEQ + 4 * tid + j; const int p = (e * NB + b) * CAP + (int)sl;
                sel_tok[p] = tok; sel_gate[p] = __uint_as_float(key[j]); slot[(size_t)tok * NE + e] = (int)sl; }
            run += gtf[j] + (eqf[j] << 16);
        }
    }
}
__device__ __forceinline__ void p10_final(const Args& a, Frame& F, float* dst) {
    const float* x0 = a.in[0]; const bf16* yo = (const bf16*)(a.ws + WS_YO); const float* gf = a.in[21]; const int* slot = (const int*)(a.ws + WS_SLOT); const bf16* Y = (const bf16*)(a.ws + WS_Y);
    const int lane = F.lane;
    const int rstep = F.G * NWAVES;
    f32x4 nx[4]; unsigned long long ny[4]; int nslot = -1;
    { const int row0 = F.bx * NWAVES + F.wave;
      if (row0 < NT) {
#pragma unroll
        for (int j = 0; j < 4; ++j) { nx[j] = ((const GAS f32x4*)(x0 + (size_t)row0 * DMODEL) + lane)[64 * j]; ny[j] = ((const GAS unsigned long long*)(yo + (size_t)row0 * DMODEL) + lane)[64 * j]; }
        nslot = slot[(size_t)row0 * NE + (lane & 15)]; } }
    for (int row = F.bx * NWAVES + F.wave; row < NT; row += rstep) {
        const int b = row / SEQ;
        f32x4 v[4];
#pragma unroll
        for (int j = 0; j < 4; ++j) { const unsigned lo = (unsigned)ny[j], hi = (unsigned)(ny[j] >> 32);
            v[j] = (f32x4){nx[j].x + __uint_as_float(lo << 16), nx[j].y + __uint_as_float(lo & 0xffff0000u), nx[j].z + __uint_as_float(hi << 16), nx[j].w + __uint_as_float(hi & 0xffff0000u)}; }
        const int myslot = nslot;
        if (row + rstep < NT) {
#pragma unroll
            for (int j = 0; j < 4; ++j) { nx[j] = ((const GAS f32x4*)(x0 + (size_t)(row + rstep) * DMODEL) + lane)[64 * j]; ny[j] = ((const GAS unsigned long long*)(yo + (size_t)(row + rstep) * DMODEL) + lane)[64 * j]; }
            nslot = slot[(size_t)(row + rstep) * NE + (lane & 15)]; }
        unsigned long long msk = __ballot(lane < 16 && myslot >= 0);
        while (msk) {
            unsigned long long y[4][4];
#pragma unroll
            for (int q = 0; q < 4; ++q) {
                const bool ok = msk != 0ull; const int e = ok ? (__ffsll((long long)msk) - 1) : 0; const int sl = __shfl(myslot, e);
                if (ok) { msk &= msk - 1ull; const GAS unsigned long long* yr = (const GAS unsigned long long*)(Y + ((size_t)(e * NB + b) * CAP + sl) * DMODEL) + lane;
#pragma unroll
                    for (int j = 0; j < 4; ++j) y[q][j] = yr[64 * j]; }
                else {
#pragma unroll
                    for (int j = 0; j < 4; ++j) y[q][j] = 0ull; }
            }
#pragma unroll
            for (int q = 0; q < 4; ++q)
#pragma unroll
                for (int j = 0; j < 4; ++j) { const unsigned lo = (unsigned)y[q][j], hi = (unsigned)(y[q][j] >> 32);
                    v[j].x += __uint_as_float(lo << 16); v[j].y += __uint_as_float(lo & 0xffff0000u); v[j].z += __uint_as_float(hi << 16); v[j].w += __uint_as_float(hi & 0xffff0000u); }
        }
        float s = 0.f;
#pragma unroll
        for (int j = 0; j < 4; ++j) s += (v[j].x * v[j].x + v[j].y * v[j].y) + (v[j].z * v[j].z + v[j].w * v[j].w);
        const float r = rsqrtf(wave_sum(s) * (1.f / DMODEL) + EPS);
#pragma unroll
        for (int j = 0; j < 4; ++j) { const f32x4 w = ((const GAS f32x4*)gf)[lane + 64 * j]; ((GAS f32x4*)(dst + (size_t)row * DMODEL) + lane)[64 * j] = (f32x4){v[j].x * r * w.x, v[j].y * r * w.y, v[j].z * r * w.z, v[j].w * r * w.w}; }
    }
}

#ifndef MK_N_LAUNCHES
#define MK_N_LAUNCHES 1
#endif
constexpr int N_PHASES = 11;
__global__ void __launch_bounds__(NTHR, 2) mk_fwd(Args args) {
    extern __shared__ __attribute__((aligned(16))) unsigned char lds[];
    Frame F;
    F.lds = (LAS unsigned char*)lds;
    F.tid = threadIdx.x; F.lane = F.tid & 63; F.wave = __builtin_amdgcn_readfirstlane(F.tid >> 6);
    F.G = gridDim.x; F.bx = blockIdx.x;
    unsigned char* ws = args.ws;
    gu32* ctl = (gu32*)(ws + WS_CTL);
    for (int u = F.tid; u < (LDS_BYTES - LDSCTL_OFF) / 4; u += NTHR) ((LAS unsigned*)(F.lds + LDSCTL_OFF))[u] = 0u;
    __syncthreads();
    volatile LAS unsigned* MISC = (volatile LAS unsigned*)(F.lds + MISC_OFF);
    XcdBarrier bar; bar.bar = (unsigned*)(ctl + CW_BAR) + args.li * XCD_BAR_WORDS; bar.x = 0; bar.st = nullptr;
    if (MK_N_LAUNCHES != N_PHASES) bar = xcd_barrier_post((unsigned*)(ctl + CW_BAR) + args.li * XCD_BAR_WORDS, MISC + 8);
    const int lo = args.ph_lo, hi = args.ph_hi;
#define IN(k) (lo <= (k) && (k) < hi)
#define SEAM(k) do { if (IN(k) && IN((k) + 1)) xcd_barrier(bar); asm volatile("" : "+v"(F.tid)); F.lane = F.tid & 63; } while (0)
#ifndef DUP_PHASE
#define DUP_PHASE -1
#endif
#define DUPBAR(k) if (DUP_PHASE == (k)) xcd_barrier(bar)
#ifndef SPIN_PHASE
#define SPIN_PHASE -1
#endif
    unsigned long long tstamp0 = 0, tstamp1 = 0;
#define STAMP(k) do { if (SPIN_PHASE >= 0) { if ((k) == SPIN_PHASE) tstamp0 = __builtin_amdgcn_s_memrealtime(); if ((k) == SPIN_PHASE + 1) tstamp1 = __builtin_amdgcn_s_memrealtime(); } } while (0)

    STAMP(0);
    if (IN(0)) { p0_prologue(args, F); if (DUP_PHASE == 0) { xcd_barrier(bar); p0_prologue(args, F); } } SEAM(0);
    STAMP(1);
    if (IN(1)) for (int rep = 0; rep < (DUP_PHASE == 1 ? 2 : 1); ++rep) {   if (rep) xcd_barrier(bar);
        pg8::Gemm g{(const pg8::bf16_t*)(ws + WS_XN), (const pg8::bf16_t*)(ws + WS_WIN), NT, DPROJ, DMODEL, nullptr, 0};
        pg8::StaticOrder S; S.init(NT, DPROJ, F.G, F.bx);
        static_assert(WS_KR - WS_QR == WS_VR - WS_KR, "Q, K, V buffers equally spaced");
        pg8::EpiInProj E{(pg8::bf16_t*)(ws + WS_PROJ), DPROJ, (pg8::bf16_t*)(ws + WS_QR), (size_t)(WS_KR - WS_QR) / 2, (const float*)(ws + WS_ROPE)};
        pg8::gemm_phase<pg8::EpiInProj, pg8::StaticOrder, true, true, false>(F.lds + RING_OFF, g, S, E, F.tid);
    } SEAM(1);
    STAMP(2);
    if (IN(2)) { p2_prep(args, F); if (DUP_PHASE == 2) { xcd_barrier(bar); p2_prep(args, F); } } SEAM(2);
    STAMP(3);
    if (IN(3)) { p3_mlstm(args, F); p3_attn(args, F); if (DUP_PHASE == 3) { xcd_barrier(bar); p3_mlstm(args, F); p3_attn(args, F); } if (DUP_PHASE == 31) { xcd_barrier(bar); p3_mlstm(args, F); } if (DUP_PHASE >= 3100 && DUP_PHASE < 3132) { xcd_barrier(bar); for (int item = F.bx; item < NB * MH * 2; item += F.G) mlstm_item<(DUP_PHASE >= 3100 ? DUP_PHASE - 3100 : 0) | 1>(args, F, item); __syncthreads(); } if (DUP_PHASE == 32) { xcd_barrier(bar); p3_attn(args, F); } if (DUP_PHASE >= 320 && DUP_PHASE < 328) { xcd_barrier(bar); p3_attn_var<DUP_PHASE >= 320 ? (DUP_PHASE - 320) | 4 : 4>(args, F); } } SEAM(3);
    STAMP(4);
    if (IN(4)) { p4_mix(args, F); if (DUP_PHASE == 4) { xcd_barrier(bar); p4_mix(args, F); } } SEAM(4);
    STAMP(5);
    if (IN(5)) for (int rep = 0; rep < (DUP_PHASE == 5 ? 2 : 1); ++rep) {   if (rep) xcd_barrier(bar);
        pg8::Gemm g{(const pg8::bf16_t*)(ws + WS_XN), (const pg8::bf16_t*)(ws + WS_WOUT), NT, DMODEL, DMODEL, nullptr, 0};
        pg8::StaticOrder S; S.init(NT, DMODEL, F.G, F.bx);
        pg8::EpiStoreBf16 E{(pg8::bf16_t*)(ws + WS_YO), DMODEL};
        pg8::gemm_phase<pg8::EpiStoreBf16, pg8::StaticOrder, true, true, false>(F.lds + RING_OFF, g, S, E, F.tid);
    } SEAM(5);
    STAMP(6);
    if (IN(6)) { p6_router(args, F); if (DUP_PHASE == 6) { xcd_barrier(bar); p6_router(args, F); } } SEAM(6);
    STAMP(7);
    if (IN(7)) { p7_topk(args, F); if (DUP_PHASE == 7) { xcd_barrier(bar); p7_topk(args, F); } cvt_run(args, F, -1, 0u); if (DUP_PHASE == 40) { xcd_barrier(bar); cvt_run(args, F, -1, 0u, -1, 0u, 320); } } SEAM(7);
    STAMP(8);
    if (IN(8)) for (int rep = 0; rep < (DUP_PHASE == 8 ? 2 : 1); ++rep) {   if (rep) xcd_barrier(bar);
        if (F.G == 256) {
            for (int seg = 0; seg < 2; ++seg) {
                pg8::Gemm g{(const pg8::bf16_t*)(ws + WS_XN), (const pg8::bf16_t*)(ws + WS_W13), NPAIR, NE * 2 * DEXP, DMODEL, (const int*)(ws + WS_SELT), 0x7a7a7a7a};
                pg8::MoeUpOrder S; S.init(F.bx, seg);
                pg8::EpiSwiGLU E{ws + WS_H, DEXP, 2 * DEXP / 256};
                pg8::gemm_phase<pg8::EpiSwiGLU, pg8::MoeUpOrder, true, true, true, true>(F.lds + RING_OFF, g, S, E, F.tid);
            }
        }
    }
    if (DUP_PHASE == 80 || DUP_PHASE == 81) { xcd_barrier(bar);
        for (int seg = 0; seg < 2; ++seg) {
            pg8::Gemm g{(const pg8::bf16_t*)(ws + WS_XN), (const pg8::bf16_t*)(ws + WS_W13), NPAIR, NE * 2 * DEXP, DMODEL, (const int*)(ws + WS_SELT), 0x7a7a7a7a};
            pg8::MoeUpOrder S; S.init(F.bx, seg);
            pg8::EpiNull E{};
            pg8::gemm_phase<pg8::EpiNull, pg8::MoeUpOrder, DUP_PHASE == 80, true, true, true>(F.lds + RING_OFF, g, S, E, F.tid);
        }
    } SEAM(8);
    STAMP(9);
    if (IN(9)) for (int rep = 0; rep < (DUP_PHASE == 9 ? 2 : 1); ++rep) {   if (rep) xcd_barrier(bar);
        if (F.G == 256) {
            pg8::Gemm g{(const pg8::bf16_t*)(ws + WS_H), (const pg8::bf16_t*)(ws + WS_W2), NPAIR, NE * DMODEL, DEXP, nullptr, 0x79797979};
            pg8::MoeDownOrder S; S.init(F.bx);
            pg8::EpiDown E{(pg8::bf16_t*)(ws + WS_Y), DMODEL, (const float*)(ws + WS_SELG)};
            pg8::gemm_phase<pg8::EpiDown, pg8::MoeDownOrder, true, true, false, true>(F.lds + RING_OFF, g, S, E, F.tid);
        }
    } SEAM(9);
    STAMP(10);
    if (IN(10)) { if (DUP_PHASE == 10) { p10_final(args, F, (float*)(ws + WS_H)); xcd_barrier(bar); } if (DUP_PHASE == 11) { for (int q = 0; q < 10; ++q) xcd_barrier(bar); } p10_final(args, F, args.out); }
    STAMP(11);
    if (SPIN_PHASE >= 0 && F.bx == 0 && F.tid == 0) { const unsigned long long until = __builtin_amdgcn_s_memrealtime() + 8ull * (tstamp1 - tstamp0); while (__builtin_amdgcn_s_memrealtime() < until) __builtin_amdgcn_s_sleep(8); }
#undef IN
#undef SEAM
}

extern "C" void kernel_launch(void* const* d_in, const int* in_sizes, int n_in, void* d_out, int out_size, void* d_ws, size_t ws_size, hipStream_t stream) {
    static int grid = 0;
    if (grid == 0) {
        if (n_in != 22 || out_size != NT * DMODEL || ws_size < WS_END) { fprintf(stderr, "kernel_launch: unexpected shapes (n_in %d out %d ws %zu need %zu)\n", n_in, out_size, ws_size, (size_t)WS_END); grid = -1; return; }
        int dev = 0, cus = 0, per_cu = 0;
        if (hipGetDevice(&dev) != hipSuccess || hipDeviceGetAttribute(&cus, hipDeviceAttributeMultiprocessorCount, dev) != hipSuccess) { grid = -1; return; }
        if (hipFuncSetAttribute((const void*)mk_fwd, hipFuncAttributeMaxDynamicSharedMemorySize, LDS_BYTES) != hipSuccess) { fprintf(stderr, "kernel_launch: hipFuncSetAttribute failed\n"); grid = -1; return; }
        if (hipOccupancyMaxActiveBlocksPerMultiprocessor(&per_cu, (const void*)mk_fwd, NTHR, LDS_BYTES) != hipSuccess || per_cu < 1) { fprintf(stderr, "kernel_launch: occupancy query says %d blocks per CU\n", per_cu); grid = -1; (void)hipGetLastError(); return; }
        grid = cus;
        if (grid != 256) fprintf(stderr, "kernel_launch: %d CUs: the MoE phases are built for 256\n", grid);
    }
    if (grid < 0) return;
    (void)hipMemsetAsync((char*)d_ws + WS_CTL, 0, CTL_ZERO_BYTES, stream);
    Args a{};
    for (int i = 0; i < 22; ++i) a.in[i] = (const float*)d_in[i];
    a.out = (float*)d_out; a.ws = (unsigned char*)d_ws;
    for (int li = 0; li < MK_N_LAUNCHES; ++li) {
        if (MK_N_LAUNCHES == 1) { a.ph_lo = 0; a.ph_hi = N_PHASES; } else { a.ph_lo = li; a.ph_hi = li + 1; }
        a.li = (MK_N_LAUNCHES == 1) ? 0 : 0;
        hipLaunchKernelGGL(mk_fwd, dim3(grid), dim3(NTHR), LDS_BYTES, stream, a);
    }
}
```

```cpp
#include <hip/hip_runtime.h>
#include <cstdio>
#include <cstdint>
#include <cmath>

namespace pg8 {
#define PG8_LAS __attribute__((address_space(3)))
typedef unsigned short bf16_t;
typedef short bf16x8 __attribute__((ext_vector_type(8)));
typedef float f32x4 __attribute__((ext_vector_type(4)));
typedef float f32x2 __attribute__((ext_vector_type(2)));
typedef unsigned u32x4 __attribute__((ext_vector_type(4)));
constexpr int BM = 256, BK = 64, HALF = 128, HTB = HALF * BK * 2  , STAGE_BYTES = 8 * HTB, NXCD = 8, WGM = 8;

__host__ __device__ __forceinline__ int lds_byte(int r, int c) { const int st = (r >> 4) * 2 + (c >> 5), rr = r & 15, cc = c & 31, ob = rr * 64 + cc * 2; return st * 1024 + (ob ^ (((ob >> 9) & 1) << 5)); }
__host__ __device__ __forceinline__ void stage_rc(int b, int& R, int& C) { const int st = b / 1024, sb = b % 1024, swz = sb ^ (((sb >> 9) & 1) << 5); R = (st >> 1) * 16 + swz / 64; C = (st & 1) * 32 + (swz % 64) / 2; }
__host__ __device__ __forceinline__ int perm32(int rho) { const int n = rho >> 4, i = rho & 15; return 8 * (i >> 2) + 4 * n + (i & 3); }

typedef int v8i_t __attribute__((ext_vector_type(8)));
typedef int v4i_t __attribute__((ext_vector_type(4)));
__device__ __forceinline__ v8i_t cat32(bf16x8 a, bf16x8 b) { const v4i_t x = __builtin_bit_cast(v4i_t, a), y = __builtin_bit_cast(v4i_t, b); return (v8i_t){x[0], x[1], x[2], x[3], y[0], y[1], y[2], y[3]}; }
struct Unit { int pm, pn; };
struct Gemm { const bf16_t* A; const bf16_t* Bt; int M, N, K; const int* rowidx; int wscale; };

struct StaticOrder {
    int nM, nN, nwg, G, c;
    __host__ __device__ void init(int M, int N, int G_, int c_) { nM = M / BM; nN = N / BM; nwg = nM * nN; G = G_; c = c_; }
    __host__ __device__ bool next(int i, Unit& u) const {
        const long L = (long)i * G + c; if (L >= nwg) return false;
        int wgid = (int)L; { const int q = nwg / NXCD, r = nwg % NXCD, xcd = wgid % NXCD, off = wgid / NXCD; wgid = (xcd < r ? xcd * (q + 1) : r * (q + 1) + (xcd - r) * q) + off; }
        const int nig = WGM * nN, gid = wgid / nig, fm = gid * WGM, gsz = (nM - fm) < WGM ? (nM - fm) : WGM;
        u.pm = fm + ((wgid % nig) % gsz); u.pn = (wgid % nig) / gsz; return true;
    }
    __device__ __forceinline__ void a_ready(const Unit&) const {}
    __device__ __forceinline__ void done(const Unit&) const {}
};


__device__ __forceinline__ unsigned cvt_pk_bf16(float lo, float hi) { unsigned r; asm volatile("v_cvt_pk_bf16_f32 %0, %1, %2" : "=v"(r) : "v"(lo), "v"(hi)); return r; }
__device__ __forceinline__ float fast_silu(float x) { return x * __builtin_amdgcn_rcpf(1.0f + __builtin_amdgcn_exp2f(-1.4426950408889634f * x)); }

struct EpiStoreBf16 {
    static constexpr bool PERM = true, AFTER_DRAIN = false;
    bf16_t* O; int ldc;
    __device__ __forceinline__ void operator()(const f32x4 (&acc)[2][2][4][2], const Unit& u, int wr, int wc, int fr, int fq) const {
        const int row0 = u.pm * BM + wr * 64 + fr, col0 = u.pn * BM + wc * 32 + 8 * fq;
#pragma unroll
        for (int ai = 0; ai < 2; ++ai)
#pragma unroll
            for (int m = 0; m < 4; ++m) { bf16_t* rowp = O + (size_t)(row0 + ai * HALF + m * 16) * ldc + col0;
#pragma unroll
                for (int bj = 0; bj < 2; ++bj) { const f32x4 v0 = acc[ai][bj][m][0], v1 = acc[ai][bj][m][1];
                    u32x4 w; w.x = cvt_pk_bf16(v0[0], v0[1]); w.y = cvt_pk_bf16(v0[2], v0[3]); w.z = cvt_pk_bf16(v1[0], v1[1]); w.w = cvt_pk_bf16(v1[2], v1[3]);
                    *(u32x4*)(rowp + bj * HALF) = w; } }
    }
};
struct EpiInProj {
    static constexpr bool PERM = true, AFTER_DRAIN = false;
    bf16_t* O; int ldc; bf16_t* QKVo; size_t kind_stride; const float* rope;
    __device__ __forceinline__ void operator()(const f32x4 (&acc)[2][2][4][2], const Unit& u, int wr, int wc, int fr, int fq) const {
        const int row0 = u.pm * BM + wr * 64 + fr;
        if (u.pn < 4) {
            const int col0 = u.pn * BM + wc * 32 + 8 * fq;
#pragma unroll
            for (int ai = 0; ai < 2; ++ai)
#pragma unroll
                for (int m = 0; m < 4; ++m) { bf16_t* rowp = O + (size_t)(row0 + ai * HALF + m * 16) * ldc + col0;
#pragma unroll
                    for (int bj = 0; bj < 2; ++bj) { const f32x4 v0 = acc[ai][bj][m][0], v1 = acc[ai][bj][m][1];
                        u32x4 w; w.x = cvt_pk_bf16(v0[0], v0[1]); w.y = cvt_pk_bf16(v0[2], v0[3]); w.z = cvt_pk_bf16(v1[0], v1[1]); w.w = cvt_pk_bf16(v1[2], v1[3]);
                        *(u32x4*)(rowp + bj * HALF) = w; } }
            return;
        }
        const int kind = (u.pn - 4) >> 1;
        bf16_t* dst = QKVo + (size_t)kind * kind_stride;
        const float scl = kind == 0 ? 0.125f : 1.0f;
        const bool roped = kind < 2 && (wc & 1) == 0;
        const int d0 = 32 * (wc & 1) + 8 * fq;
#pragma unroll
        for (int ai = 0; ai < 2; ++ai)
#pragma unroll
            for (int m = 0; m < 4; ++m) {
                const int row = row0 + ai * HALF + m * 16, b = row >> 11, sq = row & 2047;
                const float sgn = fq == 0 ? -1.f : 1.f;
#pragma unroll
                for (int bj = 0; bj < 2; ++bj) {
                    const int hh = ((u.pn & 1) << 2) + 2 * bj + (wc >> 1);
                    u32x4 w;
#pragma unroll
                    for (int n = 0; n < 2; ++n) {
                        f32x4 v = acc[ai][bj][m][n];
                        if (roped) {
                            f32x4 p;
#pragma unroll
                            for (int i = 0; i < 4; ++i) p[i] = __shfl_xor(v[i], 16);
                            if (fq < 2) { const f32x4 cs = *(const f32x4*)(rope + sq * 16 + 4 * n), sn = *(const f32x4*)(rope + sq * 16 + 8 + 4 * n); v = v * cs + p * (sn * sgn); }
                        }
                        v = v * scl;
                        if (n == 0) { w.x = cvt_pk_bf16(v[0], v[1]); w.y = cvt_pk_bf16(v[2], v[3]); } else { w.z = cvt_pk_bf16(v[0], v[1]); w.w = cvt_pk_bf16(v[2], v[3]); }
                    }
                    *(u32x4*)(dst + (((size_t)b * 8 + hh) * 2048 + sq) * 64 + d0) = w;
                }
                __builtin_amdgcn_sched_barrier(0);
            }
    }
};
struct EpiRes {
    static constexpr bool PERM = false, AFTER_DRAIN = false;
    const float* base; float* out; int ldc;
    __device__ __forceinline__ void operator()(const f32x4 (&acc)[2][2][4][2], const Unit& u, int wr, int wc, int fr, int fq) const {
        const int row0 = u.pm * BM + wr * 64 + fr, col0 = u.pn * BM + wc * 32 + 4 * fq;
#pragma unroll
        for (int ai = 0; ai < 2; ++ai)
#pragma unroll
            for (int m = 0; m < 4; ++m) { const size_t off = (size_t)(row0 + ai * HALF + m * 16) * ldc + col0;
#pragma unroll
                for (int bj = 0; bj < 2; ++bj)
#pragma unroll
                    for (int n = 0; n < 2; ++n) { const f32x4 bs = *(const f32x4*)(base + off + bj * HALF + n * 16); *(f32x4*)(out + off + bj * HALF + n * 16) = bs + acc[ai][bj][m][n]; } }
    }
};
struct EpiSwiGLU {
    static constexpr bool PERM = true, AFTER_DRAIN = false;
    unsigned char* H; int ldc; int tiles_per_expert;
    __device__ __forceinline__ void operator()(const f32x4 (&acc)[2][2][4][2], const Unit& u, int wr, int wc, int fr, int fq) const {
        const int row0 = u.pm * BM + wr * 64 + fr, col0 = (u.pn % tiles_per_expert) * HALF + wc * 32 + 8 * fq;
#pragma unroll
        for (int ai = 0; ai < 2; ++ai)
#pragma unroll
            for (int m = 0; m < 4; ++m) { unsigned char* rowp = H + (size_t)(row0 + ai * HALF + m * 16) * ldc + col0;
                float h[8];
#pragma unroll
                for (int n = 0; n < 2; ++n)
#pragma unroll
                    for (int i = 0; i < 4; i += 2) {
                        const f32x2 y = {acc[ai][0][m][n][i], acc[ai][0][m][n][i + 1]}, gp = {acc[ai][1][m][n][i], acc[ai][1][m][n][i + 1]};
                        f32x2 d = {__builtin_amdgcn_exp2f(-y[0]), __builtin_amdgcn_exp2f(-y[1])}; d = d + 1.0f;
                        const f32x2 r = {__builtin_amdgcn_rcpf(d[0]), __builtin_amdgcn_rcpf(d[1])};
                        const f32x2 o = (y * gp) * r; h[n * 4 + i] = o[0]; h[n * 4 + i + 1] = o[1]; }
                int w0 = 0, w1 = 0;
                w0 = __builtin_amdgcn_cvt_pk_fp8_f32(h[0], h[1], w0, false); w0 = __builtin_amdgcn_cvt_pk_fp8_f32(h[2], h[3], w0, true);
                w1 = __builtin_amdgcn_cvt_pk_fp8_f32(h[4], h[5], w1, false); w1 = __builtin_amdgcn_cvt_pk_fp8_f32(h[6], h[7], w1, true);
                *(unsigned long long*)rowp = (unsigned long long)(unsigned)w0 | ((unsigned long long)(unsigned)w1 << 32);
                __builtin_amdgcn_sched_barrier(0); }
    }
};
struct EpiNull {
    static constexpr bool PERM = true, AFTER_DRAIN = false;
    __device__ __forceinline__ void operator()(const f32x4 (&acc)[2][2][4][2], const Unit& u, int wr, int wc, int fr, int fq) const {
#pragma unroll
        for (int ai = 0; ai < 2; ++ai)
#pragma unroll
            for (int bj = 0; bj < 2; ++bj)
#pragma unroll
                for (int m = 0; m < 4; ++m) asm volatile("" :: "v"(acc[ai][bj][m][0]), "v"(acc[ai][bj][m][1]));
    }
};
struct EpiDown {
    static constexpr bool PERM = true, AFTER_DRAIN = false;
    bf16_t* Y; int ldc; const float* gate;
    __device__ __forceinline__ void operator()(const f32x4 (&acc)[2][2][4][2], const Unit& u, int wr, int wc, int fr, int fq) const {
        const int row0 = u.pm * BM + wr * 64 + fr, col0 = (u.pn & 3) * BM + wc * 32 + 8 * fq;
#pragma unroll
        for (int ai = 0; ai < 2; ++ai)
#pragma unroll
            for (int m = 0; m < 4; ++m) { const int row = row0 + ai * HALF + m * 16; const float gt = gate[row]; bf16_t* rowp = Y + (size_t)row * ldc + col0;
#pragma unroll
                for (int bj = 0; bj < 2; ++bj) { const f32x4 v0 = acc[ai][bj][m][0] * gt, v1 = acc[ai][bj][m][1] * gt;
                    u32x4 w; w.x = cvt_pk_bf16(v0[0], v0[1]); w.y = cvt_pk_bf16(v0[2], v0[3]); w.z = cvt_pk_bf16(v1[0], v1[1]); w.w = cvt_pk_bf16(v1[2], v1[3]);
                    *(u32x4*)(rowp + bj * HALF) = w; }
                asm volatile("" ::: "memory"); }
    }
};
struct MoeUpOrder {
    int x, lc, seg, i0, n;
    __device__ void init(int c, int seg_) { x = c & 7; lc = c >> 3; seg = seg_; const int n0 = lc < 16 ? 6 : 5; i0 = seg ? n0 : 0; n = seg ? 11 - n0 : n0; }
    __device__ bool next(int i, Unit& u) const { if (i >= n) return false; const int L = (i0 + i) * 32 + lc, e = 2 * x + L / 176, w = L % 176; u.pm = e * 8 + (w & 7); u.pn = e * 22 + (w >> 3); return true; }
    __device__ __forceinline__ void a_ready(const Unit&) const {}
    __device__ __forceinline__ void done(const Unit&) const {}
};
struct MoeDownOrder {
    int x, lc;
    __device__ void init(int c) { x = c & 7; lc = c >> 3; }
    __device__ bool next(int i, Unit& u) const { if (i >= 2) return false; const int e = 2 * x + i; u.pm = e * 8 + (lc & 7); u.pn = e * 4 + (lc >> 3); return true; }
    __device__ __forceinline__ void a_ready(const Unit&) const {}
    __device__ __forceinline__ void done(const Unit&) const {}
};

template <bool F8> struct Frag;
template <> struct Frag<false> { bf16x8 k[2]; };
template <> struct Frag<true> { v8i_t v; };
template <class Epi, class Sched, bool ALIGN_EPI = false, bool SP2 = true, bool GATHER = false, bool F8 = false>
__device__ __forceinline__ void gemm_phase(PG8_LAS unsigned char* lds, const Gemm g, const Sched& S, const Epi& E) {
    int tid_ = threadIdx.x; asm volatile("" : "+v"(tid_));
    const int tid = tid_, wid = __builtin_amdgcn_readfirstlane(tid >> 6), lane = tid & 63, wr = wid >> 2, wc = wid & 3, fr = lane & 15, fq = lane >> 4;
    const int K = g.K, KB = F8 ? K : 2 * K  , nt = KB / (BK * 2);
    unsigned voffA[2], voffB[2]; int RA[2]; unsigned CA2[2];
    unsigned gc[2][2];
#pragma unroll
    for (int i = 0; i < 2; ++i) { int R, C; stage_rc(tid * 16 + i * 8192, R, C); const int Rb = Epi::PERM ? ((R & ~31) + perm32(R & 31)) : R;
        voffA[i] = (unsigned)(R * KB + C * 2); voffB[i] = (unsigned)(Rb * KB + C * 2); RA[i] = R; CA2[i] = (unsigned)C * 2u; }
    const size_t kstep = (size_t)(BK * 2);
    const size_t hstep = (size_t)HALF * KB;
    const size_t hstepA = GATHER ? (size_t)0 : hstep;
    const size_t tstep = 2 * hstep;
    const unsigned ldsw = (unsigned)wid * 1024u;
    const int aoff = lds_byte(wr * 64 + fr, fq * 8), boff = lds_byte(wc * 32 + fr, fq * 8);
    PG8_LAS unsigned char* ldsAr = lds + aoff; PG8_LAS unsigned char* ldsBr = lds + 4 * HTB + boff;
    asm volatile("" : "+v"(ldsAr), "+v"(ldsBr));
#define PG8_SA(b, h) (((b) * 2 + (h)) * HTB)
#define PG8_SB(b, h) ((4 + (b) * 2 + (h)) * HTB)
#define PG8_STAGE(bufoff, gbase, voff) do { _Pragma("unroll") for (int _i = 0; _i < 2; ++_i) \
        __builtin_amdgcn_global_load_lds((const unsigned*)((const char*)(gbase) + (voff)[_i]), (PG8_LAS unsigned*)(lds + (bufoff) + ldsw + _i * 8192), 16, 0, 0); } while (0)
#define PG8_GLOAD(dst, u) do { _Pragma("unroll") for (int _h = 0; _h < 2; ++_h) _Pragma("unroll") for (int _i = 0; _i < 2; ++_i) \
        dst[_h][_i] = (unsigned)g.rowidx[(u).pm * BM + _h * HALF + RA[_i]] * (unsigned)KB + CA2[_i]; } while (0)
#define PG8_STAGE_A(bufoff, aptr, h, usenext) do { if constexpr (GATHER) { PG8_STAGE(bufoff, aptr, gc[h]); } \
        else { PG8_STAGE(bufoff, (aptr) + (h) * hstepA, voffA); } } while (0)
#define PG8_LD1(d, p) do { if constexpr (F8) { (d).v = cat32(*(const PG8_LAS bf16x8*)(p), *(const PG8_LAS bf16x8*)((p) + 1024)); } else { (d).k[0] = *(const PG8_LAS bf16x8*)(p); (d).k[1] = *(const PG8_LAS bf16x8*)((p) + 1024); } } while (0)
#define PG8_LDA(dst, b, h) do { _Pragma("unroll") for (int m = 0; m < 4; ++m) PG8_LD1(dst[m], ldsAr + PG8_SA(b, h) + m * 2048); } while (0)
#define PG8_LDB(dst, b, h) do { _Pragma("unroll") for (int n = 0; n < 2; ++n) PG8_LD1(dst[n], ldsBr + ((b) * 2 + (h)) * HTB + n * 2048); } while (0)
#define PG8_SUB(v, o) ((f32x4){(v)[(o)], (v)[(o) + 1], (v)[(o) + 2], (v)[(o) + 3]})
#define PG8_INS(v, r, o) do { (v)[(o)] = (r)[0]; (v)[(o) + 1] = (r)[1]; (v)[(o) + 2] = (r)[2]; (v)[(o) + 3] = (r)[3]; } while (0)
#define PG8_MMA(ai, bj, At, Bt) do { __builtin_amdgcn_s_setprio(1); \
        _Pragma("unroll") for (int m = 0; m < 4; ++m) _Pragma("unroll") for (int n = 0; n < 2; ++n) { \
            f32x4 c_ = PG8_SUB(accq[ai][bj][m >> 1], 8 * (m & 1) + 4 * n); \
            if constexpr (F8) { c_ = __builtin_amdgcn_mfma_scale_f32_16x16x128_f8f6f4(Bt[n].v, At[m].v, c_, 0, 0, 0, g.wscale, 0, 0x7f7f7f7f); } \
            else { _Pragma("unroll") for (int k = 0; k < 2; ++k) c_ = __builtin_amdgcn_mfma_f32_16x16x32_bf16(Bt[n].k[k], At[m].k[k], c_, 0, 0, 0); } \
            PG8_INS(accq[ai][bj][m >> 1], c_, 8 * (m & 1) + 4 * n); } \
        __builtin_amdgcn_s_setprio(0); } while (0)
#define PG8_WAIT_V(n) asm volatile("s_waitcnt vmcnt(" #n ")" ::: "memory")
#define PG8_WAIT_L(n) asm volatile("s_waitcnt lgkmcnt(" #n ")" ::: "memory")
#define PG8_BAR __builtin_amdgcn_s_barrier()
#define PG8_SCHED __builtin_amdgcn_sched_barrier(0)
    Unit cur, nxt; int ui = 0;
    if (!S.next(0, cur)) return;
    typedef float f32x16_t __attribute__((ext_vector_type(16)));
    f32x16_t accq[2][2][2];
    Frag<F8> At[4], B0[2], B1[2];
    const char* cA = GATHER ? (const char*)g.A : (const char*)g.A + (size_t)cur.pm * tstep; const char* cB = (const char*)g.Bt + (size_t)cur.pn * tstep;
    if constexpr (GATHER) { PG8_GLOAD(gc, cur); asm volatile("s_waitcnt vmcnt(0)" ::: "memory"); }
    S.a_ready(cur);
    if constexpr (SP2) {
        PG8_STAGE(PG8_SB(0, 0), cB, voffB); PG8_STAGE(PG8_SB(0, 1), cB + hstep, voffB); PG8_STAGE_A(PG8_SA(0, 0), cA, 0, false); PG8_STAGE_A(PG8_SA(0, 1), cA, 1, false);
        if (wr == 1) PG8_BAR;
        PG8_WAIT_V(2); PG8_BAR;
        PG8_STAGE(PG8_SB(1, 0), cB + kstep, voffB); PG8_STAGE_A(PG8_SA(1, 0), cA + kstep, 0, false); PG8_STAGE(PG8_SB(1, 1), cB + hstep + kstep, voffB);
        PG8_WAIT_V(6); PG8_BAR;
    } else {
        PG8_STAGE(PG8_SB(0, 0), cB, voffB); PG8_STAGE(PG8_SA(0, 0), cA, voffA); PG8_STAGE(PG8_SB(0, 1), cB + hstep, voffB); PG8_STAGE(PG8_SA(0, 1), cA + hstep, voffA);
        if (wr == 1) PG8_BAR;
        PG8_WAIT_V(4); PG8_BAR;
        PG8_STAGE(PG8_SB(1, 0), cB + kstep, voffB); PG8_STAGE(PG8_SA(1, 0), cA + kstep, voffA); PG8_STAGE(PG8_SB(1, 1), cB + hstep + kstep, voffB);
        PG8_WAIT_V(6); PG8_BAR;
    }
    PG8_SCHED;
#pragma unroll
    for (int a = 0; a < 2; ++a)
#pragma unroll
        for (int b = 0; b < 2; ++b)
#pragma unroll
            for (int m = 0; m < 2; ++m)
#pragma unroll
                for (int i = 0; i < 16; ++i) accq[a][b][m][i] = 0.f;
    for (;;) {
        const bool has_next = S.next(ui + 1, nxt);
        const char* nA = GATHER ? (const char*)g.A : (has_next ? (const char*)g.A + (size_t)nxt.pm * tstep : cA); const char* nB = has_next ? (const char*)g.Bt + (size_t)nxt.pn * tstep : cB;
#pragma unroll 1
        for (int t = 0; t < nt; t += 2) {
            const bool last = (t == nt - 2);
            const char* a1 = cA + (size_t)(t + 1) * kstep;
            const char* a2 = last ? nA : cA + (size_t)(t + 2) * kstep; const char* b2 = last ? nB : cB + (size_t)(t + 2) * kstep;
            const char* a3 = a2 + kstep; const char* b3 = b2 + kstep;
            if (last && has_next) S.a_ready(nxt);
            if constexpr (SP2) {
            PG8_LDB(B0, 0, 0); PG8_LDB(B1, 0, 1); PG8_SCHED; PG8_LDA(At, 0, 0); PG8_STAGE_A(PG8_SA(1, 1), a1, 1, false);
            PG8_WAIT_V(8); PG8_WAIT_L(0); PG8_BAR; PG8_MMA(0, 0, At, B0); PG8_MMA(0, 1, At, B1); PG8_BAR; PG8_SCHED;
            PG8_LDA(At, 0, 1); PG8_STAGE(PG8_SB(0, 0), b2, voffB); PG8_STAGE(PG8_SB(0, 1), b2 + hstep, voffB); PG8_STAGE_A(PG8_SA(0, 0), a2, 0, last);
            PG8_WAIT_V(8); PG8_WAIT_L(0); PG8_BAR; PG8_MMA(1, 0, At, B0); PG8_MMA(1, 1, At, B1); PG8_BAR; PG8_SCHED;
            PG8_LDB(B0, 1, 0); PG8_LDB(B1, 1, 1); PG8_SCHED; PG8_LDA(At, 1, 0); PG8_STAGE_A(PG8_SA(0, 1), a2, 1, last);
            PG8_WAIT_V(8); PG8_WAIT_L(0); PG8_BAR; PG8_MMA(0, 0, At, B0); PG8_MMA(0, 1, At, B1); PG8_BAR; PG8_SCHED;
            PG8_LDA(At, 1, 1); PG8_STAGE(PG8_SB(1, 0), b3, voffB); PG8_STAGE(PG8_SB(1, 1), b3 + hstep, voffB); PG8_STAGE_A(PG8_SA(1, 0), a3, 0, last);
            PG8_WAIT_V(8); PG8_WAIT_L(0); PG8_BAR; PG8_MMA(1, 0, At, B0); PG8_MMA(1, 1, At, B1); PG8_BAR; PG8_SCHED;
            } else {
            PG8_LDB(B0, 0, 0); PG8_SCHED; PG8_LDA(At, 0, 0); PG8_STAGE(PG8_SA(1, 1), a1 + hstep, voffA);
            PG8_WAIT_L(8); PG8_BAR; PG8_WAIT_L(0); PG8_MMA(0, 0, At, B0); PG8_BAR; PG8_SCHED;
            PG8_LDB(B1, 0, 1); PG8_STAGE(PG8_SB(0, 0), b2, voffB);
            PG8_BAR; PG8_WAIT_L(0); PG8_MMA(0, 1, At, B1); PG8_BAR;
            PG8_LDA(At, 0, 1); PG8_STAGE(PG8_SA(0, 0), a2, voffA);
            PG8_BAR; PG8_WAIT_L(0); PG8_MMA(1, 0, At, B0); PG8_BAR; PG8_SCHED;
            PG8_STAGE(PG8_SB(0, 1), b2 + hstep, voffB);
            PG8_WAIT_V(6); PG8_BAR; PG8_MMA(1, 1, At, B1); PG8_BAR;
            PG8_LDB(B0, 1, 0); PG8_SCHED; PG8_LDA(At, 1, 0); PG8_STAGE(PG8_SA(0, 1), a2 + hstep, voffA);
            PG8_WAIT_L(8); PG8_BAR; PG8_WAIT_L(0); PG8_MMA(0, 0, At, B0); PG8_BAR; PG8_SCHED;
            PG8_LDB(B1, 1, 1); PG8_STAGE(PG8_SB(1, 0), b3, voffB);
            PG8_BAR; PG8_WAIT_L(0); PG8_MMA(0, 1, At, B1); PG8_BAR;
            PG8_LDA(At, 1, 1); PG8_STAGE(PG8_SA(1, 0), a3, voffA);
            PG8_BAR; PG8_WAIT_L(0); PG8_MMA(1, 0, At, B0); PG8_BAR; PG8_SCHED;
            PG8_STAGE(PG8_SB(1, 1), b3 + hstep, voffB);
            PG8_WAIT_V(6); PG8_BAR; PG8_MMA(1, 1, At, B1); PG8_BAR;
            }
        }
        if constexpr (ALIGN_EPI) { if (wr == 0) PG8_BAR; }
        if constexpr (!Epi::AFTER_DRAIN) { f32x4 acc[2][2][4][2];
            _Pragma("unroll") for (int a = 0; a < 2; ++a) _Pragma("unroll") for (int b = 0; b < 2; ++b) _Pragma("unroll") for (int m = 0; m < 4; ++m) _Pragma("unroll") for (int n = 0; n < 2; ++n) acc[a][b][m][n] = PG8_SUB(accq[a][b][m >> 1], 8 * (m & 1) + 4 * n);
            E(acc, cur, wr, wc, fr, fq); S.done(cur); }
        if (!has_next) break;
#pragma unroll
        for (int a = 0; a < 2; ++a)
#pragma unroll
            for (int b = 0; b < 2; ++b)
#pragma unroll
                for (int m = 0; m < 2; ++m)
#pragma unroll
                    for (int i = 0; i < 16; ++i) accq[a][b][m][i] = 0.f;
        cur = nxt; cA = nA; cB = nB; ++ui;
        if constexpr (ALIGN_EPI) { if (wr == 1) PG8_BAR; }
    }
    PG8_WAIT_V(0);
    if constexpr (!ALIGN_EPI) { if (wr == 0) PG8_BAR; }
    PG8_BAR;

#undef PG8_SA
#undef PG8_SB
#undef PG8_STAGE
#undef PG8_GLOAD
#undef PG8_STAGE_A
#undef PG8_LD1
#undef PG8_LDA
#undef PG8_LDB
#undef PG8_SUB
#undef PG8_INS
#undef PG8_MMA
#undef PG8_WAIT_V
#undef PG8_WAIT_L
#undef PG8_BAR
#undef PG8_SCHED
}
}


constexpr int NB = 8, SEQ = 2048, DMODEL = 1024, NT = NB * SEQ;
constexpr int DML = 512, DAT = 512, DPROJ = 2560;
constexpr int MH = 4, MDH = 128, AH = 8, ADH = 64;
constexpr int NE = 16, CAP = 256, DEXP = 2816, NPAIR = NE * NB * CAP;
constexpr float EPS = 1e-6f;
constexpr int NWAVES = 8, NTHR = 512;

constexpr size_t MiB = 1u << 20;
constexpr size_t WS_CTL = 0, CTL_ZERO_BYTES = 32768;
constexpr size_t WS_WIN = 1 * MiB;
constexpr size_t WS_WOUT = WS_WIN + (size_t)DPROJ * DMODEL * 2;
constexpr size_t WS_W13 = WS_WOUT + (size_t)DMODEL * DMODEL * 2;
constexpr size_t WS_W2 = WS_W13 + (size_t)NE * 2 * DEXP * DMODEL;
constexpr size_t WS_XN = WS_W2 + (size_t)NE * DMODEL * DEXP;
constexpr size_t WS_PROJ = WS_XN + (size_t)NT * DMODEL * 2;
constexpr size_t WS_AFF = WS_PROJ + (size_t)NT * DPROJ * 2;
constexpr size_t WS_SLOT = WS_AFF + (size_t)NT * NE * 4;
constexpr size_t WS_SELT = WS_SLOT + (size_t)NT * NE * 4;
constexpr size_t WS_SELG = WS_SELT + (size_t)NPAIR * 4;
constexpr size_t WS_GI = WS_SELG + (size_t)NPAIR * 4;
constexpr size_t WS_GF = WS_GI + (size_t)2 * NB * MH * SEQ * 4;
constexpr size_t WS_ROPE = WS_GF + (size_t)2 * NB * MH * SEQ * 4;
constexpr size_t WS_WT = WS_ROPE + (size_t)SEQ * 16 * 4;
constexpr size_t WS_MIX0 = WS_WT + 65536;
constexpr size_t WS_XC = WS_MIX0;
constexpr size_t WS_QM = WS_XC + (size_t)NT * DML * 2;
constexpr size_t WS_KM = WS_QM + (size_t)NT * DML * 2;
constexpr size_t WS_VM = WS_KM + (size_t)NT * DML * 2;
constexpr size_t WS_QR = WS_VM + (size_t)NT * DML * 2;
constexpr size_t WS_KR = WS_QR + (size_t)NT * DAT * 2;
constexpr size_t WS_VR = WS_KR + (size_t)NT * DAT * 2;
constexpr size_t WS_HFB = WS_VR + (size_t)NT * DAT * 2;
constexpr size_t WS_OPART = WS_HFB + (size_t)2 * NT * DML * 4;
constexpr size_t WS_OSTAT = WS_OPART + (size_t)3 * NT * DAT * 2;
constexpr size_t WS_MIX1 = WS_OSTAT + (size_t)3 * NT * AH * 2 * 4;
constexpr size_t WS_YO = WS_HFB;
constexpr size_t WS_H = WS_MIX0;
constexpr size_t WS_Y = WS_PROJ;
constexpr size_t WS_END = (WS_MIX1 > WS_H + (size_t)NPAIR * DEXP) ? WS_MIX1 : WS_H + (size_t)NPAIR * DEXP;
static_assert((size_t)NPAIR * DMODEL * 2 <= (size_t)NT * DPROJ * 2, "Y fits in proj");
static_assert(WS_H + (size_t)NPAIR * DEXP <= WS_HFB && (size_t)NT * DMODEL * 2 <= (size_t)2 * NT * DML * 4, "y lives in hfb, clear of H");
static_assert(WS_END <= (size_t)736 * MiB, "d_ws map must stay below 4x the largest input");
constexpr int CW_TMO = 0, CW_QHEAD = 64, CW_MDONE = 128, CW_P1DONE = 192, CW_ADONE = 256, CW_BAR = 4096;
static_assert((CW_BAR + 3456) * 4 <= (int)CTL_ZERO_BYTES, "control words inside the per-call memset");
constexpr int CVT_EARLY = (DMODEL / 64) * (DPROJ / 64) + (DMODEL / 64) * (DMODEL / 64);
constexpr int CVT_MOE = NE * (2 * (DMODEL / 64) * (DEXP / 64) + (DEXP / 64) * (DMODEL / 64)), CVT_BATCH = 8, CVT_NBATCH = CVT_MOE / CVT_BATCH;
static_assert(CVT_MOE % CVT_BATCH == 0, "conversion batches");

constexpr int RING_OFF = 0, RING_BYTES = 155648;
constexpr int LDSCTL_OFF = RING_BYTES, MISC_OFF = LDSCTL_OFF + 320;
constexpr int LDS_BYTES = 160 * 1024;

#define GAS __attribute__((address_space(1)))
#define LAS __attribute__((address_space(3)))
typedef unsigned short bf16;
typedef unsigned v4u __attribute__((ext_vector_type(4)));
typedef float f32x4 __attribute__((ext_vector_type(4)));
typedef short bf16x8 __attribute__((ext_vector_type(8)));
typedef GAS unsigned gu32;
typedef GAS unsigned long long gu64;
#define RLX_AGENT __ATOMIC_RELAXED, __HIP_MEMORY_SCOPE_AGENT
#define LDS_WAIT() asm volatile("s_waitcnt lgkmcnt(0)" ::: "memory")
#define VM_WAIT() asm volatile("s_waitcnt vmcnt(0)" ::: "memory")
__device__ __forceinline__ unsigned long long rt() { return __builtin_amdgcn_s_memrealtime(); }
__device__ __forceinline__ unsigned f2bf(float f) { unsigned u = __builtin_bit_cast(unsigned, f); return (u + 0x7fffu + ((u >> 16) & 1u)) >> 16; }
__device__ __forceinline__ unsigned pk2(float lo, float hi) { return f2bf(lo) | (f2bf(hi) << 16); }

#define XB_TMO      128
#define XB_XCNT(j)  (256  + 64 * (j))
#define XB_XSUB(j)  (1280 + 64 * (j))
#define XB_XGEN(j)  (2304 + 64 * (j))
#define XB_TOP      3328
#define XB_TOPGEN   3392
#define XCD_BAR_WORDS 3456
#define XB_SPIN_CAP (1u << 18)

__device__ __forceinline__ unsigned xb_ld(unsigned* p)              { return __hip_atomic_load(p, __ATOMIC_RELAXED, __HIP_MEMORY_SCOPE_AGENT); }
__device__ __forceinline__ unsigned xb_add(unsigned* p, unsigned v) { return __hip_atomic_fetch_add(p, v, __ATOMIC_RELAXED, __HIP_MEMORY_SCOPE_AGENT); }
__device__ __forceinline__ unsigned xb_xcc_id() { return (unsigned)__builtin_amdgcn_s_getreg((3 << 11) | 20) & 0xFu; }
#define XB_SPIN(cond, bar) do { unsigned _sp = 0; while (cond) { __builtin_amdgcn_s_sleep(1); \
    if ((++_sp & 255u) == 0u) { if (xb_ld(&(bar)[XB_TMO])) break; if (_sp > XB_SPIN_CAP) { atomicAdd(&(bar)[XB_TMO], 1u); break; } } } } while (0)

struct XcdBarrier {
    unsigned* bar; unsigned x;
    volatile LAS unsigned* st;
};

__device__ __forceinline__ XcdBarrier xcd_barrier_post(unsigned* bar, volatile LAS unsigned* st) {
    XcdBarrier b; b.bar = bar; b.x = xb_xcc_id(); b.st = st;
    if (threadIdx.x == 0) (void)xb_add(&bar[XB_XCNT(b.x)], 1u);
    return b;
}
__device__ __forceinline__ void xcd_barrier_complete(unsigned* bar, unsigned x, unsigned& nloc, unsigned& nx) {
    const unsigned G = gridDim.x * gridDim.y * gridDim.z;
    unsigned sum, cnt, mine, sp = 0u;
    for (;;) {
        sum = 0u; cnt = 0u; mine = 0u;
#pragma unroll
        for (unsigned j = 0; j < 16; ++j) { const unsigned c = xb_ld(&bar[XB_XCNT(j)]); sum += c; cnt += (c > 0u) ? 1u : 0u; mine = (j == x) ? c : mine; }
        if (sum == G) break;
        __builtin_amdgcn_s_sleep(1);
        if ((++sp & 255u) == 0u) { if (xb_ld(&bar[XB_TMO])) break; if (sp > XB_SPIN_CAP) { atomicAdd(&bar[XB_TMO], 1u); break; } }
    }
    nloc = mine > 0u ? mine : 1u; nx = cnt > 0u ? cnt : 1u;
}

__device__ __forceinline__ void xcd_barrier(const XcdBarrier& b) {
    asm volatile("s_waitcnt vmcnt(0)" ::: "memory");
    __syncthreads();
    if (threadIdx.x == 0) {
        unsigned* bar = b.bar;
        __builtin_amdgcn_s_waitcnt(0);
        unsigned nloc = b.st[0], nx = b.st[1];
        if (nloc == 0u) { xcd_barrier_complete(bar, b.x, nloc, nx); b.st[0] = nloc; b.st[1] = nx; }
        const unsigned old = xb_add(&bar[XB_XSUB(b.x)], 1u);
        const unsigned gen = old / nloc;
        if (old + 1u == (gen + 1u) * nloc) {
            __builtin_amdgcn_fence(__ATOMIC_RELEASE, "agent");
            asm volatile("s_waitcnt vmcnt(0)" ::: "memory");
            const unsigned og = xb_add(&bar[XB_TOP], 1u);
            const unsigned tg = og / nx;
            if (og + 1u == (tg + 1u) * nx) xb_add(&bar[XB_TOPGEN], 1u);
            else XB_SPIN(xb_ld(&bar[XB_TOPGEN]) == tg, bar);
            __builtin_amdgcn_fence(__ATOMIC_ACQUIRE, "agent");
            xb_add(&bar[XB_XGEN(b.x)], 1u);
            asm volatile("s_waitcnt vmcnt(0)" ::: "memory");
        } else {
            XB_SPIN(xb_ld(&bar[XB_XGEN(b.x)]) == gen, bar);
            __builtin_amdgcn_fence(__ATOMIC_ACQUIRE, "agent");
            asm volatile("s_waitcnt vmcnt(0)" ::: "memory");
        }
    }
    __syncthreads();
}


__device__ __forceinline__ float bf2f(unsigned short u) { return __uint_as_float((unsigned)u << 16); }
__device__ __forceinline__ float wave_sum(float v) {
#pragma unroll
    for (int o = 1; o < 64; o <<= 1) v += __shfl_xor(v, o);
    return v;
}
__device__ __forceinline__ float siluf(float x) { return x / (1.f + expf(-x)); }
__device__ __forceinline__ float logsigf(float x) { return fminf(x, 0.f) - log1pf(expf(-fabsf(x))); }

struct Args {
    const float* in[22]; float* out; unsigned char* ws; int ph_lo, ph_hi, li, pad;
};
struct Frame { LAS unsigned char* lds; int tid, lane, wave, G, bx; };

__device__ __forceinline__ void cvt_load(const float* W, int ldw, int k0, int n0, int lane, f32x4 (&r)[16]) {
    const int n4 = lane & 15, rp = lane >> 4;
#pragma unroll
    for (int it = 0; it < 8; ++it) {
        const float* p = W + (size_t)(k0 + 8 * it + 2 * rp) * ldw + n0 + 4 * n4;
        r[2 * it] = *(const GAS f32x4*)p; r[2 * it + 1] = *(const GAS f32x4*)(p + ldw);
    }
}
__device__ __forceinline__ void cvt_store(const f32x4 (&r)[16], unsigned char* dst  , int ldd  , LAS unsigned* scr, int lane) {
    const int n4 = lane & 15, rp = lane >> 4;
#pragma unroll
    for (int it = 0; it < 8; ++it) {
        const int kp = 4 * it + rp;
#pragma unroll
        for (int i = 0; i < 4; ++i) { const int n = 4 * n4 + i; scr[n * 32 + (((kp >> 2) ^ (n4 & 7)) << 2) + (kp & 3)] = pk2(r[2 * it][i], r[2 * it + 1][i]); }
    }
    LDS_WAIT(); asm volatile("" ::: "memory");
    const int c = lane & 7;
#pragma unroll
    for (int it = 0; it < 8; ++it) {
        const int n = 8 * it + (lane >> 3);
        const v4u o = *(const LAS v4u*)(scr + n * 32 + ((c ^ ((n >> 2) & 7)) << 2));
        *(GAS v4u*)(dst + (size_t)n * ldd + 16 * c) = o;
    }
    LDS_WAIT(); asm volatile("" ::: "memory");
}
__device__ __forceinline__ void cvt8_load(const float* W, int ldw, int k0, int n0, int lane, f32x4 (&r)[16]) {
    const int n4 = lane & 15, rp = lane >> 4;
#pragma unroll
    for (int it = 0; it < 4; ++it) {
        const float* p = W + (size_t)(k0 + 16 * it + 4 * rp) * ldw + n0 + 4 * n4;
#pragma unroll
        for (int q = 0; q < 4; ++q) r[4 * it + q] = __builtin_nontemporal_load((const GAS f32x4*)(p + (size_t)q * ldw));
    }
}
__device__ __forceinline__ void cvt8_store(const f32x4 (&r)[16], unsigned char* dst, int ldd, LAS unsigned* scr, int lane, float sc) {
    const int n4 = lane & 15, rp = lane >> 4;
#pragma unroll
    for (int it = 0; it < 4; ++it) {
        const int kq = 4 * it + rp;
#pragma unroll
        for (int i = 0; i < 4; ++i) { int w = 0; w = __builtin_amdgcn_cvt_pk_fp8_f32(r[4 * it][i] * sc, r[4 * it + 1][i] * sc, w, false); w = __builtin_amdgcn_cvt_pk_fp8_f32(r[4 * it + 2][i] * sc, r[4 * it + 3][i] * sc, w, true);
            scr[(4 * n4 + i) * 17 + kq] = (unsigned)w; }
    }
    LDS_WAIT(); asm volatile("" ::: "memory");
    const int c = lane & 3;
#pragma unroll
    for (int j = 0; j < 4; ++j) {
        const int n = 16 * j + (lane >> 2);
        const v4u o = {scr[n * 17 + 4 * c], scr[n * 17 + 4 * c + 1], scr[n * 17 + 4 * c + 2], scr[n * 17 + 4 * c + 3]};
        *(GAS v4u*)(dst + (size_t)n * ldd + 16 * c) = o;
    }
    LDS_WAIT(); asm volatile("" ::: "memory");
}
struct CvtItem { const float* W; int ldw, k0, n0; unsigned char* dst; int ldd; int f8; float sc; };
__device__ __forceinline__ bool cvt_item(const Args& a, int it, CvtItem& c) {
    unsigned char* ws = a.ws;
    constexpr int I_IN = (DMODEL / 64) * (DPROJ / 64), I_OUT = (DMODEL / 64) * (DMODEL / 64), I_W1 = (DMODEL / 64) * (DEXP / 64), I_W2 = (DEXP / 64) * (DMODEL / 64);
    constexpr int NITEMS = I_IN + I_OUT + NE * (2 * I_W1 + I_W2);
    if (it >= NITEMS) return false;
    if (it < I_IN) { const int nb = DPROJ / 64, kb = it / nb, n0 = (it % nb) * 64; c = {a.in[2], DPROJ, kb * 64, n0, ws + WS_WIN + ((size_t)n0 * DMODEL + kb * 64) * 2, DMODEL * 2, 0, 1.f}; return true; }
    it -= I_IN;
    if (it < I_OUT) { const int nb = DMODEL / 64, kb = it / nb, n0 = (it % nb) * 64; c = {a.in[15], DMODEL, kb * 64, n0, ws + WS_WOUT + ((size_t)n0 * DMODEL + kb * 64) * 2, DMODEL * 2, 0, 1.f}; return true; }
    it -= I_OUT;
    const int per_e = 2 * I_W1 + I_W2, e = it / per_e; it %= per_e;
    if (it < 2 * I_W1) { const int which = it / I_W1; it %= I_W1; const int nb = DEXP / 64, kb = it / nb, n0 = (it % nb) * 64;
        const float* W = a.in[which ? 19 : 18] + (size_t)e * DMODEL * DEXP;
        const size_t drow = (size_t)e * 2 * DEXP + (size_t)(n0 / 128) * 256 + (n0 % 128) + (which ? 128 : 0);
        c = {W, DEXP, kb * 64, n0, ws + WS_W13 + drow * DMODEL + kb * 64, DMODEL, 1, which ? 32.f * 0.6931471805599453f : 32.f * 1.4426950408889634f}; return true; }
    it -= 2 * I_W1;
    { const int nb = DMODEL / 64, kb = it / nb, n0 = (it % nb) * 64; const float* W = a.in[20] + (size_t)e * DEXP * DMODEL;
      c = {W, DMODEL, kb * 64, n0, ws + WS_W2 + ((size_t)e * DMODEL + n0) * DEXP + kb * 64, DEXP, 1, 64.f}; return true; }
}
__device__ __forceinline__ void p0_prologue(const Args& a, Frame& F) {
    LAS unsigned* scr = (LAS unsigned*)(F.lds + RING_OFF + F.wave * 8192);
    const int gw = F.bx * NWAVES + F.wave, NGW = F.G * NWAVES;
    {
        const float* x = a.in[0]; const float* g1 = a.in[1]; bf16* XN = (bf16*)(a.ws + WS_XN);
        f32x4 gq[4];
#pragma unroll
        for (int j = 0; j < 4; ++j) gq[j] = ((const GAS f32x4*)g1)[F.lane + 64 * j];
        f32x4 nx[4];
        if (gw < NT) {
#pragma unroll
            for (int j = 0; j < 4; ++j) nx[j] = ((const GAS f32x4*)(x + (size_t)gw * DMODEL) + F.lane)[64 * j]; }
        for (int m = gw; m < NT; m += NGW) {
            f32x4 v[4]; float s = 0.f;
#pragma unroll
            for (int j = 0; j < 4; ++j) v[j] = nx[j];
            if (m + NGW < NT) {
#pragma unroll
                for (int j = 0; j < 4; ++j) nx[j] = ((const GAS f32x4*)(x + (size_t)(m + NGW) * DMODEL) + F.lane)[64 * j]; }
#pragma unroll
            for (int j = 0; j < 4; ++j) s += (v[j].x * v[j].x + v[j].y * v[j].y) + (v[j].z * v[j].z + v[j].w * v[j].w);
            const float r = rsqrtf(wave_sum(s) * (1.f / DMODEL) + EPS);
            GAS unsigned long long* o8 = (GAS unsigned long long*)(XN + (size_t)m * DMODEL) + F.lane;
#pragma unroll
            for (int j = 0; j < 4; ++j) { const f32x4 w = gq[j];
                o8[64 * j] = (unsigned long long)pk2(v[j].x * r * w.x, v[j].y * r * w.y) | ((unsigned long long)pk2(v[j].z * r * w.z, v[j].w * r * w.w) << 32); }
        }
    }
    { float* rope = (float*)(a.ws + WS_ROPE);
      for (int i = F.bx * NTHR + F.tid; i < SEQ * 8; i += F.G * NTHR) { const int sidx = i >> 3, k = i & 7; const float ang = (float)sidx * powf(500000.0f, -2.0f * (float)k / 16.0f); rope[sidx * 16 + k] = cosf(ang); rope[sidx * 16 + 8 + k] = sinf(ang); } }
    { unsigned char* img = a.ws + WS_WT; const float* wf = a.in[8]; const float* wb = a.in[10];
      for (int i = F.bx * NTHR + F.tid; i < 16 * 1536; i += F.G * NTHR) { const int n = i / 1536, k = i % 1536; *(bf16*)(img + n * 3088 + k * 2) = (bf16)f2bf(n < 8 ? wf[(size_t)k * 8 + n] : wb[(size_t)k * 8 + n - 8]); } }
    CvtItem cur, nxt; f32x4 ra[16], rb[16];
#define CVT_LOAD(c, r) do { if ((c).f8) cvt8_load((c).W, (c).ldw, (c).k0, (c).n0, F.lane, r); else cvt_load((c).W, (c).ldw, (c).k0, (c).n0, F.lane, r); } while (0)
#define CVT_STORE(c, r) do { if ((c).f8) cvt8_store(r, (c).dst, (c).ldd, scr, F.lane, (c).sc); else cvt_store(r, (c).dst, (c).ldd, scr, F.lane); } while (0)
    int it = gw; bool have = it < CVT_EARLY && cvt_item(a, it, cur);
    if (have) CVT_LOAD(cur, ra);
    while (have) {
        const bool hn = (it + NGW < CVT_EARLY) && cvt_item(a, it + NGW, nxt);
        if (hn) CVT_LOAD(nxt, rb);
        CVT_STORE(cur, ra);
        it += NGW; have = hn; if (!have) break;
        cur = nxt;
        const bool hn2 = (it + NGW < CVT_EARLY) && cvt_item(a, it + NGW, nxt);
        if (hn2) CVT_LOAD(nxt, ra);
        CVT_STORE(cur, rb);
        it += NGW; have = hn2; cur = nxt;
    }
}
__device__ __forceinline__ bool cvt_batch(const Args& a, Frame& F, int stop_word, unsigned stop_target, int stop_word2 = -1, unsigned stop_target2 = 0u, int qword = CW_QHEAD) {
    gu32* ctl = (gu32*)(a.ws + WS_CTL);
    volatile LAS unsigned* bq = (volatile LAS unsigned*)(F.lds + LDSCTL_OFF + 64);
    LAS unsigned* scr = (LAS unsigned*)(F.lds + RING_OFF + F.wave * 8192);
    __syncthreads();
    if (F.tid == 0) {
        unsigned v = 0xffffffffu;
        bool stop = stop_word >= 0 && __hip_atomic_load(ctl + stop_word, RLX_AGENT) >= stop_target;
        if (stop && stop_word2 >= 0) stop = __hip_atomic_load(ctl + stop_word2, RLX_AGENT) >= stop_target2;
        if (!stop) v = __hip_atomic_fetch_add(ctl + qword, 1u, RLX_AGENT);
        bq[0] = v;
    }
    __syncthreads();
    const unsigned batch = bq[0];
    if (batch >= (unsigned)CVT_NBATCH) return false;
    const int it0 = CVT_EARLY + (int)batch * CVT_BATCH + F.wave;
    CvtItem c0; f32x4 ra[16];
    cvt_item(a, it0, c0); CVT_LOAD(c0, ra);
    CVT_STORE(c0, ra);
    return true;
}
#ifndef NATT
#define NATT 128
#endif
__device__ __forceinline__ void cvt_stream(const Args& a, Frame& F, int stop_word, unsigned stop_target, int stop_word2 = -1, unsigned stop_target2 = 0u, int qword = CW_QHEAD) {
    gu32* ctl = (gu32*)(a.ws + WS_CTL);
    volatile LAS unsigned* bq = (volatile LAS unsigned*)(F.lds + LDSCTL_OFF + 64);
    LAS unsigned* scr = (LAS unsigned*)(F.lds + RING_OFF + F.wave * 8192);
    unsigned vq = 0xffffffffu, f1 = 0u, f2 = 0u;
#define CVT_FETCH() do { bool stop_ = stop_word >= 0 && f1 >= stop_target && (stop_word2 < 0 || f2 >= stop_target2); \
        vq = stop_ ? 0xffffffffu : __hip_atomic_fetch_add(ctl + qword, 1u, RLX_AGENT); \
        if (stop_word >= 0) f1 = __hip_atomic_load(ctl + stop_word, RLX_AGENT); if (stop_word2 >= 0) f2 = __hip_atomic_load(ctl + stop_word2, RLX_AGENT); } while (0)
    __syncthreads();
    if (F.tid == 0) { CVT_FETCH(); bq[0] = vq; CVT_FETCH(); }
    __syncthreads();
    CvtItem ca, cb; f32x4 ra[16], rb[16];
    const unsigned b0 = bq[0];
    if (b0 >= (unsigned)CVT_NBATCH) return;
    cvt_item(a, CVT_EARLY + (int)b0 * CVT_BATCH + F.wave, ca); CVT_LOAD(ca, ra);
    for (;;) {
        if (F.tid == 0) { bq[1] = vq; CVT_FETCH(); }
        __syncthreads();
        const unsigned b1 = bq[1]; const bool h1 = b1 < (unsigned)CVT_NBATCH;
        if (h1) { cvt_item(a, CVT_EARLY + (int)b1 * CVT_BATCH + F.wave, cb); CVT_LOAD(cb, rb); }
        CVT_STORE(ca, ra);
        if (!h1) break;
        if (F.tid == 0) { bq[0] = vq; CVT_FETCH(); }
        __syncthreads();
        const unsigned b2 = bq[0]; const bool h2 = b2 < (unsigned)CVT_NBATCH;
        if (h2) { cvt_item(a, CVT_EARLY + (int)b2 * CVT_BATCH + F.wave, ca); CVT_LOAD(ca, ra); }
        CVT_STORE(cb, rb);
        if (!h2) break;
    }
#undef CVT_FETCH
}
#ifndef CVT_PIPE
#define CVT_PIPE 0
#endif
__device__ __forceinline__ void cvt_run(const Args& a, Frame& F, int stop_word, unsigned stop_target, int stop_word2 = -1, unsigned stop_target2 = 0u, int qword = CW_QHEAD) {
    if (CVT_PIPE) cvt_stream(a, F, stop_word, stop_target, stop_word2, stop_target2, qword);
    else { while (cvt_batch(a, F, stop_word, stop_target, stop_word2, stop_target2, qword)) {} }
}
#undef CVT_LOAD
#undef CVT_STORE

constexpr int P2_STR = 3088;
constexpr int P2_WT = 0, P2_TILE = 16 * P2_STR, P2_PART = 32 * P2_STR, P2_WQKV = P2_PART + 8192, P2_CONV = P2_WQKV + 3 * 2048 * 4;
static_assert(P2_CONV + 6 * 512 * 4 <= RING_BYTES, "prep LDS map");
__device__ __forceinline__ float bflo(unsigned u) { return __uint_as_float(u << 16); }
__device__ __forceinline__ float bfhi(unsigned u) { return __uint_as_float(u & 0xffff0000u); }
__device__ __forceinline__ void p2_prep(const Args& a, Frame& F) {
    LAS unsigned char* L = F.lds + RING_OFF;
    const bf16* proj = (const bf16*)(a.ws + WS_PROJ);
    const float* conv_w = a.in[3]; const float* conv_b = a.in[4]; const float* wq = a.in[5]; const float* wk = a.in[6]; const float* wv = a.in[7];
    const float* wif_f = a.in[8]; const float* bif_f = a.in[9]; const float* wif_b = a.in[10]; const float* bif_b = a.in[11];
    bf16* xc = (bf16*)(a.ws + WS_XC); bf16* qm = (bf16*)(a.ws + WS_QM); bf16* km = (bf16*)(a.ws + WS_KM); bf16* vm = (bf16*)(a.ws + WS_VM);
    float* gI = (float*)(a.ws + WS_GI); float* gF = (float*)(a.ws + WS_GF); const float* rope = (const float*)(a.ws + WS_ROPE);
    bf16* qr = (bf16*)(a.ws + WS_QR); bf16* kr = (bf16*)(a.ws + WS_KR); bf16* vr = (bf16*)(a.ws + WS_VR);
    const int tid = F.tid, lane = F.lane, w = F.wave, c0 = 8 * lane, c16 = lane & 15, g = lane >> 4;
    LAS float* wqkv = (LAS float*)(L + P2_WQKV); LAS float* convl = (LAS float*)(L + P2_CONV); LAS float* part = (LAS float*)(L + P2_PART);
    __syncthreads();
    {
        const v4u* img = (const v4u*)(a.ws + WS_WT);
        v4u wi[7]; f32x4 wa[3], wb2[3], wc[3], cv[2];
#pragma unroll
        for (int i = 0; i < 7; ++i) { const int idx = tid + NTHR * i; wi[i] = idx < 16 * P2_STR / 16 ? img[idx] : (v4u){0u, 0u, 0u, 0u}; }
        wa[0] = ((const f32x4*)wq)[tid]; wb2[0] = ((const f32x4*)wk)[tid]; wc[0] = ((const f32x4*)wv)[tid];
        cv[0] = ((const f32x4*)conv_w)[tid]; cv[1] = tid < 128 ? ((const f32x4*)conv_w)[512 + tid] : ((const f32x4*)conv_b)[(tid - 128) & 127];
#pragma unroll
        for (int i = 0; i < 7; ++i) { const int idx = tid + NTHR * i; if (idx < 16 * P2_STR / 16) *(LAS v4u*)(L + P2_WT + idx * 16) = wi[i]; }
        ((LAS f32x4*)wqkv)[tid] = wa[0]; ((LAS f32x4*)wqkv)[512 + tid] = wb2[0] * 0.08838834764831845f; ((LAS f32x4*)wqkv)[1024 + tid] = wc[0];
        ((LAS f32x4*)convl)[tid] = cv[0];
        if (tid < 128) ((LAS f32x4*)convl)[512 + tid] = cv[1]; else if (tid < 256) ((LAS f32x4*)convl)[640 + tid - 128] = cv[1];
    }
    __syncthreads();
    float cw[5][8], cb[8];
#pragma unroll
    for (int t5 = 0; t5 < 5; ++t5) { const f32x4 x0 = *(const LAS f32x4*)(convl + t5 * 512 + c0), x1 = *(const LAS f32x4*)(convl + t5 * 512 + c0 + 4);
#pragma unroll
        for (int i = 0; i < 4; ++i) { cw[t5][i] = x0[i]; cw[t5][4 + i] = x1[i]; } }
    { const f32x4 x0 = *(const LAS f32x4*)(convl + 2560 + c0), x1 = *(const LAS f32x4*)(convl + 2560 + c0 + 4);
#pragma unroll
      for (int i = 0; i < 4; ++i) { cb[i] = x0[i]; cb[4 + i] = x1[i]; } }
    for (int tile = F.bx; tile < NT / 64; tile += F.G) {
        const int t0 = tile * 64, b = t0 / SEQ, s0 = t0 % SEQ;
        v4u xr[12];
#pragma unroll
        for (int i = 0; i < 12; ++i) { const int sx = s0 + 8 * w - 2 + i; xr[i] = (sx >= 0 && sx < SEQ) ? *(const v4u*)(proj + (size_t)(b * SEQ + sx) * DPROJ + c0) : (v4u){0u, 0u, 0u, 0u}; }
#pragma unroll
        for (int rnd = 0; rnd < 4; ++rnd) {
#pragma unroll
            for (int tt = 0; tt < 2; ++tt) {
                const int ti = 2 * rnd + tt;
                float xcv[8], xmv[8];
#pragma unroll
                for (int i = 0; i < 4; ++i) {
                    float a0 = cb[2 * i], a1 = cb[2 * i + 1];
#pragma unroll
                    for (int t5 = 0; t5 < 5; ++t5) { a0 += cw[t5][2 * i] * bflo(xr[ti + t5][i]); a1 += cw[t5][2 * i + 1] * bfhi(xr[ti + t5][i]); }
                    xcv[2 * i] = a0 * __builtin_amdgcn_rcpf(1.f + __expf(-a0)); xcv[2 * i + 1] = a1 * __builtin_amdgcn_rcpf(1.f + __expf(-a1));
                    xmv[2 * i] = bflo(xr[ti + 2][i]); xmv[2 * i + 1] = bfhi(xr[ti + 2][i]);
                }
                float qv[8], kv[8], vv[8];
#pragma unroll
                for (int grp = 0; grp < 2; ++grp) {
                    const LAS f32x4* wp = (const LAS f32x4*)(wqkv + (2 * lane + grp) * 16);
                    f32x4 q4 = {0.f, 0.f, 0.f, 0.f}, k4 = q4, v4 = q4;
#pragma unroll
                    for (int i = 0; i < 4; ++i) { q4 += wp[i] * xcv[4 * grp + i]; k4 += wp[512 + i] * xcv[4 * grp + i]; v4 += wp[1024 + i] * xmv[4 * grp + i]; }
#pragma unroll
                    for (int o = 0; o < 4; ++o) { qv[4 * grp + o] = q4[o]; kv[4 * grp + o] = k4[o]; vv[4 * grp + o] = v4[o]; }
                }
                const v4u xcp = {pk2(xcv[0], xcv[1]), pk2(xcv[2], xcv[3]), pk2(xcv[4], xcv[5]), pk2(xcv[6], xcv[7])};
                const v4u qp = {pk2(qv[0], qv[1]), pk2(qv[2], qv[3]), pk2(qv[4], qv[5]), pk2(qv[6], qv[7])};
                const v4u kp = {pk2(kv[0], kv[1]), pk2(kv[2], kv[3]), pk2(kv[4], kv[5]), pk2(kv[6], kv[7])};
                const v4u vp = {pk2(vv[0], vv[1]), pk2(vv[2], vv[3]), pk2(vv[4], vv[5]), pk2(vv[6], vv[7])};
                const size_t go = (size_t)(t0 + 8 * w + ti) * DML + c0;
                *(v4u*)(xc + go) = xcp; *(v4u*)(qm + go) = qp; *(v4u*)(km + go) = kp; *(v4u*)(vm + go) = vp;
                LAS unsigned char* tr = L + P2_TILE + (2 * w + tt) * P2_STR + c0 * 2;
                *(LAS v4u*)tr = qp; *(LAS v4u*)(tr + 1024) = kp; *(LAS v4u*)(tr + 2048) = vp;
            }
            __syncthreads();
            f32x4 D = {0.f, 0.f, 0.f, 0.f};
#pragma unroll
            for (int kk = 0; kk < 6; ++kk) { const int ks = 6 * w + kk;
                const bf16x8 A = *(const LAS bf16x8*)(L + P2_TILE + c16 * P2_STR + (32 * ks + 8 * g) * 2);
                const bf16x8 B = *(const LAS bf16x8*)(L + P2_WT + c16 * P2_STR + (32 * ks + 8 * g) * 2);
                D = __builtin_amdgcn_mfma_f32_16x16x32_bf16(A, B, D, 0, 0, 0); }
#pragma unroll
            for (int r = 0; r < 4; ++r) part[w * 256 + (4 * g + r) * 16 + c16] = D[r];
            __syncthreads();
            if (tid < 256) {
                const int row = tid >> 4, n = tid & 15;
                float sm = 0.f;
#pragma unroll
                for (int ww = 0; ww < 8; ++ww) sm += part[ww * 256 + tid];
                const int dirn = n >> 3, j = n & 7, hh = j & 3;
                sm += dirn ? bif_b[j] : bif_f[j];
                const int sx = s0 + 8 * (row >> 1) + 2 * rnd + (row & 1);
                const size_t off = ((size_t)(dirn * NB + b) * MH + hh) * SEQ + sx;
                if (j < 4) gI[off] = sm; else gF[off] = logsigf(sm);
            }
        }
    }
}

typedef short s16x4 __attribute__((ext_vector_type(4)));
typedef short v4i16_t __attribute__((ext_vector_type(4)));
constexpr int ML_STR = 288, ML_TILE = 64 * ML_STR, ML_WSTR = 144;
constexpr int ML_Q = 0, ML_K = ML_TILE, ML_V = 2 * ML_TILE, ML_W = 3 * ML_TILE, ML_PSUM = ML_W + 64 * ML_WSTR, ML_QN = ML_PSUM + 1024, ML_NBUF = ML_QN + 256, ML_SCR = ML_NBUF + 1024;
static_assert(ML_SCR + 8 * 1024 <= RING_BYTES, "mlstm LDS map");
__device__ __forceinline__ unsigned cvtpk2(float lo, float hi) { unsigned r; asm volatile("v_cvt_pk_bf16_f32 %0, %1, %2" : "=v"(r) : "v"(lo), "v"(hi)); return r; }
__device__ __forceinline__ s16x4 trr(LAS unsigned char* p) { return __builtin_bit_cast(s16x4, __builtin_amdgcn_ds_read_tr16_b64_v4i16((LAS v4i16_t*)p)); }
__device__ __forceinline__ bf16x8 cat8(s16x4 a, s16x4 b) { return (bf16x8){a[0], a[1], a[2], a[3], b[0], b[1], b[2], b[3]}; }
__device__ __forceinline__ float scan_add(float x, int lane) {
#pragma unroll
    for (int o = 1; o < 64; o <<= 1) { const float v = __shfl_up(x, o); if (lane >= o) x += v; }
    return x;
}
__device__ __forceinline__ float scan_max(float x, int lane) {
#pragma unroll
    for (int o = 1; o < 64; o <<= 1) { const float v = __shfl_up(x, o); if (lane >= o) x = fmaxf(x, v); }
    return x;
}
constexpr int ML_SCAL = ML_SCR + 8 * 1024;
constexpr int ML_CH = ML_SCAL + 4 * 2048 * 4;
static_assert(ML_CH + 4 * 32 * 4 <= RING_BYTES, "mlstm LDS map 2");
template <int MLV>
__device__ __forceinline__ void mlstm_item(const Args& a, Frame& F, int item) {
    const int dir = item & 1, h = (item >> 1) & 3, b = item >> 3;
    LAS unsigned char* L = F.lds + RING_OFF;
    const int tid = F.tid, w = F.wave; int lane = F.lane, c16 = lane & 15, g = lane >> 4;
    const bf16* qm = (const bf16*)(a.ws + WS_QM); const bf16* km = (const bf16*)(a.ws + WS_KM); const bf16* vm = (const bf16*)(a.ws + WS_VM);
    const float* gi = (const float*)(a.ws + WS_GI) + ((size_t)(dir * NB + b) * MH + h) * SEQ;
    const float* gf = (const float*)(a.ws + WS_GF) + ((size_t)(dir * NB + b) * MH + h) * SEQ;
    bf16* hout = (bf16*)(a.ws + WS_HFB) + (size_t)dir * NT * DML;
    LAS float* scr = (LAS float*)(L + ML_SCR + w * 1024);
    LAS float* Psum = (LAS float*)(L + ML_PSUM); LAS float* qn = (LAS float*)(L + ML_QN); LAS float* nbuf = (LAS float*)(L + ML_NBUF);
    LAS float* s_isc = (LAS float*)(L + ML_SCAL); LAS float* s_rt = s_isc + 2048; LAS float* s_u = s_isc + 4096; LAS float* s_emt = s_isc + 6144;
    LAS float* c_decay = (LAS float*)(L + ML_CH); LAS float* c_f = c_decay + 32; LAS float* c_cref = c_decay + 64; LAS float* c_gtot = c_decay + 96;
    int srow = tid >> 3, spart = tid & 7;
#define hoff ((size_t)h * MDH + 16 * spart)
    f32x4 Cacc[8];
#pragma unroll
    for (int te = 0; te < 8; ++te) Cacc[te] = (f32x4){0.f, 0.f, 0.f, 0.f};
    v4u rq[2], rk[2], rv[2];
    __syncthreads();
    { const int pos = dir ? (SEQ - 1 - srow) : srow; const size_t ro = (size_t)(b * SEQ + pos) * DML + hoff;
      rq[0] = *(const v4u*)(qm + ro); rq[1] = *(const v4u*)(qm + ro + 8); rk[0] = *(const v4u*)(km + ro); rk[1] = *(const v4u*)(km + ro + 8); rv[0] = *(const v4u*)(vm + ro); rv[1] = *(const v4u*)(vm + ro + 8); }
#pragma unroll
    for (int q = 0; q < 4; ++q) {
        const int cc = 4 * w + q, j = cc * 64 + lane, pos = dir ? (SEQ - 1 - j) : j;
        const float ig = gi[pos], lf = gf[pos];
        const float bb = scan_add(lf, lane), x = ig - bb, pm = scan_max(x, lane);
        s_emt[j] = bb; s_u[j] = x; s_rt[j] = pm;
        if (lane == 63) { c_cref[cc] = pm; c_gtot[cc] = bb; }
    }
    if (tid < 256) nbuf[tid] = 0.f;
    __syncthreads();
    {
        float m_prev = 0.f, mp0 = 0.f, mp1 = 0.f, mp2 = 0.f, mp3 = 0.f;
#pragma unroll 1
        for (int cc = 0; cc < 32; ++cc) {
            const float cr = c_cref[cc], gt = c_gtot[cc];
            const int q = cc - 4 * w;
            mp0 = (q == 0) ? m_prev : mp0; mp1 = (q == 1) ? m_prev : mp1; mp2 = (q == 2) ? m_prev : mp2; mp3 = (q == 3) ? m_prev : mp3;
            m_prev = gt + fmaxf(m_prev, cr);
        }
        const float mp[4] = {mp0, mp1, mp2, mp3};
#pragma unroll
        for (int q = 0; q < 4; ++q) {
            const int cc = 4 * w + q, j = cc * 64 + lane;
            const float bb = s_emt[j], x = s_u[j], pm = s_rt[j], cr = c_cref[cc];
            const float mx = fmaxf(mp[q], pm);
            s_isc[j] = expf(mp[q] - mx); s_rt[j] = expf(cr - mx); s_u[j] = expf(x - cr); s_emt[j] = expf(-(bb + mx));
            if (lane == 0) { const float M = fmaxf(mp[q], cr); c_decay[cc] = expf(mp[q] - M); c_f[cc] = expf(cr - M); }
        }
    }
    __syncthreads();
#define ML_STAGE(ccn) do { const float us = s_u[(ccn) * 64 + srow]; \
        _Pragma("unroll") for (int i = 0; i < 2; ++i) { \
            *(LAS v4u*)(L + ML_Q + srow * ML_STR + spart * 32 + 16 * i) = rq[i]; *(LAS v4u*)(L + ML_V + srow * ML_STR + spart * 32 + 16 * i) = rv[i]; \
            v4u o; _Pragma("unroll") for (int j = 0; j < 4; ++j) o[j] = cvtpk2(__uint_as_float(rk[i][j] << 16) * us, __uint_as_float(rk[i][j] & 0xffff0000u) * us); \
            *(LAS v4u*)(L + ML_K + srow * ML_STR + spart * 32 + 16 * i) = o; } } while (0)
    ML_STAGE(0);
    { const int j = 64 + srow, pos = dir ? (SEQ - 1 - j) : j; const size_t ro = (size_t)(b * SEQ + pos) * DML + hoff;
      rq[0] = *(const v4u*)(qm + ro); rq[1] = *(const v4u*)(qm + ro + 8); rk[0] = *(const v4u*)(km + ro); rk[1] = *(const v4u*)(km + ro + 8); rv[0] = *(const v4u*)(vm + ro); rv[1] = *(const v4u*)(vm + ro + 8); }
    __syncthreads();
    for (int cc = 0; cc < SEQ / 64; ++cc) {
        asm volatile("" : "+v"(lane), "+v"(c16), "+v"(g), "+v"(srow), "+v"(spart));
        const int p = cc & 1;
        const bool more = (cc + 1 < SEQ / 64);
        const float decay = c_decay[cc], ff = c_f[cc];
        f32x4 O[4];
#pragma unroll
        for (int ti = 0; ti < 4; ++ti) O[ti] = (f32x4){0.f, 0.f, 0.f, 0.f};
        if constexpr (!(MLV & 8)) {
            bf16x8 Cb[4];
#pragma unroll
            for (int ks = 0; ks < 4; ++ks) { v4u t; t.x = cvtpk2(Cacc[2 * ks][0], Cacc[2 * ks][1]); t.y = cvtpk2(Cacc[2 * ks][2], Cacc[2 * ks][3]); t.z = cvtpk2(Cacc[2 * ks + 1][0], Cacc[2 * ks + 1][1]); t.w = cvtpk2(Cacc[2 * ks + 1][2], Cacc[2 * ks + 1][3]); Cb[ks] = __builtin_bit_cast(bf16x8, t); }
            f32x4 IV[4];
#pragma unroll
            for (int kh2 = 0; kh2 < 2; ++kh2) {
                bf16x8 QA[4][2];
#pragma unroll
                for (int ti = 0; ti < 4; ++ti)
#pragma unroll
                    for (int k2 = 0; k2 < 2; ++k2) QA[ti][k2] = *(const LAS bf16x8*)(L + ML_Q + (16 * ti + c16) * ML_STR + (32 * (2 * kh2 + k2) + 8 * g) * 2);
                __builtin_amdgcn_sched_barrier(0);
#pragma unroll
                for (int k2 = 0; k2 < 2; ++k2)
#pragma unroll
                    for (int ti = 0; ti < 4; ++ti) O[ti] = __builtin_amdgcn_mfma_f32_16x16x32_bf16(QA[ti][k2], Cb[2 * kh2 + k2], O[ti], 0, 0, 0);
                __builtin_amdgcn_sched_barrier(0);
            }
#pragma unroll
            for (int ti = 0; ti < 4; ++ti) IV[ti] = *(const LAS f32x4*)(s_isc + cc * 64 + 16 * ti + 4 * g);
#pragma unroll
            for (int ti = 0; ti < 4; ++ti) O[ti] = O[ti] * IV[ti];
            __builtin_amdgcn_sched_barrier(0);
        }
        if constexpr (!(MLV & 2)) {
            const int ti = w >> 1, t = 16 * ti + c16; const float rtv = s_rt[cc * 64 + t];
            const int si0 = 2 * (w & 1);
            bf16x8 KA[2][4], QB[4];
#pragma unroll
            for (int ks = 0; ks < 4; ++ks) { QB[ks] = *(const LAS bf16x8*)(L + ML_Q + (16 * ti + c16) * ML_STR + (32 * ks + 8 * g) * 2);
#pragma unroll
                for (int sj = 0; sj < 2; ++sj) KA[sj][ks] = *(const LAS bf16x8*)(L + ML_K + (16 * (si0 + sj) + c16) * ML_STR + (32 * ks + 8 * g) * 2); }
            __builtin_amdgcn_sched_barrier(0);
            f32x4 Dt[2] = {{0.f, 0.f, 0.f, 0.f}, {0.f, 0.f, 0.f, 0.f}};
#pragma unroll
            for (int ks = 0; ks < 4; ++ks)
#pragma unroll
                for (int sj = 0; sj < 2; ++sj) Dt[sj] = __builtin_amdgcn_mfma_f32_16x16x32_bf16(KA[sj][ks], QB[ks], Dt[sj], 0, 0, 0);
#pragma unroll
            for (int sj = 0; sj < 2; ++sj) {
                const int si = si0 + sj;
                f32x4 D = Dt[sj]; float ps = 0.f;
#pragma unroll
                for (int r = 0; r < 4; ++r) { const int sx = 16 * si + 4 * g + r; const float v = (si <= ti && sx <= t) ? D[r] : 0.f; D[r] = v; ps += v; }
                *(LAS unsigned long long*)(L + ML_W + t * ML_WSTR + (16 * si + 4 * g) * 2) = (unsigned long long)cvtpk2(D[0] * rtv, D[1] * rtv) | ((unsigned long long)cvtpk2(D[2] * rtv, D[3] * rtv) << 32);
                ps += __shfl_xor(ps, 16); ps += __shfl_xor(ps, 32);
                if (g == 0) Psum[t * 4 + si] = ps;
            }
            __builtin_amdgcn_sched_barrier(0);
        }
        {
            const LAS unsigned char* qp = L + ML_Q + srow * ML_STR + spart * 32;
            const v4u q0 = *(const LAS v4u*)qp, q1 = *(const LAS v4u*)(qp + 16);
            const LAS f32x4* np = (const LAS f32x4*)(nbuf + p * 128 + 16 * spart);
            const f32x4 n0 = np[0], n1 = np[1], n2 = np[2], n3 = np[3];
            float d = 0.f;
            d += __uint_as_float(q0[0] << 16) * n0[0] + __uint_as_float(q0[0] & 0xffff0000u) * n0[1] + __uint_as_float(q0[1] << 16) * n0[2] + __uint_as_float(q0[1] & 0xffff0000u) * n0[3];
            d += __uint_as_float(q0[2] << 16) * n1[0] + __uint_as_float(q0[2] & 0xffff0000u) * n1[1] + __uint_as_float(q0[3] << 16) * n1[2] + __uint_as_float(q0[3] & 0xffff0000u) * n1[3];
            d += __uint_as_float(q1[0] << 16) * n2[0] + __uint_as_float(q1[0] & 0xffff0000u) * n2[1] + __uint_as_float(q1[1] << 16) * n2[2] + __uint_as_float(q1[1] & 0xffff0000u) * n2[3];
            d += __uint_as_float(q1[2] << 16) * n3[0] + __uint_as_float(q1[2] & 0xffff0000u) * n3[1] + __uint_as_float(q1[3] << 16) * n3[2] + __uint_as_float(q1[3] & 0xffff0000u) * n3[3];
            d += __shfl_xor(d, 1); d += __shfl_xor(d, 2); d += __shfl_xor(d, 4);
            if (spart == 0) qn[srow] = d;
        }
        bf16x8 Vf[2];
        {
            const int q4 = c16 >> 2, p4 = c16 & 3;
#pragma unroll
            for (int ks = 0; ks < 2; ++ks) {
                LAS unsigned char* vp = L + ML_V + (32 * ks + 4 * g + q4) * ML_STR + (16 * w + 4 * p4) * 2;
                Vf[ks] = cat8(trr(vp), trr(vp + 16 * ML_STR));
            }
            f32x4 dn = {0.f, 0.f, 0.f, 0.f};
            { unsigned one2 = 0x3F803F80u; asm volatile("" : "+v"(one2)); const bf16x8 ones = __builtin_bit_cast(bf16x8, (v4u){one2, one2, one2, one2});
              LAS unsigned char* kw = L + ML_K + (4 * g + q4) * ML_STR + (32 * (w >> 1) + 8 * p4 + 4 * (w & 1)) * 2;
              const bf16x8 A0 = cat8(trr(kw), trr(kw + 16 * ML_STR)), A1 = cat8(trr(kw + 32 * ML_STR), trr(kw + 48 * ML_STR));
              dn = __builtin_amdgcn_mfma_f32_16x16x32_bf16(A0, ones, dn, 0, 0, 0); dn = __builtin_amdgcn_mfma_f32_16x16x32_bf16(A1, ones, dn, 0, 0, 0); }
            if constexpr (!(MLV & 4))
#pragma unroll
            for (int th = 0; th < 4; ++th) {
                bf16x8 KT[2][2];
#pragma unroll
                for (int t2 = 0; t2 < 2; ++t2)
#pragma unroll
                    for (int ks = 0; ks < 2; ++ks) { const int te = 2 * th + t2; LAS unsigned char* kp = L + ML_K + (32 * ks + 4 * g + q4) * ML_STR + (32 * (te >> 1) + 8 * p4 + 4 * (te & 1)) * 2; KT[t2][ks] = cat8(trr(kp), trr(kp + 16 * ML_STR)); }
                __builtin_amdgcn_sched_barrier(0);
                f32x4 dC[2];
#pragma unroll
                for (int t2 = 0; t2 < 2; ++t2) dC[t2] = __builtin_amdgcn_mfma_f32_16x16x32_bf16(KT[t2][0], Vf[0], (f32x4){0.f, 0.f, 0.f, 0.f}, 0, 0, 0);
#pragma unroll
                for (int t2 = 0; t2 < 2; ++t2) dC[t2] = __builtin_amdgcn_mfma_f32_16x16x32_bf16(KT[t2][1], Vf[1], dC[t2], 0, 0, 0);
#pragma unroll
                for (int t2 = 0; t2 < 2; ++t2) Cacc[2 * th + t2] = Cacc[2 * th + t2] * decay + dC[t2] * ff;
            }
            __builtin_amdgcn_sched_barrier(0);
            if (c16 == 0) { const int ne = 32 * (w >> 1) + 8 * g + 4 * (w & 1); const f32x4 nold = *(const LAS f32x4*)(nbuf + p * 128 + ne); *(LAS f32x4*)(nbuf + (p ^ 1) * 128 + ne) = nold * decay + dn * ff; }
        }
        __syncthreads();
        {
            bf16x8 WA[4][2];
#pragma unroll
            for (int ti = 0; ti < 4; ++ti)
#pragma unroll
                for (int ks = 0; ks < 2; ++ks) if (ks <= (ti >> 1)) { const LAS unsigned char* wp = L + ML_W + (16 * ti + c16) * ML_WSTR + (32 * ks + 4 * g) * 2; WA[ti][ks] = cat8(*(const LAS s16x4*)wp, *(const LAS s16x4*)(wp + 32)); }
            __builtin_amdgcn_sched_barrier(0);
#pragma unroll
            for (int ks = 0; ks < 2; ++ks)
#pragma unroll
                for (int ti = 0; ti < 4; ++ti) if (ks <= (ti >> 1)) O[ti] = __builtin_amdgcn_mfma_f32_16x16x32_bf16(WA[ti][ks], Vf[ks], O[ti], 0, 0, 0);
        }
        {
            const f32x4 pv = *(const LAS f32x4*)(Psum + 4 * lane);
            const float den = s_rt[cc * 64 + lane] * ((pv[0] + pv[1]) + (pv[2] + pv[3])) + s_isc[cc * 64 + lane] * qn[lane];
            scr[lane] = 1.f / fmaxf(fabsf(den), s_emt[cc * 64 + lane]);
#pragma unroll
            for (int ti = 0; ti < 4; ++ti) {
                const f32x4 rd = *(const LAS f32x4*)(scr + 16 * ti + 4 * g);
#pragma unroll
                for (int r = 0; r < 4; ++r) { const int j = cc * 64 + 16 * ti + 4 * g + r, pos = dir ? (SEQ - 1 - j) : j;
                    if constexpr (MLV & 1) { asm volatile("" :: "v"(O[ti][r] * rd[r])); } else hout[(size_t)(b * SEQ + pos) * DML + h * MDH + 16 * w + c16] = (bf16)f2bf(O[ti][r] * rd[r]); }
            }
        }
        if (more) { ML_STAGE(cc + 1); }
        if (cc + 2 < SEQ / 64) { const int j = (cc + 2) * 64 + srow, pos = dir ? (SEQ - 1 - j) : j; const size_t ro = (size_t)(b * SEQ + pos) * DML + hoff;
            rq[0] = *(const v4u*)(qm + ro); rq[1] = *(const v4u*)(qm + ro + 8); rk[0] = *(const v4u*)(km + ro); rk[1] = *(const v4u*)(km + ro + 8); rv[0] = *(const v4u*)(vm + ro); rv[1] = *(const v4u*)(vm + ro + 8); }
        __syncthreads();
    }
#undef ML_STAGE
#undef hoff
}
__device__ __forceinline__ void p3_mlstm(const Args& a, Frame& F) {
    bool any = false;
    for (int item = F.bx; item < NB * MH * 2; item += F.G) { mlstm_item<0>(a, F, item); any = true;
        __syncthreads();
        if (F.tid == 0) __hip_atomic_fetch_add((gu32*)(a.ws + WS_CTL) + CW_MDONE, 1u, RLX_AGENT); }
    if (any && F.G == 256) cvt_run(a, F, CW_MDONE, (unsigned)(NB * MH * 2), CW_ADONE, (unsigned)NATT);
    __syncthreads();
}
typedef float f32x16 __attribute__((ext_vector_type(16)));
__device__ __forceinline__ unsigned cvtpk(float lo, float hi) { unsigned r; asm volatile("v_cvt_pk_bf16_f32 %0, %1, %2" : "=v"(r) : "v"(lo), "v"(hi)); return r; }
#ifndef ATT_VAR
#define ATT_VAR 0
#endif
template <int VAR>
__device__ __forceinline__ void attn_task(const bf16* __restrict__ Qa, const bf16* __restrict__ Ka, const bf16* __restrict__ Va, bf16* __restrict__ opart, float* __restrict__ ostat,
                                          int task, LAS unsigned char* vl  , int lane) {
    const int bh = task / 192, rem = task % 192, br = rem >> 6, tt = rem & 63;
    const int dsh = 2 * br, dil = 1 << dsh;
    const int Lb = 64 >> dsh;
    const int r = tt / Lb, gq = tt % Lb;
    const int r32 = lane & 31, h = lane >> 5;
    const size_t base = (size_t)bh * SEQ * ADH;
    const int qtok = r + dil * (32 * gq + r32);
    bf16x8 qf[4];
#pragma unroll
    for (int sx = 0; sx < 4; ++sx) qf[sx] = *(const bf16x8*)(Qa + base + (size_t)qtok * ADH + 16 * sx + 8 * h);
    f32x16 sacc[5]; v4u vreg[5][4]; bool valid[5];
#pragma unroll
    for (int kb = 0; kb < 5; ++kb) {
        const int jb = gq - 2 + kb; valid[kb] = (jb >= 0 && jb < Lb);
#pragma unroll
        for (int i = 0; i < 16; ++i) sacc[kb][i] = 0.f;
        if (valid[kb]) {
            const int ktok = r + dil * (32 * jb + r32);
            bf16x8 kf[4];
#pragma unroll
            for (int sx = 0; sx < 4; ++sx) kf[sx] = *(const bf16x8*)(Ka + base + (size_t)ktok * ADH + 16 * sx + 8 * h);
#pragma unroll
            for (int i = 0; i < 4; ++i) { const int vtok = r + dil * (32 * jb + 8 * i + (lane >> 3)); if constexpr (!(VAR & 1)) vreg[kb][i] = *(const v4u*)(Va + base + (size_t)vtok * ADH + 8 * (lane & 7)); else vreg[kb][i] = (v4u){0u, 0u, 0u, 0u}; }
#pragma unroll
            for (int sx = 0; sx < 4; ++sx) sacc[kb] = __builtin_amdgcn_mfma_f32_32x32x16_bf16(kf[sx], qf[sx], sacc[kb], 0, 0, 0);
        }
    }
    float m = -INFINITY;
#pragma unroll
    for (int kb = 0; kb < 5; ++kb) if (valid[kb]) {
#pragma unroll
        for (int rg = 0; rg < 16; ++rg) {
            const int kk = (rg & 3) + 8 * (rg >> 2) + 4 * h;
            float sv = sacc[kb][rg];
            if (kb == 0) sv = (kk >= r32) ? sv : -INFINITY;
            if (kb == 4) sv = (kk <= r32) ? sv : -INFINITY;
            sacc[kb][rg] = sv; m = fmaxf(m, sv);
        }
    }
    m = fmaxf(m, __shfl_xor(m, 32));
    float l = 0.f; const float mb = m * 1.4426950408889634f;
    bf16x8 pf[5][2];
#pragma unroll
    for (int kb = 0; kb < 5; ++kb) if (valid[kb]) {
        float p[16];
#pragma unroll
        for (int rg = 0; rg < 16; ++rg) { if constexpr (VAR & 2) p[rg] = sacc[kb][rg] * 1.4426950408889634f - mb; else p[rg] = __builtin_amdgcn_exp2f(sacc[kb][rg] * 1.4426950408889634f - mb); l += p[rg]; }
#pragma unroll
        for (int sp = 0; sp < 2; ++sp) { v4u w; w.x = cvtpk(p[8 * sp], p[8 * sp + 1]); w.y = cvtpk(p[8 * sp + 2], p[8 * sp + 3]); w.z = cvtpk(p[8 * sp + 4], p[8 * sp + 5]); w.w = cvtpk(p[8 * sp + 6], p[8 * sp + 7]); pf[kb][sp] = __builtin_bit_cast(bf16x8, w); }
    }
    l += __shfl_xor(l, 32);
    f32x16 o0, o1;
#pragma unroll
    for (int i = 0; i < 16; ++i) { o0[i] = 0.f; o1[i] = 0.f; }
    const int row0 = lane >> 3, ch16 = lane & 7;
    const int woff = row0 * 128 + (((ch16 >> 1) ^ (((row0 >> 1) & 1) << 1)) * 32) + (ch16 & 1) * 16;
    const int q4 = (lane & 15) >> 2, sw = (q4 >> 1) & 1, dhalf = (lane >> 4) & 1;
    const int rb = (4 * h + q4) * 128 + dhalf * 32 + (lane & 3) * 8;
    const int rb0 = rb + (sw ? 64 : 0), rb1 = rb + (sw ? 0 : 64);
#pragma unroll
    for (int kb = 0; kb < 5; ++kb) if (valid[kb] && !(VAR & 1)) {
#pragma unroll
        for (int i = 0; i < 4; ++i) *(LAS v4u*)(vl + woff + 1024 * i) = vreg[kb][i];
#pragma unroll
        for (int sp = 0; sp < 2; ++sp) {
            const s16x4 a00 = __builtin_bit_cast(s16x4, __builtin_amdgcn_ds_read_tr16_b64_v4i16((LAS v4i16_t*)(vl + rb0 + (16 * sp) * 128)));
            const s16x4 a01 = __builtin_bit_cast(s16x4, __builtin_amdgcn_ds_read_tr16_b64_v4i16((LAS v4i16_t*)(vl + rb0 + (16 * sp + 8) * 128)));
            const s16x4 a10 = __builtin_bit_cast(s16x4, __builtin_amdgcn_ds_read_tr16_b64_v4i16((LAS v4i16_t*)(vl + rb1 + (16 * sp) * 128)));
            const s16x4 a11 = __builtin_bit_cast(s16x4, __builtin_amdgcn_ds_read_tr16_b64_v4i16((LAS v4i16_t*)(vl + rb1 + (16 * sp + 8) * 128)));
            const bf16x8 A0 = {a00[0], a00[1], a00[2], a00[3], a01[0], a01[1], a01[2], a01[3]};
            const bf16x8 A1 = {a10[0], a10[1], a10[2], a10[3], a11[0], a11[1], a11[2], a11[3]};
            o0 = __builtin_amdgcn_mfma_f32_32x32x16_bf16(A0, pf[kb][sp], o0, 0, 0, 0);
            o1 = __builtin_amdgcn_mfma_f32_32x32x16_bf16(A1, pf[kb][sp], o1, 0, 0, 0);
        }
        asm volatile("s_waitcnt lgkmcnt(0)" ::: "memory");
    }
    if constexpr (VAR & 1) { asm volatile("" :: "v"(pf[0][0]), "v"(pf[1][1]), "v"(pf[2][0]), "v"(pf[3][1]), "v"(pf[4][0])); }
    if constexpr (VAR & 4) { asm volatile("" :: "v"(o0), "v"(o1), "v"(l), "v"(m)); return; }
    const float inv = 1.f / l;
    const int b = bh / AH, hh = bh % AH;
    const size_t tok = (size_t)b * SEQ + qtok;
    {
        LAS unsigned char* ol = vl + r32 * 144 + 8 * h;
#pragma unroll
        for (int g4 = 0; g4 < 4; ++g4) {
            *(LAS unsigned long long*)(ol + 16 * g4) = (unsigned long long)cvtpk(o0[4 * g4] * inv, o0[4 * g4 + 1] * inv) | ((unsigned long long)cvtpk(o0[4 * g4 + 2] * inv, o0[4 * g4 + 3] * inv) << 32);
            *(LAS unsigned long long*)(ol + 64 + 16 * g4) = (unsigned long long)cvtpk(o1[4 * g4] * inv, o1[4 * g4 + 1] * inv) | ((unsigned long long)cvtpk(o1[4 * g4 + 2] * inv, o1[4 * g4 + 3] * inv) << 32);
        }
        const int qrow = lane >> 1, half = lane & 1;
        const int qtok2 = r + dil * (32 * gq + qrow);
        bf16* op = opart + ((size_t)br * NT + (size_t)b * SEQ + qtok2) * DAT + hh * ADH + 32 * half;
#pragma unroll
        for (int i = 0; i < 4; ++i) *(v4u*)(op + 8 * i) = *(const LAS v4u*)(vl + qrow * 144 + 64 * half + 16 * i);
        asm volatile("s_waitcnt lgkmcnt(0)" ::: "memory");
    }
    if (h == 0) { float* st = ostat + (((size_t)br * NT + tok) * AH + hh) * 2; st[0] = m; st[1] = l; }
}
constexpr int AT_K = 0, AT_V = 49152, AT_O = 98304, AT_OSZ = 4608;
static_assert(AT_O + 8 * AT_OSZ <= RING_BYTES, "attention LDS map");
struct AtGeo { int bh, br, dsh, Lb, jbs, nblk, resb, gq0, jsh, jmk; };
__device__ __forceinline__ AtGeo at_geo(int it) {
    AtGeo g; g.bh = it / 24; const int rem = it % 24; g.br = rem >> 3; const int sub = rem & 7; g.dsh = 2 * g.br; g.Lb = 64 >> g.dsh;
    g.gq0 = (g.br == 0) ? 8 * sub : (g.br == 1 ? 8 * (sub & 1) : 0);
    g.resb = (g.br == 0) ? 0 : (g.br == 1 ? (sub >> 1) : 2 * sub);
    g.jsh = (g.br == 2) ? 2 : 4; g.jmk = (g.br == 2) ? 3 : 15;
    const int lo = g.gq0 - 2 < 0 ? 0 : g.gq0 - 2, hi = g.gq0 + 10 > g.Lb ? g.Lb : g.gq0 + 10;
    g.jbs = (g.br == 2) ? 0 : lo; g.nblk = (g.br == 2) ? 8 : hi - lo;
    return g;
}
__device__ __forceinline__ void at_load_q(const AtGeo& g, const bf16* __restrict__ Qa, int w, int lane, bf16x8 (&qf)[4]) {
    const int r32 = lane & 31, h = lane >> 5;
    const int qtok = g.resb + (w >> g.jsh) + ((32 * (g.gq0 + (w & g.jmk)) + r32) << g.dsh);
    const bf16* qp = Qa + (size_t)g.bh * SEQ * ADH + (size_t)qtok * ADH + 8 * h;
#pragma unroll
    for (int sx = 0; sx < 4; ++sx) qf[sx] = *(const bf16x8*)(qp + 16 * sx);
}
__device__ __forceinline__ void at_load_kv(const AtGeo& g, const bf16* __restrict__ Ka, const bf16* __restrict__ Va, int tid, v4u (&kr)[6], v4u (&vr)[6]) {
    const size_t base = (size_t)g.bh * SEQ * ADH;
    const int rrow = tid >> 3, ch = tid & 7, last = 32 * g.nblk - 1;
#pragma unroll
    for (int i = 0; i < 6; ++i) { int row = rrow + 64 * i; row = row > last ? last : row;
        const int sl = row >> 5;
        const int tok = g.resb + (sl >> g.jsh) + ((32 * (g.jbs + (sl & g.jmk)) + (row & 31)) << g.dsh);
        const size_t off = base + (size_t)tok * ADH + 8 * ch; kr[i] = *(const v4u*)(Ka + off); vr[i] = *(const v4u*)(Va + off); }
}
__device__ __forceinline__ void at_stage(LAS unsigned char* L, int tid, const v4u (&kr)[6], const v4u (&vr)[6]) {
    const int rrow = tid >> 3, ch = tid & 7, r32 = rrow & 31;
    LAS unsigned char* kp = L + AT_K + rrow * 128 + ((ch ^ ((rrow >> 1) & 7)) << 4);
    LAS unsigned char* vp = L + AT_V + (rrow >> 5) * 4096 + r32 * 128 + (((ch >> 1) ^ (((r32 >> 1) & 1) << 1)) * 32) + (ch & 1) * 16;
#pragma unroll
    for (int i = 0; i < 6; ++i) { *(LAS v4u*)(kp + 8192 * i) = kr[i]; *(LAS v4u*)(vp + 8192 * i) = vr[i]; }
}
__device__ __forceinline__ void at_compute(const AtGeo& g, const AtGeo& gn, const bf16* __restrict__ Qa, LAS unsigned char* L, bf16x8 (&qf)[4], bf16* __restrict__ opart, float* __restrict__ ostat, int w, int lane) {
    const int r32 = lane & 31, h = lane >> 5;
    const int res = g.resb + (w >> g.jsh), gq = g.gq0 + (w & g.jmk);
    f32x16 sacc[5]; bool valid[5]; int slot[5];
#pragma unroll
    for (int kb = 0; kb < 5; ++kb) {
        const int jb = gq - 2 + kb; valid[kb] = (jb >= 0 && jb < g.Lb);
        const int jbc = jb < 0 ? 0 : (jb >= g.Lb ? g.Lb - 1 : jb);
        slot[kb] = ((w >> g.jsh) << 2) + jbc - g.jbs;
#pragma unroll
        for (int i = 0; i < 16; ++i) sacc[kb][i] = 0.f;
        const LAS unsigned char* kp = L + AT_K + slot[kb] * 4096 + r32 * 128;
#pragma unroll
        for (int sx = 0; sx < 4; ++sx) { const bf16x8 kf = *(const LAS bf16x8*)(kp + (((2 * sx + h) ^ ((r32 >> 1) & 7)) << 4)); sacc[kb] = __builtin_amdgcn_mfma_f32_32x32x16_bf16(kf, qf[sx], sacc[kb], 0, 0, 0); }
    }
    __builtin_amdgcn_sched_barrier(0);
    at_load_q(gn, Qa, w, lane, qf);
    __builtin_amdgcn_sched_barrier(0);
    float m = -INFINITY;
#pragma unroll
    for (int kb = 0; kb < 5; ++kb) {
#pragma unroll
        for (int rg = 0; rg < 16; ++rg) {
            const int kk = (rg & 3) + 8 * (rg >> 2) + 4 * h;
            float sv = valid[kb] ? sacc[kb][rg] : -INFINITY;
            if (kb == 0) sv = (kk >= r32) ? sv : -INFINITY;
            if (kb == 4) sv = (kk <= r32) ? sv : -INFINITY;
            sacc[kb][rg] = sv; m = fmaxf(m, sv);
        }
    }
    m = fmaxf(m, __shfl_xor(m, 32));
    float l = 0.f; const float mb = m * 1.4426950408889634f;
    bf16x8 pf[5][2];
#pragma unroll
    for (int kb = 0; kb < 5; ++kb) {
        float p[16];
#pragma unroll
        for (int rg = 0; rg < 16; ++rg) { p[rg] = __builtin_amdgcn_exp2f(sacc[kb][rg] * 1.4426950408889634f - mb); l += p[rg]; }
#pragma unroll
        for (int sp = 0; sp < 2; ++sp) { v4u wv; wv.x = cvtpk(p[8 * sp], p[8 * sp + 1]); wv.y = cvtpk(p[8 * sp + 2], p[8 * sp + 3]); wv.z = cvtpk(p[8 * sp + 4], p[8 * sp + 5]); wv.w = cvtpk(p[8 * sp + 6], p[8 * sp + 7]); pf[kb][sp] = __builtin_bit_cast(bf16x8, wv); }
    }
    l += __shfl_xor(l, 32);
    f32x16 o0, o1;
#pragma unroll
    for (int i = 0; i < 16; ++i) { o0[i] = 0.f; o1[i] = 0.f; }
    int lane2 = lane; asm volatile("" : "+v"(lane2));
    const int q4 = (lane2 & 15) >> 2, sw = (q4 >> 1) & 1, dhalf = (lane2 >> 4) & 1;
    const int rb = (4 * (lane2 >> 5) + q4) * 128 + dhalf * 32 + (lane2 & 3) * 8;
    const int rb0 = rb + (sw ? 64 : 0), rb1 = rb + (sw ? 0 : 64);
#pragma unroll
    for (int kb = 0; kb < 5; ++kb) {
        LAS unsigned char* vb = L + AT_V + slot[kb] * 4096;
#pragma unroll
        for (int sp = 0; sp < 2; ++sp) {
            const s16x4 a00 = __builtin_bit_cast(s16x4, __builtin_amdgcn_ds_read_tr16_b64_v4i16((LAS v4i16_t*)(vb + rb0 + (16 * sp) * 128)));
            const s16x4 a01 = __builtin_bit_cast(s16x4, __builtin_amdgcn_ds_read_tr16_b64_v4i16((LAS v4i16_t*)(vb + rb0 + (16 * sp + 8) * 128)));
            const s16x4 a10 = __builtin_bit_cast(s16x4, __builtin_amdgcn_ds_read_tr16_b64_v4i16((LAS v4i16_t*)(vb + rb1 + (16 * sp) * 128)));
            const s16x4 a11 = __builtin_bit_cast(s16x4, __builtin_amdgcn_ds_read_tr16_b64_v4i16((LAS v4i16_t*)(vb + rb1 + (16 * sp + 8) * 128)));
            const bf16x8 A0 = {a00[0], a00[1], a00[2], a00[3], a01[0], a01[1], a01[2], a01[3]};
            const bf16x8 A1 = {a10[0], a10[1], a10[2], a10[3], a11[0], a11[1], a11[2], a11[3]};
            o0 = __builtin_amdgcn_mfma_f32_32x32x16_bf16(A0, pf[kb][sp], o0, 0, 0, 0);
            o1 = __builtin_amdgcn_mfma_f32_32x32x16_bf16(A1, pf[kb][sp], o1, 0, 0, 0);
        }
    }
    const float inv = 1.f / l;
    const int b = g.bh / AH, hh = g.bh % AH;
    LAS unsigned char* vl = L + AT_O + w * AT_OSZ;
    {
        LAS unsigned char* ol = vl + r32 * 144 + 8 * h;
#pragma unroll
        for (int g4 = 0; g4 < 4; ++g4) {
            *(LAS unsigned long long*)(ol + 16 * g4) = (unsigned long long)cvtpk(o0[4 * g4] * inv, o0[4 * g4 + 1] * inv) | ((unsigned long long)cvtpk(o0[4 * g4 + 2] * inv, o0[4 * g4 + 3] * inv) << 32);
            *(LAS unsigned long long*)(ol + 64 + 16 * g4) = (unsigned long long)cvtpk(o1[4 * g4] * inv, o1[4 * g4 + 1] * inv) | ((unsigned long long)cvtpk(o1[4 * g4 + 2] * inv, o1[4 * g4 + 3] * inv) << 32);
        }
        const int qrow = lane >> 1, half = lane & 1;
        const int qtok2 = res + ((32 * gq + qrow) << g.dsh);
        bf16* op = opart + ((size_t)g.br * NT + (size_t)b * SEQ + qtok2) * DAT + hh * ADH + 32 * half;
#pragma unroll
        for (int i = 0; i < 4; ++i) *(v4u*)(op + 8 * i) = *(const LAS v4u*)(vl + qrow * 144 + 64 * half + 16 * i);
    }
    if (h == 0) { const size_t tok = (size_t)b * SEQ + res + ((32 * gq + r32) << g.dsh); float* st = ostat + (((size_t)g.br * NT + tok) * AH + hh) * 2; st[0] = m; st[1] = l; }
}
__device__ __forceinline__ void p3_attn_coop(const Args& a, Frame& F, int abx, int aG) {
    const bf16* qr = (const bf16*)(a.ws + WS_QR); const bf16* kr = (const bf16*)(a.ws + WS_KR); const bf16* vr = (const bf16*)(a.ws + WS_VR);
    bf16* opart = (bf16*)(a.ws + WS_OPART); float* ostat = (float*)(a.ws + WS_OSTAT);
    LAS unsigned char* L = F.lds + RING_OFF;
    constexpr int NITEM = NB * AH * 24;
    v4u kreg[6], vreg[6]; bf16x8 qf[4];
    int it = abx;
    if (it >= NITEM) return;
    AtGeo g = at_geo(it);
    at_load_q(g, qr, F.wave, F.lane, qf);
    at_load_kv(g, kr, vr, F.tid, kreg, vreg);
    __syncthreads();
    for (;;) {
        int tid = F.tid; asm volatile("" : "+v"(tid));
        at_stage(L, tid, kreg, vreg);
        __syncthreads();
        const int itn = it + aG; const bool more = itn < NITEM;
        const AtGeo gn = at_geo(more ? itn : it);
        at_load_kv(gn, kr, vr, tid, kreg, vreg);
        __builtin_amdgcn_sched_barrier(0);
        at_compute(g, gn, qr, L, qf, opart, ostat, F.wave, tid & 63);
        __syncthreads();
        if (!more) break;
        it = itn; g = gn;
    }
}
template <int VAR>
__device__ __forceinline__ void p3_attn_var(const Args& a, Frame& F) {
    const bf16* qr = (const bf16*)(a.ws + WS_QR); const bf16* kr = (const bf16*)(a.ws + WS_KR); const bf16* vr = (const bf16*)(a.ws + WS_VR);
    bf16* opart = (bf16*)(a.ws + WS_OPART); float* ostat = (float*)(a.ws + WS_OSTAT);
    LAS unsigned char* vl = F.lds + RING_OFF + F.wave * 8192;
    const int abx = (F.G == 256) ? F.bx - 64 : F.bx, aG = (F.G == 256) ? 192 : F.G;
    if (abx < 0) return;
    for (int task = abx * NWAVES + F.wave; task < NB * AH * 192; task += aG * NWAVES) attn_task<VAR>(qr, kr, vr, opart, ostat, task, vl, F.lane);
}
__device__ __forceinline__ void p3_attn(const Args& a, Frame& F) {
    const bf16* qr = (const bf16*)(a.ws + WS_QR); const bf16* kr = (const bf16*)(a.ws + WS_KR); const bf16* vr = (const bf16*)(a.ws + WS_VR);
    bf16* opart = (bf16*)(a.ws + WS_OPART); float* ostat = (float*)(a.ws + WS_OSTAT);
    LAS unsigned char* vl = F.lds + RING_OFF + F.wave * 8192;
    const int abx = (F.G == 256) ? F.bx - 64 : F.bx, aG = (F.G == 256) ? NATT : F.G;
    if (abx < 0) return;
    if (F.G == 256) { if (abx < NATT) { p3_attn_coop(a, F, abx, aG); __syncthreads(); if (F.tid == 0) __hip_atomic_fetch_add((gu32*)(a.ws + WS_CTL) + CW_ADONE, 1u, RLX_AGENT); } }
    else for (int task = abx * NWAVES + F.wave; task < NB * AH * 192; task += aG * NWAVES) attn_task<0>(qr, kr, vr, opart, ostat, task, vl, F.lane);
    if (F.G == 256) cvt_run(a, F, CW_MDONE, (unsigned)(NB * MH * 2), CW_ADONE, (unsigned)NATT);
}
struct MixIn { v4u fp, bp; v4u xcp, zp, op[3]; float mm[3], ll[3]; };
__device__ __forceinline__ MixIn mix_load(const bf16* hfb, const bf16* xc, const bf16* proj, const bf16* opart, const float* ostat, int t, int c0, int hh) {
    MixIn r;
    r.fp = *(const v4u*)(hfb + (size_t)t * DML + c0); r.bp = *(const v4u*)(hfb + ((size_t)NT + t) * DML + c0);
    r.xcp = *(const v4u*)(xc + (size_t)t * DML + c0); r.zp = *(const v4u*)(proj + (size_t)t * DPROJ + 512 + c0);
#pragma unroll
    for (int br = 0; br < 3; ++br) { r.op[br] = *(const v4u*)(opart + ((size_t)br * NT + t) * DAT + c0); const float* st = ostat + (((size_t)br * NT + t) * AH + hh) * 2; r.mm[br] = st[0]; r.ll[br] = st[1]; }
    return r;
}
__device__ __forceinline__ void p4_mix(const Args& a, Frame& F) {
    const bf16* hfb = (const bf16*)(a.ws + WS_HFB); const bf16* xc = (const bf16*)(a.ws + WS_XC); const bf16* proj = (const bf16*)(a.ws + WS_PROJ);
    const bf16* opart = (const bf16*)(a.ws + WS_OPART); const float* ostat = (const float*)(a.ws + WS_OSTAT);
    const float* mnorm_g = a.in[12]; const float* mskip = a.in[13]; const float* anorm_g = a.in[14];
    bf16* mixed = (bf16*)(a.ws + WS_XN);
    const int lane = F.lane, c0 = 8 * lane, hh = lane >> 3;
    float mg[8], sk[8], ag[8];
#pragma unroll
    for (int i = 0; i < 8; ++i) { mg[i] = mnorm_g[c0 + i]; sk[i] = mskip[c0 + i]; ag[i] = anorm_g[c0 + i]; }
    const int tstep = F.G * NWAVES;
    MixIn cur = mix_load(hfb, xc, proj, opart, ostat, F.bx * NWAVES + F.wave, c0, hh);
    for (int t = F.bx * NWAVES + F.wave; t < NT; t += tstep) {
        const MixIn in = cur;
        if (t + tstep < NT) cur = mix_load(hfb, xc, proj, opart, ostat, t + tstep, c0, hh);
        const v4u fp = in.fp, bp = in.bp; const v4u xcp = in.xcp, zp = in.zp;
        v4u op[3]; float mm[3], ll[3];
#pragma unroll
        for (int br = 0; br < 3; ++br) { op[br] = in.op[br]; mm[br] = in.mm[br]; ll[br] = in.ll[br]; }
        float hs[8];
#pragma unroll
        for (int i = 0; i < 4; ++i) { hs[2 * i] = bflo(fp[i]) + bflo(bp[i]); hs[2 * i + 1] = bfhi(fp[i]) + bfhi(bp[i]); }
        float ss = 0.f;
#pragma unroll
        for (int i = 0; i < 8; ++i) ss += hs[i] * hs[i];
        ss += __shfl_xor(ss, 1); ss += __shfl_xor(ss, 2); ss += __shfl_xor(ss, 4); ss += __shfl_xor(ss, 8);
        const float rn = rsqrtf(ss * (1.f / MDH) + EPS);
        float ym[8];
#pragma unroll
        for (int i = 0; i < 8; ++i) {
            const float xcv = (i & 1) ? bfhi(xcp[i >> 1]) : bflo(xcp[i >> 1]), z = (i & 1) ? bfhi(zp[i >> 1]) : bflo(zp[i >> 1]);
            ym[i] = (hs[i] * rn * mg[i] + sk[i] * xcv) * (z / (1.f + __expf(-z)));
        }
        *(v4u*)(mixed + (size_t)t * DMODEL + c0) = (v4u){pk2(ym[0], ym[1]), pk2(ym[2], ym[3]), pk2(ym[4], ym[5]), pk2(ym[6], ym[7])};
        const float M = fmaxf(mm[0], fmaxf(mm[1], mm[2]));
        const float w0 = __expf(mm[0] - M) * ll[0], w1 = __expf(mm[1] - M) * ll[1], w2 = __expf(mm[2] - M) * ll[2];
        const float rden = 1.f / (w0 + w1 + w2);
        float av[8]; float s2 = 0.f;
#pragma unroll
        for (int i = 0; i < 8; ++i) {
            const float o0 = (i & 1) ? bfhi(op[0][i >> 1]) : bflo(op[0][i >> 1]), o1 = (i & 1) ? bfhi(op[1][i >> 1]) : bflo(op[1][i >> 1]), o2 = (i & 1) ? bfhi(op[2][i >> 1]) : bflo(op[2][i >> 1]);
            av[i] = (w0 * o0 + w1 * o1 + w2 * o2) * rden; s2 += av[i] * av[i];
        }
        s2 = wave_sum(s2);
        const float ra = rsqrtf(s2 * (1.f / DAT) + EPS);
        *(v4u*)(mixed + (size_t)t * DMODEL + 512 + c0) = (v4u){pk2(av[0] * ra * ag[0], av[1] * ra * ag[1]), pk2(av[2] * ra * ag[2], av[3] * ra * ag[3]), pk2(av[4] * ra * ag[4], av[5] * ra * ag[5]), pk2(av[6] * ra * ag[6], av[7] * ra * ag[7])};
    }
}
constexpr int RT_STR = 1040;
constexpr int RT_W = 0, RT_G2 = 16 * RT_STR * 4, RT_P = RT_G2 + 4096, RT_SS = RT_P + 8 * 256 * 4;
static_assert(RT_SS + 8 * 16 * 4 <= RING_BYTES, "router LDS map");
__device__ __forceinline__ void p6_router(const Args& a, Frame& F) {
    const float* x0 = a.in[0]; const bf16* yo = (const bf16*)(a.ws + WS_YO); const float* g2 = a.in[16]; const float* wr = a.in[17];
    unsigned char* h2 = a.ws + WS_XN; float* aff = (float*)(a.ws + WS_AFF); int* slot = (int*)(a.ws + WS_SLOT);
    LAS unsigned char* L = F.lds + RING_OFF;
    LAS float* Wl = (LAS float*)(L + RT_W); LAS float* g2l = (LAS float*)(L + RT_G2); LAS float* Pb = (LAS float*)(L + RT_P); LAS float* SSb = (LAS float*)(L + RT_SS);
    int tid_ = F.tid; asm volatile("" : "+v"(tid_));
    const int tid = tid_, lane = F.lane, w = F.wave, c16 = lane & 15, g = lane >> 4;
    __syncthreads();
    { f32x4 wv8[8]; float gk8[8];
#pragma unroll
      for (int i = 0; i < 8; ++i) { const int idx = tid + NTHR * i; wv8[i] = ((const GAS f32x4*)wr)[idx]; gk8[i] = g2[idx >> 2]; }
#pragma unroll
      for (int i = 0; i < 8; ++i) { const int idx = tid + NTHR * i, k = idx >> 2, e0 = (idx & 3) * 4;
#pragma unroll
          for (int j = 0; j < 4; ++j) Wl[(e0 + j) * RT_STR + k] = wv8[i][j] * gk8[i]; }
      g2l[2 * tid] = g2[2 * tid]; g2l[2 * tid + 1] = g2[2 * tid + 1]; }
    __syncthreads();
    const int tl = w >> 1, kh = w & 1;
    for (int t64 = F.bx; t64 < NT / 64; t64 += F.G) {
        const int r0 = t64 * 64 + 16 * tl;
        const float* xp = x0 + (size_t)(r0 + c16) * DMODEL + 512 * kh + 4 * g;
        const bf16* yp = yo + (size_t)(r0 + c16) * DMODEL + 512 * kh + 4 * g;
        f32x4 xa[32];
#pragma unroll
        for (int sx = 0; sx < 32; ++sx) xa[sx] = *(const f32x4*)(xp + 16 * sx);
#pragma unroll
        for (int blk = 0; blk < 4; ++blk) {
            unsigned long long yv[8];
#pragma unroll
            for (int i = 0; i < 8; ++i) yv[i] = *(const unsigned long long*)(yp + 16 * (8 * blk + i));
#pragma unroll
            for (int i = 0; i < 8; ++i) { const unsigned lo = (unsigned)yv[i], hi = (unsigned)(yv[i] >> 32);
                xa[8 * blk + i] += (f32x4){__uint_as_float(lo << 16), __uint_as_float(lo & 0xffff0000u), __uint_as_float(hi << 16), __uint_as_float(hi & 0xffff0000u)}; }
            __builtin_amdgcn_sched_barrier(0);
        }
        float ss = 0.f; f32x4 D = {0.f, 0.f, 0.f, 0.f};
        const LAS float* wrow = Wl + c16 * RT_STR + 512 * kh + 4 * g;
#pragma unroll
        for (int sx = 0; sx < 32; ++sx) {
            const f32x4 wb = *(const LAS f32x4*)(wrow + 16 * sx);
#pragma unroll
            for (int i = 0; i < 4; ++i) { D = __builtin_amdgcn_mfma_f32_16x16x4f32(xa[sx][i], wb[i], D, 0, 0, 0); ss += xa[sx][i] * xa[sx][i]; }
        }
        ss += __shfl_xor(ss, 16); ss += __shfl_xor(ss, 32);
#pragma unroll
        for (int r = 0; r < 4; ++r) Pb[w * 256 + (4 * g + r) * 16 + c16] = D[r];
        if (g == 0) SSb[w * 16 + c16] = ss;
        __syncthreads();
        const int w0 = w & ~1;
        const float rt = rsqrtf((SSb[w0 * 16 + c16] + SSb[(w0 + 1) * 16 + c16]) * (1.f / DMODEL) + EPS);
        unsigned char* hp = h2 + (size_t)(r0 + c16) * DMODEL + 512 * kh + 4 * g;
#pragma unroll
        for (int sx = 0; sx < 32; ++sx) { const f32x4 g4 = *(const LAS f32x4*)(g2l + 512 * kh + 16 * sx + 4 * g); const f32x4 y = xa[sx] * g4 * rt;
            int w8 = 0; w8 = __builtin_amdgcn_cvt_pk_fp8_f32(y.x, y.y, w8, false); w8 = __builtin_amdgcn_cvt_pk_fp8_f32(y.z, y.w, w8, true);
            *(int*)(hp + 16 * sx) = w8; }
        if (kh == 0) {
#pragma unroll
            for (int r = 0; r < 4; ++r) {
                const int tk = 4 * g + r;
                const float rr = rsqrtf((SSb[w0 * 16 + tk] + SSb[(w0 + 1) * 16 + tk]) * (1.f / DMODEL) + EPS);
                const float z = (Pb[w0 * 256 + tk * 16 + c16] + Pb[(w0 + 1) * 256 + tk * 16 + c16]) * rr;
                float mx = z;
                mx = fmaxf(mx, __shfl_xor(mx, 1)); mx = fmaxf(mx, __shfl_xor(mx, 2)); mx = fmaxf(mx, __shfl_xor(mx, 4)); mx = fmaxf(mx, __shfl_xor(mx, 8));
                const float ex = expf(z - mx);
                float den = ex;
                den += __shfl_xor(den, 1); den += __shfl_xor(den, 2); den += __shfl_xor(den, 4); den += __shfl_xor(den, 8);
                aff[(size_t)(r0 + tk) * NE + c16] = ex / den;
                slot[(size_t)(r0 + tk) * NE + c16] = -1;
            }
        }
        __syncthreads();
    }
}
__device__ __forceinline__ void p7_topk(const Args& a, Frame& F) {
    LAS unsigned* hist = (LAS unsigned*)(F.lds + RING_OFF);
    LAS unsigned* wsum = hist + 256;
    LAS unsigned* bc = hist + 272;
    const float* aff = (const float*)(a.ws + WS_AFF); int* slot = (int*)(a.ws + WS_SLOT); int* sel_tok = (int*)(a.ws + WS_SELT); float* sel_gate = (float*)(a.ws + WS_SELG);
    const int tid = F.tid, lane = F.lane, w = F.wave;
    for (int be = F.bx; be < NB * NE; be += F.G) {
        const int b = be / NE, e = be % NE;
        unsigned key[4];
#pragma unroll
        for (int j = 0; j < 4; ++j) key[j] = __float_as_uint(aff[(size_t)(b * SEQ + 4 * tid + j) * NE + e]);
        unsigned prefix = 0u, mask = 0u, need = CAP;
#pragma unroll
        for (int pass = 0; pass < 4; ++pass) {
            const int shift = 24 - 8 * pass;
            __syncthreads();
            if (tid < 256) hist[tid] = 0u;
            __syncthreads();
#pragma unroll
            for (int j = 0; j < 4; ++j) if ((key[j] & mask) == prefix) __hip_atomic_fetch_add(&hist[(key[j] >> shift) & 255u], 1u, __ATOMIC_RELAXED, __HIP_MEMORY_SCOPE_WORKGROUP);
            __syncthreads();
            if (w == 0) {
                const unsigned c0 = hist[4 * lane], c1 = hist[4 * lane + 1], c2 = hist[4 * lane + 2], c3 = hist[4 * lane + 3];
                const unsigned sl = c0 + c1 + c2 + c3;
                unsigned inc = sl;
#pragma unroll
                for (int o = 1; o < 64; o <<= 1) { const unsigned v = __shfl_down(inc, o); if (lane + o < 64) inc += v; }
                unsigned run = inc - sl;
                const unsigned cc[4] = {c3, c2, c1, c0};
#pragma unroll
                for (int q = 0; q < 4; ++q) { if (run < need && run + cc[q] >= need) { bc[0] = (unsigned)(4 * lane + 3 - q); bc[1] = need - run; } run += cc[q]; }
            }
            __syncthreads();
            prefix |= bc[0] << shift; mask |= 255u << shift; need = bc[1];
        }
        unsigned loc = 0u; unsigned gtf[4], eqf[4];
#pragma unroll
        for (int j = 0; j < 4; ++j) { gtf[j] = key[j] > prefix ? 1u : 0u; eqf[j] = key[j] == prefix ? 1u : 0u; loc += gtf[j] + (eqf[j] << 16); }
        unsigned inc = loc;
#pragma unroll
        for (int o = 1; o < 64; o <<= 1) { const unsigned v = __shfl_up(inc, o); if (lane >= o) inc += v; }
        if (lane == 63) wsum[w] = inc;
        __syncthreads();
        unsigned base = 0u;
#pragma unroll
        for (int ww = 0; ww < 8; ++ww) if (ww < w) base += wsum[ww];
        unsigned run = base + inc - loc;
#pragma unroll
        for (int j = 0; j < 4; ++j) {
            const unsigned gb = run & 0xffffu, eb = run >> 16;
            const bool sel = gtf[j] || (eqf[j] && eb < need);
            if (sel) { const unsigned sl = gb + (eb < need ? eb : need); const int tok = b * SEQ + 4 * tid + j; const int p = (e * NB + b) * CAP + (int)sl;
                sel_tok[p] = tok; sel_gate[p] = __uint_as_float(key[j]); slot[(size_t)tok * NE + e] = (int)sl; }
            run += gtf[j] + (eqf[j] << 16);
        }
    }
}
__device__ __forceinline__ void p10_final(const Args& a, Frame& F, float* dst) {
    const float* x0 = a.in[0]; const bf16* yo = (const bf16*)(a.ws + WS_YO); const float* gf = a.in[21]; const int* slot = (const int*)(a.ws + WS_SLOT); const bf16* Y = (const bf16*)(a.ws + WS_Y);
    const int lane = F.lane;
    const int rstep = F.G * NWAVES;
    f32x4 nx[4]; unsigned long long ny[4]; int nslot = -1;
    { const int row0 = F.bx * NWAVES + F.wave;
      if (row0 < NT) {
#pragma unroll
        for (int j = 0; j < 4; ++j) { nx[j] = ((const GAS f32x4*)(x0 + (size_t)row0 * DMODEL) + lane)[64 * j]; ny[j] = ((const GAS unsigned long long*)(yo + (size_t)row0 * DMODEL) + lane)[64 * j]; }
        nslot = slot[(size_t)row0 * NE + (lane & 15)]; } }
    for (int row = F.bx * NWAVES + F.wave; row < NT; row += rstep) {
        const int b = row / SEQ;
        f32x4 v[4];
#pragma unroll
        for (int j = 0; j < 4; ++j) { const unsigned lo = (unsigned)ny[j], hi = (unsigned)(ny[j] >> 32);
            v[j] = (f32x4){nx[j].x + __uint_as_float(lo << 16), nx[j].y + __uint_as_float(lo & 0xffff0000u), nx[j].z + __uint_as_float(hi << 16), nx[j].w + __uint_as_float(hi & 0xffff0000u)}; }
        const int myslot = nslot;
        if (row + rstep < NT) {
#pragma unroll
            for (int j = 0; j < 4; ++j) { nx[j] = ((const GAS f32x4*)(x0 + (size_t)(row + rstep) * DMODEL) + lane)[64 * j]; ny[j] = ((const GAS unsigned long long*)(yo + (size_t)(row + rstep) * DMODEL) + lane)[64 * j]; }
            nslot = slot[(size_t)(row + rstep) * NE + (lane & 15)]; }
        unsigned long long msk = __ballot(lane < 16 && myslot >= 0);
        while (msk) {
            unsigned long long y[4][4];
#pragma unroll
            for (int q = 0; q < 4; ++q) {
                const bool ok = msk != 0ull; const int e = ok ? (__ffsll((long long)msk) - 1) : 0; const int sl = __shfl(myslot, e);
                if (ok) { msk &= msk - 1ull; const GAS unsigned long long* yr = (const GAS unsigned long long*)(Y + ((size_t)(e * NB + b) * CAP + sl) * DMODEL) + lane;
#pragma unroll
                    for (int j = 0; j < 4; ++j) y[q][j] = yr[64 * j]; }
                else {
#pragma unroll
                    for (int j = 0; j < 4; ++j) y[q][j] = 0ull; }
            }
#pragma unroll
            for (int q = 0; q < 4; ++q)
#pragma unroll
                for (int j = 0; j < 4; ++j) { const unsigned lo = (unsigned)y[q][j], hi = (unsigned)(y[q][j] >> 32);
                    v[j].x += __uint_as_float(lo << 16); v[j].y += __uint_as_float(lo & 0xffff0000u); v[j].z += __uint_as_float(hi << 16); v[j].w += __uint_as_float(hi & 0xffff0000u); }
        }
        float s = 0.f;
#pragma unroll
        for (int j = 0; j < 4; ++j) s += (v[j].x * v[j].x + v[j].y * v[j].y) + (v[j].z * v[j].z + v[j].w * v[j].w);
        const float r = rsqrtf(wave_sum(s) * (1.f / DMODEL) + EPS);
#pragma unroll
        for (int j = 0; j < 4; ++j) { const f32x4 w = ((const GAS f32x4*)gf)[lane + 64 * j]; ((GAS f32x4*)(dst + (size_t)row * DMODEL) + lane)[64 * j] = (f32x4){v[j].x * r * w.x, v[j].y * r * w.y, v[j].z * r * w.z, v[j].w * r * w.w}; }
    }
}

#ifndef MK_N_LAUNCHES
#define MK_N_LAUNCHES 1
#endif
constexpr int N_PHASES = 11;
__global__ void __launch_bounds__(NTHR, 2) mk_fwd(Args args) {
    extern __shared__ __attribute__((aligned(16))) unsigned char lds[];
    Frame F;
    F.lds = (LAS unsigned char*)lds;
    F.tid = threadIdx.x; F.lane = F.tid & 63; F.wave = __builtin_amdgcn_readfirstlane(F.tid >> 6);
    F.G = gridDim.x; F.bx = blockIdx.x;
    unsigned char* ws = args.ws;
    gu32* ctl = (gu32*)(ws + WS_CTL);
    for (int u = F.tid; u < (LDS_BYTES - LDSCTL_OFF) / 4; u += NTHR) ((LAS unsigned*)(F.lds + LDSCTL_OFF))[u] = 0u;
    __syncthreads();
    volatile LAS unsigned* MISC = (volatile LAS unsigned*)(F.lds + MISC_OFF);
    XcdBarrier bar; bar.bar = (unsigned*)(ctl + CW_BAR) + args.li * XCD_BAR_WORDS; bar.x = 0; bar.st = nullptr;
    if (MK_N_LAUNCHES != N_PHASES) bar = xcd_barrier_post((unsigned*)(ctl + CW_BAR) + args.li * XCD_BAR_WORDS, MISC + 8);
    const int lo = args.ph_lo, hi = args.ph_hi;
#define IN(k) (lo <= (k) && (k) < hi)
#define SEAM(k) do { if (IN(k) && IN((k) + 1)) xcd_barrier(bar); asm volatile("" : "+v"(F.tid)); F.lane = F.tid & 63; } while (0)
#ifndef DUP_PHASE
#define DUP_PHASE -1
#endif
#define DUPBAR(k) if (DUP_PHASE == (k)) xcd_barrier(bar)
#ifndef SPIN_PHASE
#define SPIN_PHASE -1
#endif
    unsigned long long tstamp0 = 0, tstamp1 = 0;
#define STAMP(k) do { if (SPIN_PHASE >= 0) { if ((k) == SPIN_PHASE) tstamp0 = __builtin_amdgcn_s_memrealtime(); if ((k) == SPIN_PHASE + 1) tstamp1 = __builtin_amdgcn_s_memrealtime(); } } while (0)

    STAMP(0);
    if (IN(0)) { p0_prologue(args, F); if (DUP_PHASE == 0) { xcd_barrier(bar); p0_prologue(args, F); } } SEAM(0);
    STAMP(1);
    if (IN(1)) for (int rep = 0; rep < (DUP_PHASE == 1 ? 2 : 1); ++rep) {   if (rep) xcd_barrier(bar);
        pg8::Gemm g{(const pg8::bf16_t*)(ws + WS_XN), (const pg8::bf16_t*)(ws + WS_WIN), NT, DPROJ, DMODEL, nullptr, 0};
        pg8::StaticOrder S; S.init(NT, DPROJ, F.G, F.bx);
        static_assert(WS_KR - WS_QR == WS_VR - WS_KR, "Q, K, V buffers equally spaced");
        pg8::EpiInProj E{(pg8::bf16_t*)(ws + WS_PROJ), DPROJ, (pg8::bf16_t*)(ws + WS_QR), (size_t)(WS_KR - WS_QR) / 2, (const float*)(ws + WS_ROPE)};
        pg8::gemm_phase<pg8::EpiInProj, pg8::StaticOrder, true, true, false>(F.lds + RING_OFF, g, S, E);
    } SEAM(1);
    STAMP(2);
    if (IN(2)) { p2_prep(args, F); if (DUP_PHASE == 2) { xcd_barrier(bar); p2_prep(args, F); } } SEAM(2);
    STAMP(3);
    if (IN(3)) { p3_mlstm(args, F); p3_attn(args, F); if (DUP_PHASE == 3) { xcd_barrier(bar); p3_mlstm(args, F); p3_attn(args, F); } if (DUP_PHASE == 31) { xcd_barrier(bar); p3_mlstm(args, F); } if (DUP_PHASE >= 3100 && DUP_PHASE < 3132) { xcd_barrier(bar); for (int item = F.bx; item < NB * MH * 2; item += F.G) mlstm_item<(DUP_PHASE >= 3100 ? DUP_PHASE - 3100 : 0) | 1>(args, F, item); __syncthreads(); } if (DUP_PHASE == 32) { xcd_barrier(bar); p3_attn(args, F); } if (DUP_PHASE >= 320 && DUP_PHASE < 328) { xcd_barrier(bar); p3_attn_var<DUP_PHASE >= 320 ? (DUP_PHASE - 320) | 4 : 4>(args, F); } } SEAM(3);
    STAMP(4);
    if (IN(4)) { p4_mix(args, F); if (DUP_PHASE == 4) { xcd_barrier(bar); p4_mix(args, F); } } SEAM(4);
    STAMP(5);
    if (IN(5)) for (int rep = 0; rep < (DUP_PHASE == 5 ? 2 : 1); ++rep) {   if (rep) xcd_barrier(bar);
        pg8::Gemm g{(const pg8::bf16_t*)(ws + WS_XN), (const pg8::bf16_t*)(ws + WS_WOUT), NT, DMODEL, DMODEL, nullptr, 0};
        pg8::StaticOrder S; S.init(NT, DMODEL, F.G, F.bx);
        pg8::EpiStoreBf16 E{(pg8::bf16_t*)(ws + WS_YO), DMODEL};
        pg8::gemm_phase<pg8::EpiStoreBf16, pg8::StaticOrder, true, true, false>(F.lds + RING_OFF, g, S, E);
    } SEAM(5);
    STAMP(6);
    if (IN(6)) { p6_router(args, F); if (DUP_PHASE == 6) { xcd_barrier(bar); p6_router(args, F); } } SEAM(6);
    STAMP(7);
    if (IN(7)) { p7_topk(args, F); if (DUP_PHASE == 7) { xcd_barrier(bar); p7_topk(args, F); } cvt_stream(args, F, -1, 0u); if (DUP_PHASE == 40) { xcd_barrier(bar); cvt_run(args, F, -1, 0u, -1, 0u, 320); } } SEAM(7);
    STAMP(8);
    if (IN(8)) for (int rep = 0; rep < (DUP_PHASE == 8 ? 2 : 1); ++rep) {   if (rep) xcd_barrier(bar);
        if (F.G == 256) {
            for (int seg = 0; seg < 2; ++seg) {
                pg8::Gemm g{(const pg8::bf16_t*)(ws + WS_XN), (const pg8::bf16_t*)(ws + WS_W13), NPAIR, NE * 2 * DEXP, DMODEL, (const int*)(ws + WS_SELT), 0x7a7a7a7a};
                pg8::MoeUpOrder S; S.init(F.bx, seg);
                pg8::EpiSwiGLU E{ws + WS_H, DEXP, 2 * DEXP / 256};
                pg8::gemm_phase<pg8::EpiSwiGLU, pg8::MoeUpOrder, true, true, true, true>(F.lds + RING_OFF, g, S, E);
            }
        }
    }
    if (DUP_PHASE == 80 || DUP_PHASE == 81) { xcd_barrier(bar);
        for (int seg = 0; seg < 2; ++seg) {
            pg8::Gemm g{(const pg8::bf16_t*)(ws + WS_XN), (const pg8::bf16_t*)(ws + WS_W13), NPAIR, NE * 2 * DEXP, DMODEL, (const int*)(ws + WS_SELT), 0x7a7a7a7a};
            pg8::MoeUpOrder S; S.init(F.bx, seg);
            pg8::EpiNull E{};
            pg8::gemm_phase<pg8::EpiNull, pg8::MoeUpOrder, DUP_PHASE == 80, true, true, true>(F.lds + RING_OFF, g, S, E);
        }
    } SEAM(8);
    STAMP(9);
    if (IN(9)) for (int rep = 0; rep < (DUP_PHASE == 9 ? 2 : 1); ++rep) {   if (rep) xcd_barrier(bar);
        if (F.G == 256) {
            pg8::Gemm g{(const pg8::bf16_t*)(ws + WS_H), (const pg8::bf16_t*)(ws + WS_W2), NPAIR, NE * DMODEL, DEXP, nullptr, 0x79797979};
            pg8::MoeDownOrder S; S.init(F.bx);
            pg8::EpiDown E{(pg8::bf16_t*)(ws + WS_Y), DMODEL, (const float*)(ws + WS_SELG)};
            pg8::gemm_phase<pg8::EpiDown, pg8::MoeDownOrder, true, true, false, true>(F.lds + RING_OFF, g, S, E);
        }
    } SEAM(9);
    STAMP(10);
    if (IN(10)) { if (DUP_PHASE == 10) { p10_final(args, F, (float*)(ws + WS_H)); xcd_barrier(bar); } if (DUP_PHASE == 11) { for (int q = 0; q < 10; ++q) xcd_barrier(bar); } p10_final(args, F, args.out); }
    STAMP(11);
    if (SPIN_PHASE >= 0 && F.bx == 0 && F.tid == 0) { const unsigned long long until = __builtin_amdgcn_s_memrealtime() + 8ull * (tstamp1 - tstamp0); while (__builtin_amdgcn_s_memrealtime() < until) __builtin_amdgcn_s_sleep(8); }
#undef IN
#undef SEAM
}

extern "C" void kernel_launch(void* const* d_in, const int* in_sizes, int n_in, void* d_out, int out_size, void* d_ws, size_t ws_size, hipStream_t stream) {
    static int grid = 0;
    if (grid == 0) {
        if (n_in != 22 || out_size != NT * DMODEL || ws_size < WS_END) { fprintf(stderr, "kernel_launch: unexpected shapes (n_in %d out %d ws %zu need %zu)\n", n_in, out_size, ws_size, (size_t)WS_END); grid = -1; return; }
        int dev = 0, cus = 0, per_cu = 0;
        if (hipGetDevice(&dev) != hipSuccess || hipDeviceGetAttribute(&cus, hipDeviceAttributeMultiprocessorCount, dev) != hipSuccess) { grid = -1; return; }
        if (hipFuncSetAttribute((const void*)mk_fwd, hipFuncAttributeMaxDynamicSharedMemorySize, LDS_BYTES) != hipSuccess) { fprintf(stderr, "kernel_launch: hipFuncSetAttribute failed\n"); grid = -1; return; }
        if (hipOccupancyMaxActiveBlocksPerMultiprocessor(&per_cu, (const void*)mk_fwd, NTHR, LDS_BYTES) != hipSuccess || per_cu < 1) { fprintf(stderr, "kernel_launch: occupancy query says %d blocks per CU\n", per_cu); grid = -1; (void)hipGetLastError(); return; }
        grid = cus;
        if (grid != 256) fprintf(stderr, "kernel_launch: %d CUs: the MoE phases are built for 256\n", grid);
    }
    if (grid < 0) return;
    (void)hipMemsetAsync((char*)d_ws + WS_CTL, 0, CTL_ZERO_BYTES, stream);
    Args a{};
    for (int i = 0; i < 22; ++i) a.in[i] = (const float*)d_in[i];
    a.out = (float*)d_out; a.ws = (unsigned char*)d_ws;
    for (int li = 0; li < MK_N_LAUNCHES; ++li) {
        if (MK_N_LAUNCHES == 1) { a.ph_lo = 0; a.ph_hi = N_PHASES; } else { a.ph_lo = li; a.ph_hi = li + 1; }
        a.li = (MK_N_LAUNCHES == 1) ? 0 : 0;
        hipLaunchKernelGGL(mk_fwd, dim3(grid), dim3(NTHR), LDS_BYTES, stream, a);
    }
}
```

```cpp
#include <hip/hip_runtime.h>
#include <cstdio>
#include <cstdint>
#include <cmath>

namespace pg8 {
#define PG8_LAS __attribute__((address_space(3)))
typedef unsigned short bf16_t;
typedef short bf16x8 __attribute__((ext_vector_type(8)));
typedef float f32x4 __attribute__((ext_vector_type(4)));
typedef float f32x2 __attribute__((ext_vector_type(2)));
typedef unsigned u32x4 __attribute__((ext_vector_type(4)));
constexpr int BM = 256, BK = 64, HALF = 128, HTB = HALF * BK * 2  , STAGE_BYTES = 8 * HTB, NXCD = 8, WGM = 8;

__host__ __device__ __forceinline__ int lds_byte(int r, int c) { const int st = (r >> 4) * 2 + (c >> 5), rr = r & 15, cc = c & 31, ob = rr * 64 + cc * 2; return st * 1024 + (ob ^ (((ob >> 9) & 1) << 5)); }
__host__ __device__ __forceinline__ void stage_rc(int b, int& R, int& C) { const int st = b / 1024, sb = b % 1024, swz = sb ^ (((sb >> 9) & 1) << 5); R = (st >> 1) * 16 + swz / 64; C = (st & 1) * 32 + (swz % 64) / 2; }
__host__ __device__ __forceinline__ int perm32(int rho) { const int n = rho >> 4, i = rho & 15; return 8 * (i >> 2) + 4 * n + (i & 3); }

typedef int v8i_t __attribute__((ext_vector_type(8)));
typedef int v4i_t __attribute__((ext_vector_type(4)));
__device__ __forceinline__ v8i_t cat32(bf16x8 a, bf16x8 b) { const v4i_t x = __builtin_bit_cast(v4i_t, a), y = __builtin_bit_cast(v4i_t, b); return (v8i_t){x[0], x[1], x[2], x[3], y[0], y[1], y[2], y[3]}; }
struct Unit { int pm, pn; };
struct Gemm { const bf16_t* A; const bf16_t* Bt; int M, N, K; const int* rowidx; int wscale; };

struct StaticOrder {
    int nM, nN, nwg, G, c;
    __host__ __device__ void init(int M, int N, int G_, int c_) { nM = M / BM; nN = N / BM; nwg = nM * nN; G = G_; c = c_; }
    __host__ __device__ bool next(int i, Unit& u) const {
        const long L = (long)i * G + c; if (L >= nwg) return false;
        int wgid = (int)L; { const int q = nwg / NXCD, r = nwg % NXCD, xcd = wgid % NXCD, off = wgid / NXCD; wgid = (xcd < r ? xcd * (q + 1) : r * (q + 1) + (xcd - r) * q) + off; }
        const int nig = WGM * nN, gid = wgid / nig, fm = gid * WGM, gsz = (nM - fm) < WGM ? (nM - fm) : WGM;
        u.pm = fm + ((wgid % nig) % gsz); u.pn = (wgid % nig) / gsz; return true;
    }
    __device__ __forceinline__ void a_ready(const Unit&) const {}
    __device__ __forceinline__ void done(const Unit&) const {}
};


__device__ __forceinline__ unsigned cvt_pk_bf16(float lo, float hi) { unsigned r; asm volatile("v_cvt_pk_bf16_f32 %0, %1, %2" : "=v"(r) : "v"(lo), "v"(hi)); return r; }
__device__ __forceinline__ float fast_silu(float x) { return x * __builtin_amdgcn_rcpf(1.0f + __builtin_amdgcn_exp2f(-1.4426950408889634f * x)); }

struct EpiStoreBf16 {
    static constexpr bool PERM = true, AFTER_DRAIN = false;
    bf16_t* O; int ldc;
    __device__ __forceinline__ void operator()(const f32x4 (&acc)[2][2][4][2], const Unit& u, int wr, int wc, int fr, int fq) const {
        const int row0 = u.pm * BM + wr * 64 + fr, col0 = u.pn * BM + wc * 32 + 8 * fq;
#pragma unroll
        for (int ai = 0; ai < 2; ++ai)
#pragma unroll
            for (int m = 0; m < 4; ++m) { bf16_t* rowp = O + (size_t)(row0 + ai * HALF + m * 16) * ldc + col0;
#pragma unroll
                for (int bj = 0; bj < 2; ++bj) { const f32x4 v0 = acc[ai][bj][m][0], v1 = acc[ai][bj][m][1];
                    u32x4 w; w.x = cvt_pk_bf16(v0[0], v0[1]); w.y = cvt_pk_bf16(v0[2], v0[3]); w.z = cvt_pk_bf16(v1[0], v1[1]); w.w = cvt_pk_bf16(v1[2], v1[3]);
                    *(u32x4*)(rowp + bj * HALF) = w; } }
    }
};
struct EpiInProj {
    static constexpr bool PERM = true, AFTER_DRAIN = false;
    bf16_t* O; int ldc; bf16_t* QKVo; size_t kind_stride; const float* rope;
    __device__ __forceinline__ void operator()(const f32x4 (&acc)[2][2][4][2], const Unit& u, int wr, int wc, int fr, int fq) const {
        const int row0 = u.pm * BM + wr * 64 + fr;
        if (u.pn < 4) {
            const int col0 = u.pn * BM + wc * 32 + 8 * fq;
#pragma unroll
            for (int ai = 0; ai < 2; ++ai)
#pragma unroll
                for (int m = 0; m < 4; ++m) { bf16_t* rowp = O + (size_t)(row0 + ai * HALF + m * 16) * ldc + col0;
#pragma unroll
                    for (int bj = 0; bj < 2; ++bj) { const f32x4 v0 = acc[ai][bj][m][0], v1 = acc[ai][bj][m][1];
                        u32x4 w; w.x = cvt_pk_bf16(v0[0], v0[1]); w.y = cvt_pk_bf16(v0[2], v0[3]); w.z = cvt_pk_bf16(v1[0], v1[1]); w.w = cvt_pk_bf16(v1[2], v1[3]);
                        *(u32x4*)(rowp + bj * HALF) = w; } }
            return;
        }
        const int kind = (u.pn - 4) >> 1;
        bf16_t* dst = QKVo + (size_t)kind * kind_stride;
        const float scl = kind == 0 ? 0.125f : 1.0f;
        const bool roped = kind < 2 && (wc & 1) == 0;
        const int d0 = 32 * (wc & 1) + 8 * fq;
#pragma unroll
        for (int ai = 0; ai < 2; ++ai)
#pragma unroll
            for (int m = 0; m < 4; ++m) {
                const int row = row0 + ai * HALF + m * 16, b = row >> 11, sq = row & 2047;
                const float sgn = fq == 0 ? -1.f : 1.f;
#pragma unroll
                for (int bj = 0; bj < 2; ++bj) {
                    const int hh = ((u.pn & 1) << 2) + 2 * bj + (wc >> 1);
                    u32x4 w;
#pragma unroll
                    for (int n = 0; n < 2; ++n) {
                        f32x4 v = acc[ai][bj][m][n];
                        if (roped) {
                            f32x4 p;
#pragma unroll
                            for (int i = 0; i < 4; ++i) p[i] = __shfl_xor(v[i], 16);
                            if (fq < 2) { const f32x4 cs = *(const f32x4*)(rope + sq * 16 + 4 * n), sn = *(const f32x4*)(rope + sq * 16 + 8 + 4 * n); v = v * cs + p * (sn * sgn); }
                        }
                        v = v * scl;
                        if (n == 0) { w.x = cvt_pk_bf16(v[0], v[1]); w.y = cvt_pk_bf16(v[2], v[3]); } else { w.z = cvt_pk_bf16(v[0], v[1]); w.w = cvt_pk_bf16(v[2], v[3]); }
                    }
                    *(u32x4*)(dst + (((size_t)b * 8 + hh) * 2048 + sq) * 64 + d0) = w;
                }
                __builtin_amdgcn_sched_barrier(0);
            }
    }
};
struct EpiRes {
    static constexpr bool PERM = false, AFTER_DRAIN = false;
    const float* base; float* out; int ldc;
    __device__ __forceinline__ void operator()(const f32x4 (&acc)[2][2][4][2], const Unit& u, int wr, int wc, int fr, int fq) const {
        const int row0 = u.pm * BM + wr * 64 + fr, col0 = u.pn * BM + wc * 32 + 4 * fq;
#pragma unroll
        for (int ai = 0; ai < 2; ++ai)
#pragma unroll
            for (int m = 0; m < 4; ++m) { const size_t off = (size_t)(row0 + ai * HALF + m * 16) * ldc + col0;
#pragma unroll
                for (int bj = 0; bj < 2; ++bj)
#pragma unroll
                    for (int n = 0; n < 2; ++n) { const f32x4 bs = *(const f32x4*)(base + off + bj * HALF + n * 16); *(f32x4*)(out + off + bj * HALF + n * 16) = bs + acc[ai][bj][m][n]; } }
    }
};
struct EpiSwiGLU {
    static constexpr bool PERM = true, AFTER_DRAIN = false;
    unsigned char* H; int ldc; int tiles_per_expert;
    __device__ __forceinline__ void operator()(const f32x4 (&acc)[2][2][4][2], const Unit& u, int wr, int wc, int fr, int fq) const {
        const int row0 = u.pm * BM + wr * 64 + fr, col0 = (u.pn % tiles_per_expert) * HALF + wc * 32 + 8 * fq;
#pragma unroll
        for (int ai = 0; ai < 2; ++ai)
#pragma unroll
            for (int m = 0; m < 4; ++m) { unsigned char* rowp = H + (size_t)(row0 + ai * HALF + m * 16) * ldc + col0;
                float h[8];
#pragma unroll
                for (int n = 0; n < 2; ++n)
#pragma unroll
                    for (int i = 0; i < 4; i += 2) {
                        const f32x2 y = {acc[ai][0][m][n][i], acc[ai][0][m][n][i + 1]}, gp = {acc[ai][1][m][n][i], acc[ai][1][m][n][i + 1]};
                        f32x2 d = {__builtin_amdgcn_exp2f(-y[0]), __builtin_amdgcn_exp2f(-y[1])}; d = d + 1.0f;
                        const f32x2 r = {__builtin_amdgcn_rcpf(d[0]), __builtin_amdgcn_rcpf(d[1])};
                        const f32x2 o = (y * gp) * r; h[n * 4 + i] = o[0]; h[n * 4 + i + 1] = o[1]; }
                int w0 = 0, w1 = 0;
                w0 = __builtin_amdgcn_cvt_pk_fp8_f32(h[0], h[1], w0, false); w0 = __builtin_amdgcn_cvt_pk_fp8_f32(h[2], h[3], w0, true);
                w1 = __builtin_amdgcn_cvt_pk_fp8_f32(h[4], h[5], w1, false); w1 = __builtin_amdgcn_cvt_pk_fp8_f32(h[6], h[7], w1, true);
                *(unsigned long long*)rowp = (unsigned long long)(unsigned)w0 | ((unsigned long long)(unsigned)w1 << 32);
                __builtin_amdgcn_sched_barrier(0); }
    }
};
struct EpiNull {
    static constexpr bool PERM = true, AFTER_DRAIN = false;
    __device__ __forceinline__ void operator()(const f32x4 (&acc)[2][2][4][2], const Unit& u, int wr, int wc, int fr, int fq) const {
#pragma unroll
        for (int ai = 0; ai < 2; ++ai)
#pragma unroll
            for (int bj = 0; bj < 2; ++bj)
#pragma unroll
                for (int m = 0; m < 4; ++m) asm volatile("" :: "v"(acc[ai][bj][m][0]), "v"(acc[ai][bj][m][1]));
    }
};
struct EpiDown {
    static constexpr bool PERM = true, AFTER_DRAIN = false;
    bf16_t* Y; int ldc; const float* gate;
    __device__ __forceinline__ void operator()(const f32x4 (&acc)[2][2][4][2], const Unit& u, int wr, int wc, int fr, int fq) const {
        const int row0 = u.pm * BM + wr * 64 + fr, col0 = (u.pn & 3) * BM + wc * 32 + 8 * fq;
#pragma unroll
        for (int ai = 0; ai < 2; ++ai)
#pragma unroll
            for (int m = 0; m < 4; ++m) { const int row = row0 + ai * HALF + m * 16; const float gt = gate[row]; bf16_t* rowp = Y + (size_t)row * ldc + col0;
#pragma unroll
                for (int bj = 0; bj < 2; ++bj) { const f32x4 v0 = acc[ai][bj][m][0] * gt, v1 = acc[ai][bj][m][1] * gt;
                    u32x4 w; w.x = cvt_pk_bf16(v0[0], v0[1]); w.y = cvt_pk_bf16(v0[2], v0[3]); w.z = cvt_pk_bf16(v1[0], v1[1]); w.w = cvt_pk_bf16(v1[2], v1[3]);
                    *(u32x4*)(rowp + bj * HALF) = w; }
                asm volatile("" ::: "memory"); }
    }
};
struct MoeUpOrder {
    int x, lc, seg, i0, n;
    __device__ void init(int c, int seg_) { x = c & 7; lc = c >> 3; seg = seg_; const int n0 = lc < 16 ? 6 : 5; i0 = seg ? n0 : 0; n = seg ? 11 - n0 : n0; }
    __device__ bool next(int i, Unit& u) const { if (i >= n) return false; const int L = (i0 + i) * 32 + lc, e = 2 * x + L / 176, w = L % 176; u.pm = e * 8 + (w & 7); u.pn = e * 22 + (w >> 3); return true; }
    __device__ __forceinline__ void a_ready(const Unit&) const {}
    __device__ __forceinline__ void done(const Unit&) const {}
};
struct MoeDownOrder {
    int x, lc;
    __device__ void init(int c) { x = c & 7; lc = c >> 3; }
    __device__ bool next(int i, Unit& u) const { if (i >= 2) return false; const int e = 2 * x + i; u.pm = e * 8 + (lc & 7); u.pn = e * 4 + (lc >> 3); return true; }
    __device__ __forceinline__ void a_ready(const Unit&) const {}
    __device__ __forceinline__ void done(const Unit&) const {}
};

template <bool F8> struct Frag;
template <> struct Frag<false> { bf16x8 k[2]; };
template <> struct Frag<true> { v8i_t v; };
template <class Epi, class Sched, bool ALIGN_EPI = false, bool SP2 = true, bool GATHER = false, bool F8 = false>
__device__ __forceinline__ void gemm_phase(PG8_LAS unsigned char* lds, const Gemm g, const Sched& S, const Epi& E) {
    int tid_ = threadIdx.x; asm volatile("" : "+v"(tid_));
    const int tid = tid_, wid = __builtin_amdgcn_readfirstlane(tid >> 6), lane = tid & 63, wr = wid >> 2, wc = wid & 3, fr = lane & 15, fq = lane >> 4;
    const int K = g.K, KB = F8 ? K : 2 * K  , nt = KB / (BK * 2);
    unsigned voffA[2], voffB[2]; int RA[2]; unsigned CA2[2];
    unsigned gc[2][2];
#pragma unroll
    for (int i = 0; i < 2; ++i) { int R, C; stage_rc(tid * 16 + i * 8192, R, C); const int Rb = Epi::PERM ? ((R & ~31) + perm32(R & 31)) : R;
        voffA[i] = (unsigned)(R * KB + C * 2); voffB[i] = (unsigned)(Rb * KB + C * 2); RA[i] = R; CA2[i] = (unsigned)C * 2u; }
    const size_t kstep = (size_t)(BK * 2);
    const size_t hstep = (size_t)HALF * KB;
    const size_t hstepA = GATHER ? (size_t)0 : hstep;
    const size_t tstep = 2 * hstep;
    const unsigned ldsw = (unsigned)wid * 1024u;
    const int aoff = lds_byte(wr * 64 + fr, fq * 8), boff = lds_byte(wc * 32 + fr, fq * 8);
    PG8_LAS unsigned char* ldsAr = lds + aoff; PG8_LAS unsigned char* ldsBr = lds + 4 * HTB + boff;
    asm volatile("" : "+v"(ldsAr), "+v"(ldsBr));
#define PG8_SA(b, h) (((b) * 2 + (h)) * HTB)
#define PG8_SB(b, h) ((4 + (b) * 2 + (h)) * HTB)
#define PG8_STAGE(bufoff, gbase, voff) do { _Pragma("unroll") for (int _i = 0; _i < 2; ++_i) \
        __builtin_amdgcn_global_load_lds((const unsigned*)((const char*)(gbase) + (voff)[_i]), (PG8_LAS unsigned*)(lds + (bufoff) + ldsw + _i * 8192), 16, 0, 0); } while (0)
#define PG8_GLOAD(dst, u) do { _Pragma("unroll") for (int _h = 0; _h < 2; ++_h) _Pragma("unroll") for (int _i = 0; _i < 2; ++_i) \
        dst[_h][_i] = (unsigned)g.rowidx[(u).pm * BM + _h * HALF + RA[_i]] * (unsigned)KB + CA2[_i]; } while (0)
#define PG8_STAGE_A(bufoff, aptr, h, usenext) do { if constexpr (GATHER) { PG8_STAGE(bufoff, aptr, gc[h]); } \
        else { PG8_STAGE(bufoff, (aptr) + (h) * hstepA, voffA); } } while (0)
#define PG8_LD1(d, p) do { if constexpr (F8) { (d).v = cat32(*(const PG8_LAS bf16x8*)(p), *(const PG8_LAS bf16x8*)((p) + 1024)); } else { (d).k[0] = *(const PG8_LAS bf16x8*)(p); (d).k[1] = *(const PG8_LAS bf16x8*)((p) + 1024); } } while (0)
#define PG8_LDA(dst, b, h) do { _Pragma("unroll") for (int m = 0; m < 4; ++m) PG8_LD1(dst[m], ldsAr + PG8_SA(b, h) + m * 2048); } while (0)
#define PG8_LDB(dst, b, h) do { _Pragma("unroll") for (int n = 0; n < 2; ++n) PG8_LD1(dst[n], ldsBr + ((b) * 2 + (h)) * HTB + n * 2048); } while (0)
#define PG8_SUB(v, o) ((f32x4){(v)[(o)], (v)[(o) + 1], (v)[(o) + 2], (v)[(o) + 3]})
#define PG8_INS(v, r, o) do { (v)[(o)] = (r)[0]; (v)[(o) + 1] = (r)[1]; (v)[(o) + 2] = (r)[2]; (v)[(o) + 3] = (r)[3]; } while (0)
#define PG8_MMA(ai, bj, At, Bt) do { __builtin_amdgcn_s_setprio(1); \
        _Pragma("unroll") for (int m = 0; m < 4; ++m) _Pragma("unroll") for (int n = 0; n < 2; ++n) { \
            f32x4 c_ = PG8_SUB(accq[ai][bj][m >> 1], 8 * (m & 1) + 4 * n); \
            if constexpr (F8) { c_ = __builtin_amdgcn_mfma_scale_f32_16x16x128_f8f6f4(Bt[n].v, At[m].v, c_, 0, 0, 0, g.wscale, 0, 0x7f7f7f7f); } \
            else { _Pragma("unroll") for (int k = 0; k < 2; ++k) c_ = __builtin_amdgcn_mfma_f32_16x16x32_bf16(Bt[n].k[k], At[m].k[k], c_, 0, 0, 0); } \
            PG8_INS(accq[ai][bj][m >> 1], c_, 8 * (m & 1) + 4 * n); } \
        __builtin_amdgcn_s_setprio(0); } while (0)
#define PG8_WAIT_V(n) asm volatile("s_waitcnt vmcnt(" #n ")" ::: "memory")
#define PG8_WAIT_L(n) asm volatile("s_waitcnt lgkmcnt(" #n ")" ::: "memory")
#define PG8_BAR __builtin_amdgcn_s_barrier()
#define PG8_SCHED __builtin_amdgcn_sched_barrier(0)
    Unit cur, nxt; int ui = 0;
    if (!S.next(0, cur)) return;
    typedef float f32x16_t __attribute__((ext_vector_type(16)));
    f32x16_t accq[2][2][2];
    Frag<F8> At[4], B0[2], B1[2];
    const char* cA = GATHER ? (const char*)g.A : (const char*)g.A + (size_t)cur.pm * tstep; const char* cB = (const char*)g.Bt + (size_t)cur.pn * tstep;
    if constexpr (GATHER) { PG8_GLOAD(gc, cur); asm volatile("s_waitcnt vmcnt(0)" ::: "memory"); }
    S.a_ready(cur);
    if constexpr (SP2) {
        PG8_STAGE(PG8_SB(0, 0), cB, voffB); PG8_STAGE(PG8_SB(0, 1), cB + hstep, voffB); PG8_STAGE_A(PG8_SA(0, 0), cA, 0, false); PG8_STAGE_A(PG8_SA(0, 1), cA, 1, false);
        if (wr == 1) PG8_BAR;
        PG8_WAIT_V(2); PG8_BAR;
        PG8_STAGE(PG8_SB(1, 0), cB + kstep, voffB); PG8_STAGE_A(PG8_SA(1, 0), cA + kstep, 0, false); PG8_STAGE(PG8_SB(1, 1), cB + hstep + kstep, voffB);
        PG8_WAIT_V(6); PG8_BAR;
    } else {
        PG8_STAGE(PG8_SB(0, 0), cB, voffB); PG8_STAGE(PG8_SA(0, 0), cA, voffA); PG8_STAGE(PG8_SB(0, 1), cB + hstep, voffB); PG8_STAGE(PG8_SA(0, 1), cA + hstep, voffA);
        if (wr == 1) PG8_BAR;
        PG8_WAIT_V(4); PG8_BAR;
        PG8_STAGE(PG8_SB(1, 0), cB + kstep, voffB); PG8_STAGE(PG8_SA(1, 0), cA + kstep, voffA); PG8_STAGE(PG8_SB(1, 1), cB + hstep + kstep, voffB);
        PG8_WAIT_V(6); PG8_BAR;
    }
    PG8_SCHED;
#pragma unroll
    for (int a = 0; a < 2; ++a)
#pragma unroll
        for (int b = 0; b < 2; ++b)
#pragma unroll
            for (int m = 0; m < 2; ++m)
#pragma unroll
                for (int i = 0; i < 16; ++i) accq[a][b][m][i] = 0.f;
    for (;;) {
        const bool has_next = S.next(ui + 1, nxt);
        const char* nA = GATHER ? (const char*)g.A : (has_next ? (const char*)g.A + (size_t)nxt.pm * tstep : cA); const char* nB = has_next ? (const char*)g.Bt + (size_t)nxt.pn * tstep : cB;
#pragma unroll 1
        for (int t = 0; t < nt; t += 2) {
            const bool last = (t == nt - 2);
            const char* a1 = cA + (size_t)(t + 1) * kstep;
            const char* a2 = last ? nA : cA + (size_t)(t + 2) * kstep; const char* b2 = last ? nB : cB + (size_t)(t + 2) * kstep;
            const char* a3 = a2 + kstep; const char* b3 = b2 + kstep;
            if (last && has_next) S.a_ready(nxt);
            if constexpr (SP2) {
            PG8_LDB(B0, 0, 0); PG8_LDB(B1, 0, 1); PG8_SCHED; PG8_LDA(At, 0, 0); PG8_STAGE_A(PG8_SA(1, 1), a1, 1, false);
            PG8_WAIT_V(8); PG8_WAIT_L(0); PG8_BAR; PG8_MMA(0, 0, At, B0); PG8_MMA(0, 1, At, B1); PG8_BAR; PG8_SCHED;
            PG8_LDA(At, 0, 1); PG8_STAGE(PG8_SB(0, 0), b2, voffB); PG8_STAGE(PG8_SB(0, 1), b2 + hstep, voffB); PG8_STAGE_A(PG8_SA(0, 0), a2, 0, last);
            PG8_WAIT_V(8); PG8_WAIT_L(0); PG8_BAR; PG8_MMA(1, 0, At, B0); PG8_MMA(1, 1, At, B1); PG8_BAR; PG8_SCHED;
            PG8_LDB(B0, 1, 0); PG8_LDB(B1, 1, 1); PG8_SCHED; PG8_LDA(At, 1, 0); PG8_STAGE_A(PG8_SA(0, 1), a2, 1, last);
            PG8_WAIT_V(8); PG8_WAIT_L(0); PG8_BAR; PG8_MMA(0, 0, At, B0); PG8_MMA(0, 1, At, B1); PG8_BAR; PG8_SCHED;
            PG8_LDA(At, 1, 1); PG8_STAGE(PG8_SB(1, 0), b3, voffB); PG8_STAGE(PG8_SB(1, 1), b3 + hstep, voffB); PG8_STAGE_A(PG8_SA(1, 0), a3, 0, last);
            PG8_WAIT_V(8); PG8_WAIT_L(0); PG8_BAR; PG8_MMA(1, 0, At, B0); PG8_MMA(1, 1, At, B1); PG8_BAR; PG8_SCHED;
            } else {
            PG8_LDB(B0, 0, 0); PG8_SCHED; PG8_LDA(At, 0, 0); PG8_STAGE(PG8_SA(1, 1), a1 + hstep, voffA);
            PG8_WAIT_L(8); PG8_BAR; PG8_WAIT_L(0); PG8_MMA(0, 0, At, B0); PG8_BAR; PG8_SCHED;
            PG8_LDB(B1, 0, 1); PG8_STAGE(PG8_SB(0, 0), b2, voffB);
            PG8_BAR; PG8_WAIT_L(0); PG8_MMA(0, 1, At, B1); PG8_BAR;
            PG8_LDA(At, 0, 1); PG8_STAGE(PG8_SA(0, 0), a2, voffA);
            PG8_BAR; PG8_WAIT_L(0); PG8_MMA(1, 0, At, B0); PG8_BAR; PG8_SCHED;
            PG8_STAGE(PG8_SB(0, 1), b2 + hstep, voffB);
            PG8_WAIT_V(6); PG8_BAR; PG8_MMA(1, 1, At, B1); PG8_BAR;
            PG8_LDB(B0, 1, 0); PG8_SCHED; PG8_LDA(At, 1, 0); PG8_STAGE(PG8_SA(0, 1), a2 + hstep, voffA);
            PG8_WAIT_L(8); PG8_BAR; PG8_WAIT_L(0); PG8_MMA(0, 0, At, B0); PG8_BAR; PG8_SCHED;
            PG8_LDB(B1, 1, 1); PG8_STAGE(PG8_SB(1, 0), b3, voffB);
            PG8_BAR; PG8_WAIT_L(0); PG8_MMA(0, 1, At, B1); PG8_BAR;
            PG8_LDA(At, 1, 1); PG8_STAGE(PG8_SA(1, 0), a3, voffA);
            PG8_BAR; PG8_WAIT_L(0); PG8_MMA(1, 0, At, B0); PG8_BAR; PG8_SCHED;
            PG8_STAGE(PG8_SB(1, 1), b3 + hstep, voffB);
            PG8_WAIT_V(6); PG8_BAR; PG8_MMA(1, 1, At, B1); PG8_BAR;
            }
        }
        if constexpr (ALIGN_EPI) { if (wr == 0) PG8_BAR; }
        if constexpr (!Epi::AFTER_DRAIN) { f32x4 acc[2][2][4][2];
            _Pragma("unroll") for (int a = 0; a < 2; ++a) _Pragma("unroll") for (int b = 0; b < 2; ++b) _Pragma("unroll") for (int m = 0; m < 4; ++m) _Pragma("unroll") for (int n = 0; n < 2; ++n) acc[a][b][m][n] = PG8_SUB(accq[a][b][m >> 1], 8 * (m & 1) + 4 * n);
            E(acc, cur, wr, wc, fr, fq); S.done(cur); }
        if (!has_next) break;
#pragma unroll
        for (int a = 0; a < 2; ++a)
#pragma unroll
            for (int b = 0; b < 2; ++b)
#pragma unroll
                for (int m = 0; m < 2; ++m)
#pragma unroll
                    for (int i = 0; i < 16; ++i) accq[a][b][m][i] = 0.f;
        cur = nxt; cA = nA; cB = nB; ++ui;
        if constexpr (ALIGN_EPI) { if (wr == 1) PG8_BAR; }
    }
    PG8_WAIT_V(0);
    if constexpr (!ALIGN_EPI) { if (wr == 0) PG8_BAR; }
    PG8_BAR;

#undef PG8_SA
#undef PG8_SB
#undef PG8_STAGE
#undef PG8_GLOAD
#undef PG8_STAGE_A
#undef PG8_LD1
#undef PG8_LDA
#undef PG8_LDB
#undef PG8_SUB
#undef PG8_INS
#undef PG8_MMA
#undef PG8_WAIT_V
#undef PG8_WAIT_L
#undef PG8_BAR
#undef PG8_SCHED
}
}


constexpr int NB = 8, SEQ = 2048, DMODEL = 1024, NT = NB * SEQ;
constexpr int DML = 512, DAT = 512, DPROJ = 2560;
constexpr int MH = 4, MDH = 128, AH = 8, ADH = 64;
constexpr int NE = 16, CAP = 256, DEXP = 2816, NPAIR = NE * NB * CAP;
constexpr float EPS = 1e-6f;
constexpr int NWAVES = 8, NTHR = 512;

constexpr size_t MiB = 1u << 20;
constexpr size_t WS_CTL = 0, CTL_ZERO_BYTES = 32768;
constexpr size_t WS_WIN = 1 * MiB;
constexpr size_t WS_WOUT = WS_WIN + (size_t)DPROJ * DMODEL * 2;
constexpr size_t WS_W13 = WS_WOUT + (size_t)DMODEL * DMODEL * 2;
constexpr size_t WS_W2 = WS_W13 + (size_t)NE * 2 * DEXP * DMODEL;
constexpr size_t WS_XN = WS_W2 + (size_t)NE * DMODEL * DEXP;
constexpr size_t WS_PROJ = WS_XN + (size_t)NT * DMODEL * 2;
constexpr size_t WS_AFF = WS_PROJ + (size_t)NT * DPROJ * 2;
constexpr size_t WS_SLOT = WS_AFF + (size_t)NT * NE * 4;
constexpr size_t WS_SELT = WS_SLOT + (size_t)NT * NE * 4;
constexpr size_t WS_SELG = WS_SELT + (size_t)NPAIR * 4;
constexpr size_t WS_GI = WS_SELG + (size_t)NPAIR * 4;
constexpr size_t WS_GF = WS_GI + (size_t)2 * NB * MH * SEQ * 4;
constexpr size_t WS_ROPE = WS_GF + (size_t)2 * NB * MH * SEQ * 4;
constexpr size_t WS_WT = WS_ROPE + (size_t)SEQ * 16 * 4;
constexpr size_t WS_MIX0 = WS_WT + 65536;
constexpr size_t WS_XC = WS_MIX0;
constexpr size_t WS_QM = WS_XC + (size_t)NT * DML * 2;
constexpr size_t WS_KM = WS_QM + (size_t)NT * DML * 2;
constexpr size_t WS_VM = WS_KM + (size_t)NT * DML * 2;
constexpr size_t WS_QR = WS_VM + (size_t)NT * DML * 2;
constexpr size_t WS_KR = WS_QR + (size_t)NT * DAT * 2;
constexpr size_t WS_VR = WS_KR + (size_t)NT * DAT * 2;
constexpr size_t WS_HFB = WS_VR + (size_t)NT * DAT * 2;
constexpr size_t WS_OPART = WS_HFB + (size_t)2 * NT * DML * 4;
constexpr size_t WS_OSTAT = WS_OPART + (size_t)3 * NT * DAT * 2;
constexpr size_t WS_MIX1 = WS_OSTAT + (size_t)3 * NT * AH * 2 * 4;
constexpr size_t WS_YO = WS_HFB;
constexpr size_t WS_H = WS_MIX0;
constexpr size_t WS_Y = WS_PROJ;
constexpr size_t WS_END = (WS_MIX1 > WS_H + (size_t)NPAIR * DEXP) ? WS_MIX1 : WS_H + (size_t)NPAIR * DEXP;
static_assert((size_t)NPAIR * DMODEL * 2 <= (size_t)NT * DPROJ * 2, "Y fits in proj");
static_assert(WS_H + (size_t)NPAIR * DEXP <= WS_HFB && (size_t)NT * DMODEL * 2 <= (size_t)2 * NT * DML * 4, "y lives in hfb, clear of H");
static_assert(WS_END <= (size_t)736 * MiB, "d_ws map must stay below 4x the largest input");
constexpr int CW_TMO = 0, CW_QHEAD = 64, CW_MDONE = 128, CW_P1DONE = 192, CW_ADONE = 256, CW_BAR = 4096;
static_assert((CW_BAR + 3456) * 4 <= (int)CTL_ZERO_BYTES, "control words inside the per-call memset");
constexpr int CVT_EARLY = (DMODEL / 64) * (DPROJ / 64) + (DMODEL / 64) * (DMODEL / 64);
constexpr int CVT_MOE = NE * (2 * (DMODEL / 64) * (DEXP / 64) + (DEXP / 64) * (DMODEL / 64)), CVT_BATCH = 8, CVT_NBATCH = CVT_MOE / CVT_BATCH;
static_assert(CVT_MOE % CVT_BATCH == 0, "conversion batches");

constexpr int RING_OFF = 0, RING_BYTES = 155648;
constexpr int LDSCTL_OFF = RING_BYTES, MISC_OFF = LDSCTL_OFF + 320;
constexpr int LDS_BYTES = 160 * 1024;

#define GAS __attribute__((address_space(1)))
#define LAS __attribute__((address_space(3)))
typedef unsigned short bf16;
typedef unsigned v4u __attribute__((ext_vector_type(4)));
typedef float f32x4 __attribute__((ext_vector_type(4)));
typedef short bf16x8 __attribute__((ext_vector_type(8)));
typedef GAS unsigned gu32;
typedef GAS unsigned long long gu64;
#define RLX_AGENT __ATOMIC_RELAXED, __HIP_MEMORY_SCOPE_AGENT
#define LDS_WAIT() asm volatile("s_waitcnt lgkmcnt(0)" ::: "memory")
#define VM_WAIT() asm volatile("s_waitcnt vmcnt(0)" ::: "memory")
__device__ __forceinline__ unsigned long long rt() { return __builtin_amdgcn_s_memrealtime(); }
__device__ __forceinline__ unsigned f2bf(float f) { unsigned u = __builtin_bit_cast(unsigned, f); return (u + 0x7fffu + ((u >> 16) & 1u)) >> 16; }
__device__ __forceinline__ unsigned pk2(float lo, float hi) { return f2bf(lo) | (f2bf(hi) << 16); }

#define XB_TMO      128
#define XB_XCNT(j)  (256  + 64 * (j))
#define XB_XSUB(j)  (1280 + 64 * (j))
#define XB_XGEN(j)  (2304 + 64 * (j))
#define XB_TOP      3328
#define XB_TOPGEN   3392
#define XCD_BAR_WORDS 3456
#define XB_SPIN_CAP (1u << 18)

__device__ __forceinline__ unsigned xb_ld(unsigned* p)              { return __hip_atomic_load(p, __ATOMIC_RELAXED, __HIP_MEMORY_SCOPE_AGENT); }
__device__ __forceinline__ unsigned xb_add(unsigned* p, unsigned v) { return __hip_atomic_fetch_add(p, v, __ATOMIC_RELAXED, __HIP_MEMORY_SCOPE_AGENT); }
__device__ __forceinline__ unsigned xb_xcc_id() { return (unsigned)__builtin_amdgcn_s_getreg((3 << 11) | 20) & 0xFu; }
#define XB_SPIN(cond, bar) do { unsigned _sp = 0; while (cond) { __builtin_amdgcn_s_sleep(1); \
    if ((++_sp & 255u) == 0u) { if (xb_ld(&(bar)[XB_TMO])) break; if (_sp > XB_SPIN_CAP) { atomicAdd(&(bar)[XB_TMO], 1u); break; } } } } while (0)

struct XcdBarrier {
    unsigned* bar; unsigned x;
    volatile LAS unsigned* st;
};

__device__ __forceinline__ XcdBarrier xcd_barrier_post(unsigned* bar, volatile LAS unsigned* st) {
    XcdBarrier b; b.bar = bar; b.x = xb_xcc_id(); b.st = st;
    if (threadIdx.x == 0) (void)xb_add(&bar[XB_XCNT(b.x)], 1u);
    return b;
}
__device__ __forceinline__ void xcd_barrier_complete(unsigned* bar, unsigned x, unsigned& nloc, unsigned& nx) {
    const unsigned G = gridDim.x * gridDim.y * gridDim.z;
    unsigned sum, cnt, mine, sp = 0u;
    for (;;) {
        sum = 0u; cnt = 0u; mine = 0u;
#pragma unroll
        for (unsigned j = 0; j < 16; ++j) { const unsigned c = xb_ld(&bar[XB_XCNT(j)]); sum += c; cnt += (c > 0u) ? 1u : 0u; mine = (j == x) ? c : mine; }
        if (sum == G) break;
        __builtin_amdgcn_s_sleep(1);
        if ((++sp & 255u) == 0u) { if (xb_ld(&bar[XB_TMO])) break; if (sp > XB_SPIN_CAP) { atomicAdd(&bar[XB_TMO], 1u); break; } }
    }
    nloc = mine > 0u ? mine : 1u; nx = cnt > 0u ? cnt : 1u;
}

__device__ __forceinline__ void xcd_barrier(const XcdBarrier& b) {
    asm volatile("s_waitcnt vmcnt(0)" ::: "memory");
    __syncthreads();
    if (threadIdx.x == 0) {
        unsigned* bar = b.bar;
        __builtin_amdgcn_s_waitcnt(0);
        unsigned nloc = b.st[0], nx = b.st[1];
        if (nloc == 0u) { xcd_barrier_complete(bar, b.x, nloc, nx); b.st[0] = nloc; b.st[1] = nx; }
        const unsigned old = xb_add(&bar[XB_XSUB(b.x)], 1u);
        const unsigned gen = old / nloc;
        if (old + 1u == (gen + 1u) * nloc) {
            __builtin_amdgcn_fence(__ATOMIC_RELEASE, "agent");
            asm volatile("s_waitcnt vmcnt(0)" ::: "memory");
            const unsigned og = xb_add(&bar[XB_TOP], 1u);
            const unsigned tg = og / nx;
            if (og + 1u == (tg + 1u) * nx) xb_add(&bar[XB_TOPGEN], 1u);
            else XB_SPIN(xb_ld(&bar[XB_TOPGEN]) == tg, bar);
            __builtin_amdgcn_fence(__ATOMIC_ACQUIRE, "agent");
            xb_add(&bar[XB_XGEN(b.x)], 1u);
            asm volatile("s_waitcnt vmcnt(0)" ::: "memory");
        } else {
            XB_SPIN(xb_ld(&bar[XB_XGEN(b.x)]) == gen, bar);
            __builtin_amdgcn_fence(__ATOMIC_ACQUIRE, "agent");
            asm volatile("s_waitcnt vmcnt(0)" ::: "memory");
        }
    }
    __syncthreads();
}


__device__ __forceinline__ float bf2f(unsigned short u) { return __uint_as_float((unsigned)u << 16); }
__device__ __forceinline__ float wave_sum(float v) {
#pragma unroll
    for (int o = 1; o < 64; o <<= 1) v += __shfl_xor(v, o);
    return v;
}
__device__ __forceinline__ float siluf(float x) { return x / (1.f + expf(-x)); }
__device__ __forceinline__ float logsigf(float x) { return fminf(x, 0.f) - log1pf(expf(-fabsf(x))); }

struct Args {
    const float* in[22]; float* out; unsigned char* ws; int ph_lo, ph_hi, li, pad;
};
struct Frame { LAS unsigned char* lds; int tid, lane, wave, G, bx; };

__device__ __forceinline__ void cvt_load(const float* W, int ldw, int k0, int n0, int lane, f32x4 (&r)[16]) {
    const int n4 = lane & 15, rp = lane >> 4;
#pragma unroll
    for (int it = 0; it < 8; ++it) {
        const float* p = W + (size_t)(k0 + 8 * it + 2 * rp) * ldw + n0 + 4 * n4;
        r[2 * it] = *(const GAS f32x4*)p; r[2 * it + 1] = *(const GAS f32x4*)(p + ldw);
    }
}
__device__ __forceinline__ void cvt_store(const f32x4 (&r)[16], unsigned char* dst  , int ldd  , LAS unsigned* scr, int lane) {
    const int n4 = lane & 15, rp = lane >> 4;
#pragma unroll
    for (int it = 0; it < 8; ++it) {
        const int kp = 4 * it + rp;
#pragma unroll
        for (int i = 0; i < 4; ++i) { const int n = 4 * n4 + i; scr[n * 32 + (((kp >> 2) ^ (n4 & 7)) << 2) + (kp & 3)] = pk2(r[2 * it][i], r[2 * it + 1][i]); }
    }
    LDS_WAIT(); asm volatile("" ::: "memory");
    const int c = lane & 7;
#pragma unroll
    for (int it = 0; it < 8; ++it) {
        const int n = 8 * it + (lane >> 3);
        const v4u o = *(const LAS v4u*)(scr + n * 32 + ((c ^ ((n >> 2) & 7)) << 2));
        *(GAS v4u*)(dst + (size_t)n * ldd + 16 * c) = o;
    }
    LDS_WAIT(); asm volatile("" ::: "memory");
}
__device__ __forceinline__ void cvt8_load(const float* W, int ldw, int k0, int n0, int lane, f32x4 (&r)[16]) {
    const int n4 = lane & 15, rp = lane >> 4;
#pragma unroll
    for (int it = 0; it < 4; ++it) {
        const float* p = W + (size_t)(k0 + 16 * it + 4 * rp) * ldw + n0 + 4 * n4;
#pragma unroll
        for (int q = 0; q < 4; ++q) r[4 * it + q] = __builtin_nontemporal_load((const GAS f32x4*)(p + (size_t)q * ldw));
    }
}
__device__ __forceinline__ void cvt8_store(const f32x4 (&r)[16], unsigned char* dst, int ldd, LAS unsigned* scr, int lane, float sc) {
    const int n4 = lane & 15, rp = lane >> 4;
#pragma unroll
    for (int it = 0; it < 4; ++it) {
        const int kq = 4 * it + rp;
#pragma unroll
        for (int i = 0; i < 4; ++i) { int w = 0; w = __builtin_amdgcn_cvt_pk_fp8_f32(r[4 * it][i] * sc, r[4 * it + 1][i] * sc, w, false); w = __builtin_amdgcn_cvt_pk_fp8_f32(r[4 * it + 2][i] * sc, r[4 * it + 3][i] * sc, w, true);
            scr[(4 * n4 + i) * 17 + kq] = (unsigned)w; }
    }
    LDS_WAIT(); asm volatile("" ::: "memory");
    const int c = lane & 3;
#pragma unroll
    for (int j = 0; j < 4; ++j) {
        const int n = 16 * j + (lane >> 2);
        const v4u o = {scr[n * 17 + 4 * c], scr[n * 17 + 4 * c + 1], scr[n * 17 + 4 * c + 2], scr[n * 17 + 4 * c + 3]};
        *(GAS v4u*)(dst + (size_t)n * ldd + 16 * c) = o;
    }
    LDS_WAIT(); asm volatile("" ::: "memory");
}
struct CvtItem { const float* W; int ldw, k0, n0; unsigned char* dst; int ldd; int f8; float sc; };
__device__ __forceinline__ bool cvt_item(const Args& a, int it, CvtItem& c) {
    unsigned char* ws = a.ws;
    constexpr int I_IN = (DMODEL / 64) * (DPROJ / 64), I_OUT = (DMODEL / 64) * (DMODEL / 64), I_W1 = (DMODEL / 64) * (DEXP / 64), I_W2 = (DEXP / 64) * (DMODEL / 64);
    constexpr int NITEMS = I_IN + I_OUT + NE * (2 * I_W1 + I_W2);
    if (it >= NITEMS) return false;
    if (it < I_IN) { const int nb = DPROJ / 64, kb = it / nb, n0 = (it % nb) * 64; c = {a.in[2], DPROJ, kb * 64, n0, ws + WS_WIN + ((size_t)n0 * DMODEL + kb * 64) * 2, DMODEL * 2, 0, 1.f}; return true; }
    it -= I_IN;
    if (it < I_OUT) { const int nb = DMODEL / 64, kb = it / nb, n0 = (it % nb) * 64; c = {a.in[15], DMODEL, kb * 64, n0, ws + WS_WOUT + ((size_t)n0 * DMODEL + kb * 64) * 2, DMODEL * 2, 0, 1.f}; return true; }
    it -= I_OUT;
    const int per_e = 2 * I_W1 + I_W2, e = it / per_e; it %= per_e;
    if (it < 2 * I_W1) { const int which = it / I_W1; it %= I_W1; const int nb = DEXP / 64, kb = it / nb, n0 = (it % nb) * 64;
        const float* W = a.in[which ? 19 : 18] + (size_t)e * DMODEL * DEXP;
        const size_t drow = (size_t)e * 2 * DEXP + (size_t)(n0 / 128) * 256 + (n0 % 128) + (which ? 128 : 0);
        c = {W, DEXP, kb * 64, n0, ws + WS_W13 + drow * DMODEL + kb * 64, DMODEL, 1, which ? 32.f * 0.6931471805599453f : 32.f * 1.4426950408889634f}; return true; }
    it -= 2 * I_W1;
    { const int nb = DMODEL / 64, kb = it / nb, n0 = (it % nb) * 64; const float* W = a.in[20] + (size_t)e * DEXP * DMODEL;
      c = {W, DMODEL, kb * 64, n0, ws + WS_W2 + ((size_t)e * DMODEL + n0) * DEXP + kb * 64, DEXP, 1, 64.f}; return true; }
}
__device__ __forceinline__ void p0_prologue(const Args& a, Frame& F) {
    LAS unsigned* scr = (LAS unsigned*)(F.lds + RING_OFF + F.wave * 8192);
    const int gw = F.bx * NWAVES + F.wave, NGW = F.G * NWAVES;
    {
        const float* x = a.in[0]; const float* g1 = a.in[1]; bf16* XN = (bf16*)(a.ws + WS_XN);
        f32x4 gq[4];
#pragma unroll
        for (int j = 0; j < 4; ++j) gq[j] = ((const GAS f32x4*)g1)[F.lane + 64 * j];
        f32x4 nx[4];
        if (gw < NT) {
#pragma unroll
            for (int j = 0; j < 4; ++j) nx[j] = ((const GAS f32x4*)(x + (size_t)gw * DMODEL) + F.lane)[64 * j]; }
        for (int m = gw; m < NT; m += NGW) {
            f32x4 v[4]; float s = 0.f;
#pragma unroll
            for (int j = 0; j < 4; ++j) v[j] = nx[j];
            if (m + NGW < NT) {
#pragma unroll
                for (int j = 0; j < 4; ++j) nx[j] = ((const GAS f32x4*)(x + (size_t)(m + NGW) * DMODEL) + F.lane)[64 * j]; }
#pragma unroll
            for (int j = 0; j < 4; ++j) s += (v[j].x * v[j].x + v[j].y * v[j].y) + (v[j].z * v[j].z + v[j].w * v[j].w);
            const float r = rsqrtf(wave_sum(s) * (1.f / DMODEL) + EPS);
            GAS unsigned long long* o8 = (GAS unsigned long long*)(XN + (size_t)m * DMODEL) + F.lane;
#pragma unroll
            for (int j = 0; j < 4; ++j) { const f32x4 w = gq[j];
                o8[64 * j] = (unsigned long long)pk2(v[j].x * r * w.x, v[j].y * r * w.y) | ((unsigned long long)pk2(v[j].z * r * w.z, v[j].w * r * w.w) << 32); }
        }
    }
    { float* rope = (float*)(a.ws + WS_ROPE);
      for (int i = F.bx * NTHR + F.tid; i < SEQ * 8; i += F.G * NTHR) { const int sidx = i >> 3, k = i & 7; const float ang = (float)sidx * powf(500000.0f, -2.0f * (float)k / 16.0f); rope[sidx * 16 + k] = cosf(ang); rope[sidx * 16 + 8 + k] = sinf(ang); } }
    { unsigned char* img = a.ws + WS_WT; const float* wf = a.in[8]; const float* wb = a.in[10];
      for (int i = F.bx * NTHR + F.tid; i < 16 * 1536; i += F.G * NTHR) { const int n = i / 1536, k = i % 1536; *(bf16*)(img + n * 3088 + k * 2) = (bf16)f2bf(n < 8 ? wf[(size_t)k * 8 + n] : wb[(size_t)k * 8 + n - 8]); } }
    CvtItem cur, nxt; f32x4 ra[16], rb[16];
#define CVT_LOAD(c, r) do { if ((c).f8) cvt8_load((c).W, (c).ldw, (c).k0, (c).n0, F.lane, r); else cvt_load((c).W, (c).ldw, (c).k0, (c).n0, F.lane, r); } while (0)
#define CVT_STORE(c, r) do { if ((c).f8) cvt8_store(r, (c).dst, (c).ldd, scr, F.lane, (c).sc); else cvt_store(r, (c).dst, (c).ldd, scr, F.lane); } while (0)
    int it = gw; bool have = it < CVT_EARLY && cvt_item(a, it, cur);
    if (have) CVT_LOAD(cur, ra);
    while (have) {
        const bool hn = (it + NGW < CVT_EARLY) && cvt_item(a, it + NGW, nxt);
        if (hn) CVT_LOAD(nxt, rb);
        CVT_STORE(cur, ra);
        it += NGW; have = hn; if (!have) break;
        cur = nxt;
        const bool hn2 = (it + NGW < CVT_EARLY) && cvt_item(a, it + NGW, nxt);
        if (hn2) CVT_LOAD(nxt, ra);
        CVT_STORE(cur, rb);
        it += NGW; have = hn2; cur = nxt;
    }
}
__device__ __forceinline__ bool cvt_batch(const Args& a, Frame& F, int stop_word, unsigned stop_target, int stop_word2 = -1, unsigned stop_target2 = 0u, int qword = CW_QHEAD) {
    gu32* ctl = (gu32*)(a.ws + WS_CTL);
    volatile LAS unsigned* bq = (volatile LAS unsigned*)(F.lds + LDSCTL_OFF + 64);
    LAS unsigned* scr = (LAS unsigned*)(F.lds + RING_OFF + F.wave * 8192);
    __syncthreads();
    if (F.tid == 0) {
        unsigned v = 0xffffffffu;
        bool stop = stop_word >= 0 && __hip_atomic_load(ctl + stop_word, RLX_AGENT) >= stop_target;
        if (stop && stop_word2 >= 0) stop = __hip_atomic_load(ctl + stop_word2, RLX_AGENT) >= stop_target2;
        if (!stop) v = __hip_atomic_fetch_add(ctl + qword, 1u, RLX_AGENT);
        bq[0] = v;
    }
    __syncthreads();
    const unsigned batch = bq[0];
    if (batch >= (unsigned)CVT_NBATCH) return false;
    const int it0 = CVT_EARLY + (int)batch * CVT_BATCH + F.wave;
    CvtItem c0; f32x4 ra[16];
    cvt_item(a, it0, c0); CVT_LOAD(c0, ra);
    CVT_STORE(c0, ra);
    return true;
}
#ifndef NATT
#define NATT 128
#endif
__device__ __forceinline__ void cvt_stream(const Args& a, Frame& F, int stop_word, unsigned stop_target, int stop_word2 = -1, unsigned stop_target2 = 0u, int qword = CW_QHEAD) {
    gu32* ctl = (gu32*)(a.ws + WS_CTL);
    volatile LAS unsigned* bq = (volatile LAS unsigned*)(F.lds + LDSCTL_OFF + 64);
    LAS unsigned* scr = (LAS unsigned*)(F.lds + RING_OFF + F.wave * 8192);
    unsigned vq = 0xffffffffu, f1 = 0u, f2 = 0u;
#define CVT_FETCH() do { bool stop_ = stop_word >= 0 && f1 >= stop_target && (stop_word2 < 0 || f2 >= stop_target2); \
        vq = stop_ ? 0xffffffffu : __hip_atomic_fetch_add(ctl + qword, 1u, RLX_AGENT); \
        if (stop_word >= 0) f1 = __hip_atomic_load(ctl + stop_word, RLX_AGENT); if (stop_word2 >= 0) f2 = __hip_atomic_load(ctl + stop_word2, RLX_AGENT); } while (0)
    __syncthreads();
    if (F.tid == 0) { CVT_FETCH(); bq[0] = vq; CVT_FETCH(); }
    __syncthreads();
    CvtItem ca, cb; f32x4 ra[16], rb[16];
    const unsigned b0 = bq[0];
    if (b0 >= (unsigned)CVT_NBATCH) return;
    cvt_item(a, CVT_EARLY + (int)b0 * CVT_BATCH + F.wave, ca); CVT_LOAD(ca, ra);
    for (;;) {
        if (F.tid == 0) { bq[1] = vq; CVT_FETCH(); }
        __syncthreads();
        const unsigned b1 = bq[1]; const bool h1 = b1 < (unsigned)CVT_NBATCH;
        if (h1) { cvt_item(a, CVT_EARLY + (int)b1 * CVT_BATCH + F.wave, cb); CVT_LOAD(cb, rb); }
        CVT_STORE(ca, ra);
        if (!h1) break;
        if (F.tid == 0) { bq[0] = vq; CVT_FETCH(); }
        __syncthreads();
        const unsigned b2 = bq[0]; const bool h2 = b2 < (unsigned)CVT_NBATCH;
        if (h2) { cvt_item(a, CVT_EARLY + (int)b2 * CVT_BATCH + F.wave, ca); CVT_LOAD(ca, ra); }
        CVT_STORE(cb, rb);
        if (!h2) break;
    }
#undef CVT_FETCH
}
#ifndef CVT_PIPE
#define CVT_PIPE 0
#endif
__device__ __forceinline__ void cvt_run(const Args& a, Frame& F, int stop_word, unsigned stop_target, int stop_word2 = -1, unsigned stop_target2 = 0u, int qword = CW_QHEAD) {
    if (CVT_PIPE) cvt_stream(a, F, stop_word, stop_target, stop_word2, stop_target2, qword);
    else { while (cvt_batch(a, F, stop_word, stop_target, stop_word2, stop_target2, qword)) {} }
}
#undef CVT_LOAD
#undef CVT_STORE

constexpr int P2_STR = 3088;
constexpr int P2_WT = 0, P2_TILE = 16 * P2_STR, P2_PART = 32 * P2_STR, P2_WQKV = P2_PART + 8192, P2_CONV = P2_WQKV + 3 * 2048 * 4;
static_assert(P2_CONV + 6 * 512 * 4 <= RING_BYTES, "prep LDS map");
__device__ __forceinline__ float bflo(unsigned u) { return __uint_as_float(u << 16); }
__device__ __forceinline__ float bfhi(unsigned u) { return __uint_as_float(u & 0xffff0000u); }
__device__ __forceinline__ void p2_prep(const Args& a, Frame& F) {
    LAS unsigned char* L = F.lds + RING_OFF;
    const bf16* proj = (const bf16*)(a.ws + WS_PROJ);
    const float* conv_w = a.in[3]; const float* conv_b = a.in[4]; const float* wq = a.in[5]; const float* wk = a.in[6]; const float* wv = a.in[7];
    const float* wif_f = a.in[8]; const float* bif_f = a.in[9]; const float* wif_b = a.in[10]; const float* bif_b = a.in[11];
    bf16* xc = (bf16*)(a.ws + WS_XC); bf16* qm = (bf16*)(a.ws + WS_QM); bf16* km = (bf16*)(a.ws + WS_KM); bf16* vm = (bf16*)(a.ws + WS_VM);
    float* gI = (float*)(a.ws + WS_GI); float* gF = (float*)(a.ws + WS_GF); const float* rope = (const float*)(a.ws + WS_ROPE);
    bf16* qr = (bf16*)(a.ws + WS_QR); bf16* kr = (bf16*)(a.ws + WS_KR); bf16* vr = (bf16*)(a.ws + WS_VR);
    const int tid = F.tid, lane = F.lane, w = F.wave, c0 = 8 * lane, c16 = lane & 15, g = lane >> 4;
    LAS float* wqkv = (LAS float*)(L + P2_WQKV); LAS float* convl = (LAS float*)(L + P2_CONV); LAS float* part = (LAS float*)(L + P2_PART);
    __syncthreads();
    {
        const v4u* img = (const v4u*)(a.ws + WS_WT);
        v4u wi[7]; f32x4 wa[3], wb2[3], wc[3], cv[2];
#pragma unroll
        for (int i = 0; i < 7; ++i) { const int idx = tid + NTHR * i; wi[i] = idx < 16 * P2_STR / 16 ? img[idx] : (v4u){0u, 0u, 0u, 0u}; }
        wa[0] = ((const f32x4*)wq)[tid]; wb2[0] = ((const f32x4*)wk)[tid]; wc[0] = ((const f32x4*)wv)[tid];
        cv[0] = ((const f32x4*)conv_w)[tid]; cv[1] = tid < 128 ? ((const f32x4*)conv_w)[512 + tid] : ((const f32x4*)conv_b)[(tid - 128) & 127];
#pragma unroll
        for (int i = 0; i < 7; ++i) { const int idx = tid + NTHR * i; if (idx < 16 * P2_STR / 16) *(LAS v4u*)(L + P2_WT + idx * 16) = wi[i]; }
        ((LAS f32x4*)wqkv)[tid] = wa[0]; ((LAS f32x4*)wqkv)[512 + tid] = wb2[0] * 0.08838834764831845f; ((LAS f32x4*)wqkv)[1024 + tid] = wc[0];
        ((LAS f32x4*)convl)[tid] = cv[0];
        if (tid < 128) ((LAS f32x4*)convl)[512 + tid] = cv[1]; else if (tid < 256) ((LAS f32x4*)convl)[640 + tid - 128] = cv[1];
    }
    __syncthreads();
    float cw[5][8], cb[8];
#pragma unroll
    for (int t5 = 0; t5 < 5; ++t5) { const f32x4 x0 = *(const LAS f32x4*)(convl + t5 * 512 + c0), x1 = *(const LAS f32x4*)(convl + t5 * 512 + c0 + 4);
#pragma unroll
        for (int i = 0; i < 4; ++i) { cw[t5][i] = x0[i]; cw[t5][4 + i] = x1[i]; } }
    { const f32x4 x0 = *(const LAS f32x4*)(convl + 2560 + c0), x1 = *(const LAS f32x4*)(convl + 2560 + c0 + 4);
#pragma unroll
      for (int i = 0; i < 4; ++i) { cb[i] = x0[i]; cb[4 + i] = x1[i]; } }
    for (int tile = F.bx; tile < NT / 64; tile += F.G) {
        const int t0 = tile * 64, b = t0 / SEQ, s0 = t0 % SEQ;
        v4u xr[12];
#pragma unroll
        for (int i = 0; i < 12; ++i) { const int sx = s0 + 8 * w - 2 + i; xr[i] = (sx >= 0 && sx < SEQ) ? *(const v4u*)(proj + (size_t)(b * SEQ + sx) * DPROJ + c0) : (v4u){0u, 0u, 0u, 0u}; }
#pragma unroll
        for (int rnd = 0; rnd < 4; ++rnd) {
#pragma unroll
            for (int tt = 0; tt < 2; ++tt) {
                const int ti = 2 * rnd + tt;
                float xcv[8], xmv[8];
#pragma unroll
                for (int i = 0; i < 4; ++i) {
                    float a0 = cb[2 * i], a1 = cb[2 * i + 1];
#pragma unroll
                    for (int t5 = 0; t5 < 5; ++t5) { a0 += cw[t5][2 * i] * bflo(xr[ti + t5][i]); a1 += cw[t5][2 * i + 1] * bfhi(xr[ti + t5][i]); }
                    xcv[2 * i] = a0 * __builtin_amdgcn_rcpf(1.f + __expf(-a0)); xcv[2 * i + 1] = a1 * __builtin_amdgcn_rcpf(1.f + __expf(-a1));
                    xmv[2 * i] = bflo(xr[ti + 2][i]); xmv[2 * i + 1] = bfhi(xr[ti + 2][i]);
                }
                float qv[8], kv[8], vv[8];
#pragma unroll
                for (int grp = 0; grp < 2; ++grp) {
                    const LAS f32x4* wp = (const LAS f32x4*)(wqkv + (2 * lane + grp) * 16);
                    f32x4 q4 = {0.f, 0.f, 0.f, 0.f}, k4 = q4, v4 = q4;
#pragma unroll
                    for (int i = 0; i < 4; ++i) { q4 += wp[i] * xcv[4 * grp + i]; k4 += wp[512 + i] * xcv[4 * grp + i]; v4 += wp[1024 + i] * xmv[4 * grp + i]; }
#pragma unroll
                    for (int o = 0; o < 4; ++o) { qv[4 * grp + o] = q4[o]; kv[4 * grp + o] = k4[o]; vv[4 * grp + o] = v4[o]; }
                }
                const v4u xcp = {pk2(xcv[0], xcv[1]), pk2(xcv[2], xcv[3]), pk2(xcv[4], xcv[5]), pk2(xcv[6], xcv[7])};
                const v4u qp = {pk2(qv[0], qv[1]), pk2(qv[2], qv[3]), pk2(qv[4], qv[5]), pk2(qv[6], qv[7])};
                const v4u kp = {pk2(kv[0], kv[1]), pk2(kv[2], kv[3]), pk2(kv[4], kv[5]), pk2(kv[6], kv[7])};
                const v4u vp = {pk2(vv[0], vv[1]), pk2(vv[2], vv[3]), pk2(vv[4], vv[5]), pk2(vv[6], vv[7])};
                const size_t go = (size_t)(t0 + 8 * w + ti) * DML + c0;
                *(v4u*)(xc + go) = xcp; *(v4u*)(qm + go) = qp; *(v4u*)(km + go) = kp; *(v4u*)(vm + go) = vp;
                LAS unsigned char* tr = L + P2_TILE + (2 * w + tt) * P2_STR + c0 * 2;
                *(LAS v4u*)tr = qp; *(LAS v4u*)(tr + 1024) = kp; *(LAS v4u*)(tr + 2048) = vp;
            }
            __syncthreads();
            f32x4 D = {0.f, 0.f, 0.f, 0.f};
#pragma unroll
            for (int kk = 0; kk < 6; ++kk) { const int ks = 6 * w + kk;
                const bf16x8 A = *(const LAS bf16x8*)(L + P2_TILE + c16 * P2_STR + (32 * ks + 8 * g) * 2);
                const bf16x8 B = *(const LAS bf16x8*)(L + P2_WT + c16 * P2_STR + (32 * ks + 8 * g) * 2);
                D = __builtin_amdgcn_mfma_f32_16x16x32_bf16(A, B, D, 0, 0, 0); }
#pragma unroll
            for (int r = 0; r < 4; ++r) part[w * 256 + (4 * g + r) * 16 + c16] = D[r];
            __syncthreads();
            if (tid < 256) {
                const int row = tid >> 4, n = tid & 15;
                float sm = 0.f;
#pragma unroll
                for (int ww = 0; ww < 8; ++ww) sm += part[ww * 256 + tid];
                const int dirn = n >> 3, j = n & 7, hh = j & 3;
                sm += dirn ? bif_b[j] : bif_f[j];
                const int sx = s0 + 8 * (row >> 1) + 2 * rnd + (row & 1);
                const size_t off = ((size_t)(dirn * NB + b) * MH + hh) * SEQ + sx;
                if (j < 4) gI[off] = sm; else gF[off] = logsigf(sm);
            }
        }
    }
}

typedef short s16x4 __attribute__((ext_vector_type(4)));
typedef short v4i16_t __attribute__((ext_vector_type(4)));
constexpr int ML_STR = 288, ML_TILE = 64 * ML_STR, ML_WSTR = 144;
constexpr int ML_Q = 0, ML_K = ML_TILE, ML_V = 2 * ML_TILE, ML_W = 3 * ML_TILE, ML_PSUM = ML_W + 64 * ML_WSTR, ML_QN = ML_PSUM + 1024, ML_NBUF = ML_QN + 256, ML_SCR = ML_NBUF + 1024;
static_assert(ML_SCR + 8 * 1024 <= RING_BYTES, "mlstm LDS map");
__device__ __forceinline__ unsigned cvtpk2(float lo, float hi) { unsigned r; asm volatile("v_cvt_pk_bf16_f32 %0, %1, %2" : "=v"(r) : "v"(lo), "v"(hi)); return r; }
__device__ __forceinline__ s16x4 trr(LAS unsigned char* p) { return __builtin_bit_cast(s16x4, __builtin_amdgcn_ds_read_tr16_b64_v4i16((LAS v4i16_t*)p)); }
__device__ __forceinline__ bf16x8 cat8(s16x4 a, s16x4 b) { return (bf16x8){a[0], a[1], a[2], a[3], b[0], b[1], b[2], b[3]}; }
__device__ __forceinline__ float scan_add(float x, int lane) {
#pragma unroll
    for (int o = 1; o < 64; o <<= 1) { const float v = __shfl_up(x, o); if (lane >= o) x += v; }
    return x;
}
__device__ __forceinline__ float scan_max(float x, int lane) {
#pragma unroll
    for (int o = 1; o < 64; o <<= 1) { const float v = __shfl_up(x, o); if (lane >= o) x = fmaxf(x, v); }
    return x;
}
constexpr int ML_SCAL = ML_SCR + 8 * 1024;
constexpr int ML_CH = ML_SCAL + 4 * 2048 * 4;
static_assert(ML_CH + 4 * 32 * 4 <= RING_BYTES, "mlstm LDS map 2");
template <int MLV>
__device__ __forceinline__ void mlstm_item(const Args& a, Frame& F, int item) {
    const int dir = item & 1, h = (item >> 1) & 3, b = item >> 3;
    LAS unsigned char* L = F.lds + RING_OFF;
    const int tid = F.tid, w = F.wave; int lane = F.lane, c16 = lane & 15, g = lane >> 4;
    const bf16* qm = (const bf16*)(a.ws + WS_QM); const bf16* km = (const bf16*)(a.ws + WS_KM); const bf16* vm = (const bf16*)(a.ws + WS_VM);
    const float* gi = (const float*)(a.ws + WS_GI) + ((size_t)(dir * NB + b) * MH + h) * SEQ;
    const float* gf = (const float*)(a.ws + WS_GF) + ((size_t)(dir * NB + b) * MH + h) * SEQ;
    bf16* hout = (bf16*)(a.ws + WS_HFB) + (size_t)dir * NT * DML;
    LAS float* scr = (LAS float*)(L + ML_SCR + w * 1024);
    LAS float* Psum = (LAS float*)(L + ML_PSUM); LAS float* qn = (LAS float*)(L + ML_QN); LAS float* nbuf = (LAS float*)(L + ML_NBUF);
    LAS float* s_isc = (LAS float*)(L + ML_SCAL); LAS float* s_rt = s_isc + 2048; LAS float* s_u = s_isc + 4096; LAS float* s_emt = s_isc + 6144;
    LAS float* c_decay = (LAS float*)(L + ML_CH); LAS float* c_f = c_decay + 32; LAS float* c_cref = c_decay + 64; LAS float* c_gtot = c_decay + 96;
    int srow = tid >> 3, spart = tid & 7;
#define hoff ((size_t)h * MDH + 16 * spart)
    f32x4 Cacc[8];
#pragma unroll
    for (int te = 0; te < 8; ++te) Cacc[te] = (f32x4){0.f, 0.f, 0.f, 0.f};
    v4u rq[2], rk[2], rv[2];
    __syncthreads();
    { const int pos = dir ? (SEQ - 1 - srow) : srow; const size_t ro = (size_t)(b * SEQ + pos) * DML + hoff;
      rq[0] = *(const v4u*)(qm + ro); rq[1] = *(const v4u*)(qm + ro + 8); rk[0] = *(const v4u*)(km + ro); rk[1] = *(const v4u*)(km + ro + 8); rv[0] = *(const v4u*)(vm + ro); rv[1] = *(const v4u*)(vm + ro + 8); }
#pragma unroll
    for (int q = 0; q < 4; ++q) {
        const int cc = 4 * w + q, j = cc * 64 + lane, pos = dir ? (SEQ - 1 - j) : j;
        const float ig = gi[pos], lf = gf[pos];
        const float bb = scan_add(lf, lane), x = ig - bb, pm = scan_max(x, lane);
        s_emt[j] = bb; s_u[j] = x; s_rt[j] = pm;
        if (lane == 63) { c_cref[cc] = pm; c_gtot[cc] = bb; }
    }
    if (tid < 256) nbuf[tid] = 0.f;
    __syncthreads();
    {
        float m_prev = 0.f, mp0 = 0.f, mp1 = 0.f, mp2 = 0.f, mp3 = 0.f;
#pragma unroll 1
        for (int cc = 0; cc < 32; ++cc) {
            const float cr = c_cref[cc], gt = c_gtot[cc];
            const int q = cc - 4 * w;
            mp0 = (q == 0) ? m_prev : mp0; mp1 = (q == 1) ? m_prev : mp1; mp2 = (q == 2) ? m_prev : mp2; mp3 = (q == 3) ? m_prev : mp3;
            m_prev = gt + fmaxf(m_prev, cr);
        }
        const float mp[4] = {mp0, mp1, mp2, mp3};
#pragma unroll
        for (int q = 0; q < 4; ++q) {
            const int cc = 4 * w + q, j = cc * 64 + lane;
            const float bb = s_emt[j], x = s_u[j], pm = s_rt[j], cr = c_cref[cc];
            const float mx = fmaxf(mp[q], pm);
            s_isc[j] = expf(mp[q] - mx); s_rt[j] = expf(cr - mx); s_u[j] = expf(x - cr); s_emt[j] = expf(-(bb + mx));
            if (lane == 0) { const float M = fmaxf(mp[q], cr); c_decay[cc] = expf(mp[q] - M); c_f[cc] = expf(cr - M); }
        }
    }
    __syncthreads();
#define ML_STAGE(ccn) do { const float us = s_u[(ccn) * 64 + srow]; \
        _Pragma("unroll") for (int i = 0; i < 2; ++i) { \
            *(LAS v4u*)(L + ML_Q + srow * ML_STR + spart * 32 + 16 * i) = rq[i]; *(LAS v4u*)(L + ML_V + srow * ML_STR + spart * 32 + 16 * i) = rv[i]; \
            v4u o; _Pragma("unroll") for (int j = 0; j < 4; ++j) o[j] = cvtpk2(__uint_as_float(rk[i][j] << 16) * us, __uint_as_float(rk[i][j] & 0xffff0000u) * us); \
            *(LAS v4u*)(L + ML_K + srow * ML_STR + spart * 32 + 16 * i) = o; } } while (0)
    ML_STAGE(0);
    { const int j = 64 + srow, pos = dir ? (SEQ - 1 - j) : j; const size_t ro = (size_t)(b * SEQ + pos) * DML + hoff;
      rq[0] = *(const v4u*)(qm + ro); rq[1] = *(const v4u*)(qm + ro + 8); rk[0] = *(const v4u*)(km + ro); rk[1] = *(const v4u*)(km + ro + 8); rv[0] = *(const v4u*)(vm + ro); rv[1] = *(const v4u*)(vm + ro + 8); }
    __syncthreads();
    for (int cc = 0; cc < SEQ / 64; ++cc) {
        asm volatile("" : "+v"(lane), "+v"(c16), "+v"(g), "+v"(srow), "+v"(spart));
        const int p = cc & 1;
        const bool more = (cc + 1 < SEQ / 64);
        const float decay = c_decay[cc], ff = c_f[cc];
        f32x4 O[4];
#pragma unroll
        for (int ti = 0; ti < 4; ++ti) O[ti] = (f32x4){0.f, 0.f, 0.f, 0.f};
        if constexpr (!(MLV & 8)) {
            bf16x8 Cb[4];
#pragma unroll
            for (int ks = 0; ks < 4; ++ks) { v4u t; t.x = cvtpk2(Cacc[2 * ks][0], Cacc[2 * ks][1]); t.y = cvtpk2(Cacc[2 * ks][2], Cacc[2 * ks][3]); t.z = cvtpk2(Cacc[2 * ks + 1][0], Cacc[2 * ks + 1][1]); t.w = cvtpk2(Cacc[2 * ks + 1][2], Cacc[2 * ks + 1][3]); Cb[ks] = __builtin_bit_cast(bf16x8, t); }
            f32x4 IV[4];
#pragma unroll
            for (int kh2 = 0; kh2 < 2; ++kh2) {
                bf16x8 QA[4][2];
#pragma unroll
                for (int ti = 0; ti < 4; ++ti)
#pragma unroll
                    for (int k2 = 0; k2 < 2; ++k2) QA[ti][k2] = *(const LAS bf16x8*)(L + ML_Q + (16 * ti + c16) * ML_STR + (32 * (2 * kh2 + k2) + 8 * g) * 2);
                __builtin_amdgcn_sched_barrier(0);
#pragma unroll
                for (int k2 = 0; k2 < 2; ++k2)
#pragma unroll
                    for (int ti = 0; ti < 4; ++ti) O[ti] = __builtin_amdgcn_mfma_f32_16x16x32_bf16(QA[ti][k2], Cb[2 * kh2 + k2], O[ti], 0, 0, 0);
                __builtin_amdgcn_sched_barrier(0);
            }
#pragma unroll
            for (int ti = 0; ti < 4; ++ti) IV[ti] = *(const LAS f32x4*)(s_isc + cc * 64 + 16 * ti + 4 * g);
#pragma unroll
            for (int ti = 0; ti < 4; ++ti) O[ti] = O[ti] * IV[ti];
            __builtin_amdgcn_sched_barrier(0);
        }
        if constexpr (!(MLV & 2)) {
            const int ti = w >> 1, t = 16 * ti + c16; const float rtv = s_rt[cc * 64 + t];
            const int si0 = 2 * (w & 1);
            bf16x8 KA[2][4], QB[4];
#pragma unroll
            for (int ks = 0; ks < 4; ++ks) { QB[ks] = *(const LAS bf16x8*)(L + ML_Q + (16 * ti + c16) * ML_STR + (32 * ks + 8 * g) * 2);
#pragma unroll
                for (int sj = 0; sj < 2; ++sj) KA[sj][ks] = *(const LAS bf16x8*)(L + ML_K + (16 * (si0 + sj) + c16) * ML_STR + (32 * ks + 8 * g) * 2); }
            __builtin_amdgcn_sched_barrier(0);
            f32x4 Dt[2] = {{0.f, 0.f, 0.f, 0.f}, {0.f, 0.f, 0.f, 0.f}};
#pragma unroll
            for (int ks = 0; ks < 4; ++ks)
#pragma unroll
                for (int sj = 0; sj < 2; ++sj) Dt[sj] = __builtin_amdgcn_mfma_f32_16x16x32_bf16(KA[sj][ks], QB[ks], Dt[sj], 0, 0, 0);
#pragma unroll
            for (int sj = 0; sj < 2; ++sj) {
                const int si = si0 + sj;
                f32x4 D = Dt[sj]; float ps = 0.f;
#pragma unroll
                for (int r = 0; r < 4; ++r) { const int sx = 16 * si + 4 * g + r; const float v = (si <= ti && sx <= t) ? D[r] : 0.f; D[r] = v; ps += v; }
                *(LAS unsigned long long*)(L + ML_W + t * ML_WSTR + (16 * si + 4 * g) * 2) = (unsigned long long)cvtpk2(D[0] * rtv, D[1] * rtv) | ((unsigned long long)cvtpk2(D[2] * rtv, D[3] * rtv) << 32);
                ps += __shfl_xor(ps, 16); ps += __shfl_xor(ps, 32);
                if (g == 0) Psum[t * 4 + si] = ps;
            }
            __builtin_amdgcn_sched_barrier(0);
        }
        {
            const LAS unsigned char* qp = L + ML_Q + srow * ML_STR + spart * 32;
            const v4u q0 = *(const LAS v4u*)qp, q1 = *(const LAS v4u*)(qp + 16);
            const LAS f32x4* np = (const LAS f32x4*)(nbuf + p * 128 + 16 * spart);
            const f32x4 n0 = np[0], n1 = np[1], n2 = np[2], n3 = np[3];
            float d = 0.f;
            d += __uint_as_float(q0[0] << 16) * n0[0] + __uint_as_float(q0[0] & 0xffff0000u) * n0[1] + __uint_as_float(q0[1] << 16) * n0[2] + __uint_as_float(q0[1] & 0xffff0000u) * n0[3];
            d += __uint_as_float(q0[2] << 16) * n1[0] + __uint_as_float(q0[2] & 0xffff0000u) * n1[1] + __uint_as_float(q0[3] << 16) * n1[2] + __uint_as_float(q0[3] & 0xffff0000u) * n1[3];
            d += __uint_as_float(q1[0] << 16) * n2[0] + __uint_as_float(q1[0] & 0xffff0000u) * n2[1] + __uint_as_float(q1[1] << 16) * n2[2] + __uint_as_float(q1[1] & 0xffff0000u) * n2[3];
            d += __uint_as_float(q1[2] << 16) * n3[0] + __uint_as_float(q1[2] & 0xffff0000u) * n3[1] + __uint_as_float(q1[3] << 16) * n3[2] + __uint_as_float(q1[3] & 0xffff0000u) * n3[3];
            d += __shfl_xor(d, 1); d += __shfl_xor(d, 2); d += __shfl_xor(d, 4);
            if (spart == 0) qn[srow] = d;
        }
        bf16x8 Vf[2];
        {
            const int q4 = c16 >> 2, p4 = c16 & 3;
#pragma unroll
            for (int ks = 0; ks < 2; ++ks) {
                LAS unsigned char* vp = L + ML_V + (32 * ks + 4 * g + q4) * ML_STR + (16 * w + 4 * p4) * 2;
                Vf[ks] = cat8(trr(vp), trr(vp + 16 * ML_STR));
            }
            f32x4 dn = {0.f, 0.f, 0.f, 0.f};
            { unsigned one2 = 0x3F803F80u; asm volatile("" : "+v"(one2)); const bf16x8 ones = __builtin_bit_cast(bf16x8, (v4u){one2, one2, one2, one2});
              LAS unsigned char* kw = L + ML_K + (4 * g + q4) * ML_STR + (32 * (w >> 1) + 8 * p4 + 4 * (w & 1)) * 2;
              const bf16x8 A0 = cat8(trr(kw), trr(kw + 16 * ML_STR)), A1 = cat8(trr(kw + 32 * ML_STR), trr(kw + 48 * ML_STR));
              dn = __builtin_amdgcn_mfma_f32_16x16x32_bf16(A0, ones, dn, 0, 0, 0); dn = __builtin_amdgcn_mfma_f32_16x16x32_bf16(A1, ones, dn, 0, 0, 0); }
            if constexpr (!(MLV & 4))
#pragma unroll
            for (int th = 0; th < 4; ++th) {
                bf16x8 KT[2][2];
#pragma unroll
                for (int t2 = 0; t2 < 2; ++t2)
#pragma unroll
                    for (int ks = 0; ks < 2; ++ks) { const int te = 2 * th + t2; LAS unsigned char* kp = L + ML_K + (32 * ks + 4 * g + q4) * ML_STR + (32 * (te >> 1) + 8 * p4 + 4 * (te & 1)) * 2; KT[t2][ks] = cat8(trr(kp), trr(kp + 16 * ML_STR)); }
                __builtin_amdgcn_sched_barrier(0);
                f32x4 dC[2];
#pragma unroll
                for (int t2 = 0; t2 < 2; ++t2) dC[t2] = __builtin_amdgcn_mfma_f32_16x16x32_bf16(KT[t2][0], Vf[0], (f32x4){0.f, 0.f, 0.f, 0.f}, 0, 0, 0);
#pragma unroll
                for (int t2 = 0; t2 < 2; ++t2) dC[t2] = __builtin_amdgcn_mfma_f32_16x16x32_bf16(KT[t2][1], Vf[1], dC[t2], 0, 0, 0);
#pragma unroll
                for (int t2 = 0; t2 < 2; ++t2) Cacc[2 * th + t2] = Cacc[2 * th + t2] * decay + dC[t2] * ff;
            }
            __builtin_amdgcn_sched_barrier(0);
            if (c16 == 0) { const int ne = 32 * (w >> 1) + 8 * g + 4 * (w & 1); const f32x4 nold = *(const LAS f32x4*)(nbuf + p * 128 + ne); *(LAS f32x4*)(nbuf + (p ^ 1) * 128 + ne) = nold * decay + dn * ff; }
        }
        __syncthreads();
        {
            bf16x8 WA[4][2];
#pragma unroll
            for (int ti = 0; ti < 4; ++ti)
#pragma unroll
                for (int ks = 0; ks < 2; ++ks) if (ks <= (ti >> 1)) { const LAS unsigned char* wp = L + ML_W + (16 * ti + c16) * ML_WSTR + (32 * ks + 4 * g) * 2; WA[ti][ks] = cat8(*(const LAS s16x4*)wp, *(const LAS s16x4*)(wp + 32)); }
            __builtin_amdgcn_sched_barrier(0);
#pragma unroll
            for (int ks = 0; ks < 2; ++ks)
#pragma unroll
                for (int ti = 0; ti < 4; ++ti) if (ks <= (ti >> 1)) O[ti] = __builtin_amdgcn_mfma_f32_16x16x32_bf16(WA[ti][ks], Vf[ks], O[ti], 0, 0, 0);
        }
        {
            const f32x4 pv = *(const LAS f32x4*)(Psum + 4 * lane);
            const float den = s_rt[cc * 64 + lane] * ((pv[0] + pv[1]) + (pv[2] + pv[3])) + s_isc[cc * 64 + lane] * qn[lane];
            scr[lane] = 1.f / fmaxf(fabsf(den), s_emt[cc * 64 + lane]);
#pragma unroll
            for (int ti = 0; ti < 4; ++ti) {
                const f32x4 rd = *(const LAS f32x4*)(scr + 16 * ti + 4 * g);
#pragma unroll
                for (int r = 0; r < 4; ++r) { const int j = cc * 64 + 16 * ti + 4 * g + r, pos = dir ? (SEQ - 1 - j) : j;
                    if constexpr (MLV & 1) { asm volatile("" :: "v"(O[ti][r] * rd[r])); } else hout[(size_t)(b * SEQ + pos) * DML + h * MDH + 16 * w + c16] = (bf16)f2bf(O[ti][r] * rd[r]); }
            }
        }
        if (more) { ML_STAGE(cc + 1); }
        if (cc + 2 < SEQ / 64) { const int j = (cc + 2) * 64 + srow, pos = dir ? (SEQ - 1 - j) : j; const size_t ro = (size_t)(b * SEQ + pos) * DML + hoff;
            rq[0] = *(const v4u*)(qm + ro); rq[1] = *(const v4u*)(qm + ro + 8); rk[0] = *(const v4u*)(km + ro); rk[1] = *(const v4u*)(km + ro + 8); rv[0] = *(const v4u*)(vm + ro); rv[1] = *(const v4u*)(vm + ro + 8); }
        __syncthreads();
    }
#undef ML_STAGE
#undef hoff
}
__device__ __forceinline__ void p3_mlstm(const Args& a, Frame& F) {
    bool any = false;
    for (int item = F.bx; item < NB * MH * 2; item += F.G) { mlstm_item<0>(a, F, item); any = true;
        __syncthreads();
        if (F.tid == 0) __hip_atomic_fetch_add((gu32*)(a.ws + WS_CTL) + CW_MDONE, 1u, RLX_AGENT); }
    if (any && F.G == 256) cvt_run(a, F, CW_MDONE, (unsigned)(NB * MH * 2), CW_ADONE, (unsigned)NATT);
    __syncthreads();
}
typedef float f32x16 __attribute__((ext_vector_type(16)));
__device__ __forceinline__ unsigned cvtpk(float lo, float hi) { unsigned r; asm volatile("v_cvt_pk_bf16_f32 %0, %1, %2" : "=v"(r) : "v"(lo), "v"(hi)); return r; }
#ifndef ATT_VAR
#define ATT_VAR 0
#endif
template <int VAR>
__device__ __forceinline__ void attn_task(const bf16* __restrict__ Qa, const bf16* __restrict__ Ka, const bf16* __restrict__ Va, bf16* __restrict__ opart, float* __restrict__ ostat,
                                          int task, LAS unsigned char* vl  , int lane) {
    const int bh = task / 192, rem = task % 192, br = rem >> 6, tt = rem & 63;
    const int dsh = 2 * br, dil = 1 << dsh;
    const int Lb = 64 >> dsh;
    const int r = tt / Lb, gq = tt % Lb;
    const int r32 = lane & 31, h = lane >> 5;
    const size_t base = (size_t)bh * SEQ * ADH;
    const int qtok = r + dil * (32 * gq + r32);
    bf16x8 qf[4];
#pragma unroll
    for (int sx = 0; sx < 4; ++sx) qf[sx] = *(const bf16x8*)(Qa + base + (size_t)qtok * ADH + 16 * sx + 8 * h);
    f32x16 sacc[5]; v4u vreg[5][4]; bool valid[5];
#pragma unroll
    for (int kb = 0; kb < 5; ++kb) {
        const int jb = gq - 2 + kb; valid[kb] = (jb >= 0 && jb < Lb);
#pragma unroll
        for (int i = 0; i < 16; ++i) sacc[kb][i] = 0.f;
        if (valid[kb]) {
            const int ktok = r + dil * (32 * jb + r32);
            bf16x8 kf[4];
#pragma unroll
            for (int sx = 0; sx < 4; ++sx) kf[sx] = *(const bf16x8*)(Ka + base + (size_t)ktok * ADH + 16 * sx + 8 * h);
#pragma unroll
            for (int i = 0; i < 4; ++i) { const int vtok = r + dil * (32 * jb + 8 * i + (lane >> 3)); if constexpr (!(VAR & 1)) vreg[kb][i] = *(const v4u*)(Va + base + (size_t)vtok * ADH + 8 * (lane & 7)); else vreg[kb][i] = (v4u){0u, 0u, 0u, 0u}; }
#pragma unroll
            for (int sx = 0; sx < 4; ++sx) sacc[kb] = __builtin_amdgcn_mfma_f32_32x32x16_bf16(kf[sx], qf[sx], sacc[kb], 0, 0, 0);
        }
    }
    float m = -INFINITY;
#pragma unroll
    for (int kb = 0; kb < 5; ++kb) if (valid[kb]) {
#pragma unroll
        for (int rg = 0; rg < 16; ++rg) {
            const int kk = (rg & 3) + 8 * (rg >> 2) + 4 * h;
            float sv = sacc[kb][rg];
            if (kb == 0) sv = (kk >= r32) ? sv : -INFINITY;
            if (kb == 4) sv = (kk <= r32) ? sv : -INFINITY;
            sacc[kb][rg] = sv; m = fmaxf(m, sv);
        }
    }
    m = fmaxf(m, __shfl_xor(m, 32));
    float l = 0.f; const float mb = m * 1.4426950408889634f;
    bf16x8 pf[5][2];
#pragma unroll
    for (int kb = 0; kb < 5; ++kb) if (valid[kb]) {
        float p[16];
#pragma unroll
        for (int rg = 0; rg < 16; ++rg) { if constexpr (VAR & 2) p[rg] = sacc[kb][rg] * 1.4426950408889634f - mb; else p[rg] = __builtin_amdgcn_exp2f(sacc[kb][rg] * 1.4426950408889634f - mb); l += p[rg]; }
#pragma unroll
        for (int sp = 0; sp < 2; ++sp) { v4u w; w.x = cvtpk(p[8 * sp], p[8 * sp + 1]); w.y = cvtpk(p[8 * sp + 2], p[8 * sp + 3]); w.z = cvtpk(p[8 * sp + 4], p[8 * sp + 5]); w.w = cvtpk(p[8 * sp + 6], p[8 * sp + 7]); pf[kb][sp] = __builtin_bit_cast(bf16x8, w); }
    }
    l += __shfl_xor(l, 32);
    f32x16 o0, o1;
#pragma unroll
    for (int i = 0; i < 16; ++i) { o0[i] = 0.f; o1[i] = 0.f; }
    const int row0 = lane >> 3, ch16 = lane & 7;
    const int woff = row0 * 128 + (((ch16 >> 1) ^ (((row0 >> 1) & 1) << 1)) * 32) + (ch16 & 1) * 16;
    const int q4 = (lane & 15) >> 2, sw = (q4 >> 1) & 1, dhalf = (lane >> 4) & 1;
    const int rb = (4 * h + q4) * 128 + dhalf * 32 + (lane & 3) * 8;
    const int rb0 = rb + (sw ? 64 : 0), rb1 = rb + (sw ? 0 : 64);
#pragma unroll
    for (int kb = 0; kb < 5; ++kb) if (valid[kb] && !(VAR & 1)) {
#pragma unroll
        for (int i = 0; i < 4; ++i) *(LAS v4u*)(vl + woff + 1024 * i) = vreg[kb][i];
#pragma unroll
        for (int sp = 0; sp < 2; ++sp) {
            const s16x4 a00 = __builtin_bit_cast(s16x4, __builtin_amdgcn_ds_read_tr16_b64_v4i16((LAS v4i16_t*)(vl + rb0 + (16 * sp) * 128)));
            const s16x4 a01 = __builtin_bit_cast(s16x4, __builtin_amdgcn_ds_read_tr16_b64_v4i16((LAS v4i16_t*)(vl + rb0 + (16 * sp + 8) * 128)));
            const s16x4 a10 = __builtin_bit_cast(s16x4, __builtin_amdgcn_ds_read_tr16_b64_v4i16((LAS v4i16_t*)(vl + rb1 + (16 * sp) * 128)));
            const s16x4 a11 = __builtin_bit_cast(s16x4, __builtin_amdgcn_ds_read_tr16_b64_v4i16((LAS v4i16_t*)(vl + rb1 + (16 * sp + 8) * 128)));
            const bf16x8 A0 = {a00[0], a00[1], a00[2], a00[3], a01[0], a01[1], a01[2], a01[3]};
            const bf16x8 A1 = {a10[0], a10[1], a10[2], a10[3], a11[0], a11[1], a11[2], a11[3]};
            o0 = __builtin_amdgcn_mfma_f32_32x32x16_bf16(A0, pf[kb][sp], o0, 0, 0, 0);
            o1 = __builtin_amdgcn_mfma_f32_32x32x16_bf16(A1, pf[kb][sp], o1, 0, 0, 0);
        }
        asm volatile("s_waitcnt lgkmcnt(0)" ::: "memory");
    }
    if constexpr (VAR & 1) { asm volatile("" :: "v"(pf[0][0]), "v"(pf[1][1]), "v"(pf[2][0]), "v"(pf[3][1]), "v"(pf[4][0])); }
    if constexpr (VAR & 4) { asm volatile("" :: "v"(o0), "v"(o1), "v"(l), "v"(m)); return; }
    const float inv = 1.f / l;
    const int b = bh / AH, hh = bh % AH;
    const size_t tok = (size_t)b * SEQ + qtok;
    {
        LAS unsigned char* ol = vl + r32 * 144 + 8 * h;
#pragma unroll
        for (int g4 = 0; g4 < 4; ++g4) {
            *(LAS unsigned long long*)(ol + 16 * g4) = (unsigned long long)cvtpk(o0[4 * g4] * inv, o0[4 * g4 + 1] * inv) | ((unsigned long long)cvtpk(o0[4 * g4 + 2] * inv, o0[4 * g4 + 3] * inv) << 32);
            *(LAS unsigned long long*)(ol + 64 + 16 * g4) = (unsigned long long)cvtpk(o1[4 * g4] * inv, o1[4 * g4 + 1] * inv) | ((unsigned long long)cvtpk(o1[4 * g4 + 2] * inv, o1[4 * g4 + 3] * inv) << 32);
        }
        const int qrow = lane >> 1, half = lane & 1;
        const int qtok2 = r + dil * (32 * gq + qrow);
        bf16* op = opart + ((size_t)br * NT + (size_t)b * SEQ + qtok2) * DAT + hh * ADH + 32 * half;
#pragma unroll
        for (int i = 0; i < 4; ++i) *(v4u*)(op + 8 * i) = *(const LAS v4u*)(vl + qrow * 144 + 64 * half + 16 * i);
        asm volatile("s_waitcnt lgkmcnt(0)" ::: "memory");
    }
    if (h == 0) { float* st = ostat + (((size_t)br * NT + tok) * AH + hh) * 2; st[0] = m; st[1] = l; }
}
constexpr int AT_K = 0, AT_V = 49152, AT_O = 98304, AT_OSZ = 4608;
static_assert(AT_O + 8 * AT_OSZ <= RING_BYTES, "attention LDS map");
struct AtGeo { int bh, br, dsh, Lb, jbs, nblk, resb, gq0, jsh, jmk; };
__device__ __forceinline__ AtGeo at_geo(int it) {
    AtGeo g; g.bh = it / 24; const int rem = it % 24; g.br = rem >> 3; const int sub = rem & 7; g.dsh = 2 * g.br; g.Lb = 64 >> g.dsh;
    g.gq0 = (g.br == 0) ? 8 * sub : (g.br == 1 ? 8 * (sub & 1) : 0);
    g.resb = (g.br == 0) ? 0 : (g.br == 1 ? (sub >> 1) : 2 * sub);
    g.jsh = (g.br == 2) ? 2 : 4; g.jmk = (g.br == 2) ? 3 : 15;
    const int lo = g.gq0 - 2 < 0 ? 0 : g.gq0 - 2, hi = g.gq0 + 10 > g.Lb ? g.Lb : g.gq0 + 10;
    g.jbs = (g.br == 2) ? 0 : lo; g.nblk = (g.br == 2) ? 8 : hi - lo;
    return g;
}
__device__ __forceinline__ void at_load_q(const AtGeo& g, const bf16* __restrict__ Qa, int w, int lane, bf16x8 (&qf)[4]) {
    const int r32 = lane & 31, h = lane >> 5;
    const int qtok = g.resb + (w >> g.jsh) + ((32 * (g.gq0 + (w & g.jmk)) + r32) << g.dsh);
    const bf16* qp = Qa + (size_t)g.bh * SEQ * ADH + (size_t)qtok * ADH + 8 * h;
#pragma unroll
    for (int sx = 0; sx < 4; ++sx) qf[sx] = *(const bf16x8*)(qp + 16 * sx);
}
__device__ __forceinline__ void at_load_kv(const AtGeo& g, const bf16* __restrict__ Ka, const bf16* __restrict__ Va, int tid, v4u (&kr)[6], v4u (&vr)[6]) {
    const size_t base = (size_t)g.bh * SEQ * ADH;
    const int rrow = tid >> 3, ch = tid & 7, last = 32 * g.nblk - 1;
#pragma unroll
    for (int i = 0; i < 6; ++i) { int row = rrow + 64 * i; row = row > last ? last : row;
        const int sl = row >> 5;
        const int tok = g.resb + (sl >> g.jsh) + ((32 * (g.jbs + (sl & g.jmk)) + (row & 31)) << g.dsh);
        const size_t off = base + (size_t)tok * ADH + 8 * ch; kr[i] = *(const v4u*)(Ka + off); vr[i] = *(const v4u*)(Va + off); }
}
__device__ __forceinline__ void at_stage(LAS unsigned char* L, int tid, const v4u (&kr)[6], const v4u (&vr)[6]) {
    const int rrow = tid >> 3, ch = tid & 7, r32 = rrow & 31;
    LAS unsigned char* kp = L + AT_K + rrow * 128 + ((ch ^ ((rrow >> 1) & 7)) << 4);
    LAS unsigned char* vp = L + AT_V + (rrow >> 5) * 4096 + r32 * 128 + (((ch >> 1) ^ (((r32 >> 1) & 1) << 1)) * 32) + (ch & 1) * 16;
#pragma unroll
    for (int i = 0; i < 6; ++i) { *(LAS v4u*)(kp + 8192 * i) = kr[i]; *(LAS v4u*)(vp + 8192 * i) = vr[i]; }
}
__device__ __forceinline__ void at_compute(const AtGeo& g, const AtGeo& gn, const bf16* __restrict__ Qa, LAS unsigned char* L, bf16x8 (&qf)[4], bf16* __restrict__ opart, float* __restrict__ ostat, int w, int lane) {
    const int r32 = lane & 31, h = lane >> 5;
    const int res = g.resb + (w >> g.jsh), gq = g.gq0 + (w & g.jmk);
    f32x16 sacc[5]; bool valid[5]; int slot[5];
#pragma unroll
    for (int kb = 0; kb < 5; ++kb) {
        const int jb = gq - 2 + kb; valid[kb] = (jb >= 0 && jb < g.Lb);
        const int jbc = jb < 0 ? 0 : (jb >= g.Lb ? g.Lb - 1 : jb);
        slot[kb] = ((w >> g.jsh) << 2) + jbc - g.jbs;
#pragma unroll
        for (int i = 0; i < 16; ++i) sacc[kb][i] = 0.f;
        const LAS unsigned char* kp = L + AT_K + slot[kb] * 4096 + r32 * 128;
#pragma unroll
        for (int sx = 0; sx < 4; ++sx) { const bf16x8 kf = *(const LAS bf16x8*)(kp + (((2 * sx + h) ^ ((r32 >> 1) & 7)) << 4)); sacc[kb] = __builtin_amdgcn_mfma_f32_32x32x16_bf16(kf, qf[sx], sacc[kb], 0, 0, 0); }
    }
    __builtin_amdgcn_sched_barrier(0);
    at_load_q(gn, Qa, w, lane, qf);
    __builtin_amdgcn_sched_barrier(0);
    float m = -INFINITY;
#pragma unroll
    for (int kb = 0; kb < 5; ++kb) {
#pragma unroll
        for (int rg = 0; rg < 16; ++rg) {
            const int kk = (rg & 3) + 8 * (rg >> 2) + 4 * h;
            float sv = valid[kb] ? sacc[kb][rg] : -INFINITY;
            if (kb == 0) sv = (kk >= r32) ? sv : -INFINITY;
            if (kb == 4) sv = (kk <= r32) ? sv : -INFINITY;
            sacc[kb][rg] = sv; m = fmaxf(m, sv);
        }
    }
    m = fmaxf(m, __shfl_xor(m, 32));
    float l = 0.f; const float mb = m * 1.4426950408889634f;
    bf16x8 pf[5][2];
#pragma unroll
    for (int kb = 0; kb < 5; ++kb) {
        float p[16];
#pragma unroll
        for (int rg = 0; rg < 16; ++rg) { p[rg] = __builtin_amdgcn_exp2f(sacc[kb][rg] * 1.4426950408889634f - mb); l += p[rg]; }
#pragma unroll
        for (int sp = 0; sp < 2; ++sp) { v4u wv; wv.x = cvtpk(p[8 * sp], p[8 * sp + 1]); wv.y = cvtpk(p[8 * sp + 2], p[8 * sp + 3]); wv.z = cvtpk(p[8 * sp + 4], p[8 * sp + 5]); wv.w = cvtpk(p[8 * sp + 6], p[8 * sp + 7]); pf[kb][sp] = __builtin_bit_cast(bf16x8, wv); }
    }
    l += __shfl_xor(l, 32);
    f32x16 o0, o1;
#pragma unroll
    for (int i = 0; i < 16; ++i) { o0[i] = 0.f; o1[i] = 0.f; }
    int lane2 = lane; asm volatile("" : "+v"(lane2));
    const int q4 = (lane2 & 15) >> 2, sw = (q4 >> 1) & 1, dhalf = (lane2 >> 4) & 1;
    const int rb = (4 * (lane2 >> 5) + q4) * 128 + dhalf * 32 + (lane2 & 3) * 8;
    const int rb0 = rb + (sw ? 64 : 0), rb1 = rb + (sw ? 0 : 64);
#pragma unroll
    for (int kb = 0; kb < 5; ++kb) {
        LAS unsigned char* vb = L + AT_V + slot[kb] * 4096;
#pragma unroll
        for (int sp = 0; sp < 2; ++sp) {
            const s16x4 a00 = __builtin_bit_cast(s16x4, __builtin_amdgcn_ds_read_tr16_b64_v4i16((LAS v4i16_t*)(vb + rb0 + (16 * sp) * 128)));
            const s16x4 a01 = __builtin_bit_cast(s16x4, __builtin_amdgcn_ds_read_tr16_b64_v4i16((LAS v4i16_t*)(vb + rb0 + (16 * sp + 8) * 128)));
            const s16x4 a10 = __builtin_bit_cast(s16x4, __builtin_amdgcn_ds_read_tr16_b64_v4i16((LAS v4i16_t*)(vb + rb1 + (16 * sp) * 128)));
            const s16x4 a11 = __builtin_bit_cast(s16x4, __builtin_amdgcn_ds_read_tr16_b64_v4i16((LAS v4i16_t*)(vb + rb1 + (16 * sp + 8) * 128)));
            const bf16x8 A0 = {a00[0], a00[1], a00[2], a00[3], a01[0], a01[1], a01[2], a01[3]};
            const bf16x8 A1 = {a10[0], a10[1], a10[2], a10[3], a11[0], a11[1], a11[2], a11[3]};
            o0 = __builtin_amdgcn_mfma_f32_32x32x16_bf16(A0, pf[kb][sp], o0, 0, 0, 0);
            o1 = __builtin_amdgcn_mfma_f32_32x32x16_bf16(A1, pf[kb][sp], o1, 0, 0, 0);
        }
    }
    const float inv = 1.f / l;
    const int b = g.bh / AH, hh = g.bh % AH;
    LAS unsigned char* vl = L + AT_O + w * AT_OSZ;
    {
        LAS unsigned char* ol = vl + r32 * 144 + 8 * h;
#pragma unroll
        for (int g4 = 0; g4 < 4; ++g4) {
            *(LAS unsigned long long*)(ol + 16 * g4) = (unsigned long long)cvtpk(o0[4 * g4] * inv, o0[4 * g4 + 1] * inv) | ((unsigned long long)cvtpk(o0[4 * g4 + 2] * inv, o0[4 * g4 + 3] * inv) << 32);
            *(LAS unsigned long long*)(ol + 64 + 16 * g4) = (unsigned long long)cvtpk(o1[4 * g4] * inv, o1[4 * g4 + 1] * inv) | ((unsigned long long)cvtpk(o1[4 * g4 + 2] * inv, o1[4 * g4 + 3] * inv) << 32);
        }
        const int qrow = lane >> 1, half = lane & 1;
        const int qtok2 = res + ((32 * gq + qrow) << g.dsh);
        bf16* op = opart + ((size_t)g.br * NT + (size_t)b * SEQ + qtok2) * DAT + hh * ADH + 32 * half;
#pragma unroll
        for (int i = 0; i < 4; ++i) *(v4u*)(op + 8 * i) = *(const LAS v4u*)(vl + qrow * 144 + 64 * half + 16 * i);
    }
    if (h == 0) { const size_t tok = (size_t)b * SEQ + res + ((32 * gq + r32) << g.dsh); float* st = ostat + (((size_t)g.br * NT + tok) * AH + hh) * 2; st[0] = m; st[1] = l; }
}
__device__ __forceinline__ void p3_attn_coop(const Args& a, Frame& F, int abx, int aG) {
    const bf16* qr = (const bf16*)(a.ws + WS_QR); const bf16* kr = (const bf16*)(a.ws + WS_KR); const bf16* vr = (const bf16*)(a.ws + WS_VR);
    bf16* opart = (bf16*)(a.ws + WS_OPART); float* ostat = (float*)(a.ws + WS_OSTAT);
    LAS unsigned char* L = F.lds + RING_OFF;
    constexpr int NITEM = NB * AH * 24;
    v4u kreg[6], vreg[6]; bf16x8 qf[4];
    int it = abx;
    if (it >= NITEM) return;
    AtGeo g = at_geo(it);
    at_load_q(g, qr, F.wave, F.lane, qf);
    at_load_kv(g, kr, vr, F.tid, kreg, vreg);
    __syncthreads();
    for (;;) {
        int tid = F.tid; asm volatile("" : "+v"(tid));
        at_stage(L, tid, kreg, vreg);
        __syncthreads();
        const int itn = it + aG; const bool more = itn < NITEM;
        const AtGeo gn = at_geo(more ? itn : it);
        at_load_kv(gn, kr, vr, tid, kreg, vreg);
        __builtin_amdgcn_sched_barrier(0);
        at_compute(g, gn, qr, L, qf, opart, ostat, F.wave, tid & 63);
        __syncthreads();
        if (!more) break;
        it = itn; g = gn;
    }
}
template <int VAR>
__device__ __forceinline__ void p3_attn_var(const Args& a, Frame& F) {
    const bf16* qr = (const bf16*)(a.ws + WS_QR); const bf16* kr = (const bf16*)(a.ws + WS_KR); const bf16* vr = (const bf16*)(a.ws + WS_VR);
    bf16* opart = (bf16*)(a.ws + WS_OPART); float* ostat = (float*)(a.ws + WS_OSTAT);
    LAS unsigned char* vl = F.lds + RING_OFF + F.wave * 8192;
    const int abx = (F.G == 256) ? F.bx - 64 : F.bx, aG = (F.G == 256) ? 192 : F.G;
    if (abx < 0) return;
    for (int task = abx * NWAVES + F.wave; task < NB * AH * 192; task += aG * NWAVES) attn_task<VAR>(qr, kr, vr, opart, ostat, task, vl, F.lane);
}
__device__ __forceinline__ void p3_attn(const Args& a, Frame& F) {
    const bf16* qr = (const bf16*)(a.ws + WS_QR); const bf16* kr = (const bf16*)(a.ws + WS_KR); const bf16* vr = (const bf16*)(a.ws + WS_VR);
    bf16* opart = (bf16*)(a.ws + WS_OPART); float* ostat = (float*)(a.ws + WS_OSTAT);
    LAS unsigned char* vl = F.lds + RING_OFF + F.wave * 8192;
    const int abx = (F.G == 256) ? F.bx - 64 : F.bx, aG = (F.G == 256) ? NATT : F.G;
    if (abx < 0) return;
    if (F.G == 256) { if (abx < NATT) { p3_attn_coop(a, F, abx, aG); __syncthreads(); if (F.tid == 0) __hip_atomic_fetch_add((gu32*)(a.ws + WS_CTL) + CW_ADONE, 1u, RLX_AGENT); } }
    else for (int task = abx * NWAVES + F.wave; task < NB * AH * 192; task += aG * NWAVES) attn_task<0>(qr, kr, vr, opart, ostat, task, vl, F.lane);
    if (F.G == 256) cvt_run(a, F, CW_MDONE, (unsigned)(NB * MH * 2), CW_ADONE, (unsigned)NATT);
}
struct MixIn { v4u fp, bp; v4u xcp, zp, op[3]; float mm[3], ll[3]; };
__device__ __forceinline__ MixIn mix_load(const bf16* hfb, const bf16* xc, const bf16* proj, const bf16* opart, const float* ostat, int t, int c0, int hh) {
    MixIn r;
    r.fp = *(const v4u*)(hfb + (size_t)t * DML + c0); r.bp = *(const v4u*)(hfb + ((size_t)NT + t) * DML + c0);
    r.xcp = *(const v4u*)(xc + (size_t)t * DML + c0); r.zp = *(const v4u*)(proj + (size_t)t * DPROJ + 512 + c0);
#pragma unroll
    for (int br = 0; br < 3; ++br) { r.op[br] = *(const v4u*)(opart + ((size_t)br * NT + t) * DAT + c0); const float* st = ostat + (((size_t)br * NT + t) * AH + hh) * 2; r.mm[br] = st[0]; r.ll[br] = st[1]; }
    return r;
}
__device__ __forceinline__ void p4_mix(const Args& a, Frame& F) {
    const bf16* hfb = (const bf16*)(a.ws + WS_HFB); const bf16* xc = (const bf16*)(a.ws + WS_XC); const bf16* proj = (const bf16*)(a.ws + WS_PROJ);
    const bf16* opart = (const bf16*)(a.ws + WS_OPART); const float* ostat = (const float*)(a.ws + WS_OSTAT);
    const float* mnorm_g = a.in[12]; const float* mskip = a.in[13]; const float* anorm_g = a.in[14];
    bf16* mixed = (bf16*)(a.ws + WS_XN);
    const int lane = F.lane, c0 = 8 * lane, hh = lane >> 3;
    float mg[8], sk[8], ag[8];
#pragma unroll
    for (int i = 0; i < 8; ++i) { mg[i] = mnorm_g[c0 + i]; sk[i] = mskip[c0 + i]; ag[i] = anorm_g[c0 + i]; }
    const int tstep = F.G * NWAVES;
    MixIn cur = mix_load(hfb, xc, proj, opart, ostat, F.bx * NWAVES + F.wave, c0, hh);
    for (int t = F.bx * NWAVES + F.wave; t < NT; t += tstep) {
        const MixIn in = cur;
        if (t + tstep < NT) cur = mix_load(hfb, xc, proj, opart, ostat, t + tstep, c0, hh);
        const v4u fp = in.fp, bp = in.bp; const v4u xcp = in.xcp, zp = in.zp;
        v4u op[3]; float mm[3], ll[3];
#pragma unroll
        for (int br = 0; br < 3; ++br) { op[br] = in.op[br]; mm[br] = in.mm[br]; ll[br] = in.ll[br]; }
        float hs[8];
#pragma unroll
        for (int i = 0; i < 4; ++i) { hs[2 * i] = bflo(fp[i]) + bflo(bp[i]); hs[2 * i + 1] = bfhi(fp[i]) + bfhi(bp[i]); }
        float ss = 0.f;
#pragma unroll
        for (int i = 0; i < 8; ++i) ss += hs[i] * hs[i];
        ss += __shfl_xor(ss, 1); ss += __shfl_xor(ss, 2); ss += __shfl_xor(ss, 4); ss += __shfl_xor(ss, 8);
        const float rn = rsqrtf(ss * (1.f / MDH) + EPS);
        float ym[8];
#pragma unroll
        for (int i = 0; i < 8; ++i) {
            const float xcv = (i & 1) ? bfhi(xcp[i >> 1]) : bflo(xcp[i >> 1]), z = (i & 1) ? bfhi(zp[i >> 1]) : bflo(zp[i >> 1]);
            ym[i] = (hs[i] * rn * mg[i] + sk[i] * xcv) * (z / (1.f + __expf(-z)));
        }
        *(v4u*)(mixed + (size_t)t * DMODEL + c0) = (v4u){pk2(ym[0], ym[1]), pk2(ym[2], ym[3]), pk2(ym[4], ym[5]), pk2(ym[6], ym[7])};
        const float M = fmaxf(mm[0], fmaxf(mm[1], mm[2]));
        const float w0 = __expf(mm[0] - M) * ll[0], w1 = __expf(mm[1] - M) * ll[1], w2 = __expf(mm[2] - M) * ll[2];
        const float rden = 1.f / (w0 + w1 + w2);
        float av[8]; float s2 = 0.f;
#pragma unroll
        for (int i = 0; i < 8; ++i) {
            const float o0 = (i & 1) ? bfhi(op[0][i >> 1]) : bflo(op[0][i >> 1]), o1 = (i & 1) ? bfhi(op[1][i >> 1]) : bflo(op[1][i >> 1]), o2 = (i & 1) ? bfhi(op[2][i >> 1]) : bflo(op[2][i >> 1]);
            av[i] = (w0 * o0 + w1 * o1 + w2 * o2) * rden; s2 += av[i] * av[i];
        }
        s2 = wave_sum(s2);
        const float ra = rsqrtf(s2 * (1.f / DAT) + EPS);
        *(v4u*)(mixed + (size_t)t * DMODEL + 512 + c0) = (v4u){pk2(av[0] * ra * ag[0], av[1] * ra * ag[1]), pk2(av[2] * ra * ag[2], av[3] * ra * ag[3]), pk2(av[4] * ra * ag[4], av[5] * ra * ag[5]), pk2(av[6] * ra * ag[6], av[7] * ra * ag[7])};
    }
}
constexpr int RT_STR = 1040;
constexpr int RT_W = 0, RT_G2 = 16 * RT_STR * 4, RT_P = RT_G2 + 4096, RT_SS = RT_P + 8 * 256 * 4;
static_assert(RT_SS + 8 * 16 * 4 <= RING_BYTES, "router LDS map");
__device__ __forceinline__ void p6_router(const Args& a, Frame& F) {
    const float* x0 = a.in[0]; const bf16* yo = (const bf16*)(a.ws + WS_YO); const float* g2 = a.in[16]; const float* wr = a.in[17];
    unsigned char* h2 = a.ws + WS_XN; float* aff = (float*)(a.ws + WS_AFF); int* slot = (int*)(a.ws + WS_SLOT);
    LAS unsigned char* L = F.lds + RING_OFF;
    LAS float* Wl = (LAS float*)(L + RT_W); LAS float* g2l = (LAS float*)(L + RT_G2); LAS float* Pb = (LAS float*)(L + RT_P); LAS float* SSb = (LAS float*)(L + RT_SS);
    int tid_ = F.tid; asm volatile("" : "+v"(tid_));
    const int tid = tid_, lane = F.lane, w = F.wave, c16 = lane & 15, g = lane >> 4;
    __syncthreads();
    { f32x4 wv8[8]; float gk8[8];
#pragma unroll
      for (int i = 0; i < 8; ++i) { const int idx = tid + NTHR * i; wv8[i] = ((const GAS f32x4*)wr)[idx]; gk8[i] = g2[idx >> 2]; }
#pragma unroll
      for (int i = 0; i < 8; ++i) { const int idx = tid + NTHR * i, k = idx >> 2, e0 = (idx & 3) * 4;
#pragma unroll
          for (int j = 0; j < 4; ++j) Wl[(e0 + j) * RT_STR + k] = wv8[i][j] * gk8[i]; }
      g2l[2 * tid] = g2[2 * tid]; g2l[2 * tid + 1] = g2[2 * tid + 1]; }
    __syncthreads();
    const int tl = w >> 1, kh = w & 1;
    for (int t64 = F.bx; t64 < NT / 64; t64 += F.G) {
        const int r0 = t64 * 64 + 16 * tl;
        const float* xp = x0 + (size_t)(r0 + c16) * DMODEL + 512 * kh + 4 * g;
        const bf16* yp = yo + (size_t)(r0 + c16) * DMODEL + 512 * kh + 4 * g;
        f32x4 xa[32];
#pragma unroll
        for (int sx = 0; sx < 32; ++sx) xa[sx] = *(const f32x4*)(xp + 16 * sx);
#pragma unroll
        for (int blk = 0; blk < 4; ++blk) {
            unsigned long long yv[8];
#pragma unroll
            for (int i = 0; i < 8; ++i) yv[i] = *(const unsigned long long*)(yp + 16 * (8 * blk + i));
#pragma unroll
            for (int i = 0; i < 8; ++i) { const unsigned lo = (unsigned)yv[i], hi = (unsigned)(yv[i] >> 32);
                xa[8 * blk + i] += (f32x4){__uint_as_float(lo << 16), __uint_as_float(lo & 0xffff0000u), __uint_as_float(hi << 16), __uint_as_float(hi & 0xffff0000u)}; }
            __builtin_amdgcn_sched_barrier(0);
        }
        float ss = 0.f; f32x4 D = {0.f, 0.f, 0.f, 0.f};
        const LAS float* wrow = Wl + c16 * RT_STR + 512 * kh + 4 * g;
#pragma unroll
        for (int sx = 0; sx < 32; ++sx) {
            const f32x4 wb = *(const LAS f32x4*)(wrow + 16 * sx);
#pragma unroll
            for (int i = 0; i < 4; ++i) { D = __builtin_amdgcn_mfma_f32_16x16x4f32(xa[sx][i], wb[i], D, 0, 0, 0); ss += xa[sx][i] * xa[sx][i]; }
        }
        ss += __shfl_xor(ss, 16); ss += __shfl_xor(ss, 32);
#pragma unroll
        for (int r = 0; r < 4; ++r) Pb[w * 256 + (4 * g + r) * 16 + c16] = D[r];
        if (g == 0) SSb[w * 16 + c16] = ss;
        __syncthreads();
        const int w0 = w & ~1;
        const float rt = rsqrtf((SSb[w0 * 16 + c16] + SSb[(w0 + 1) * 16 + c16]) * (1.f / DMODEL) + EPS);
        unsigned char* hp = h2 + (size_t)(r0 + c16) * DMODEL + 512 * kh + 4 * g;
#pragma unroll
        for (int sx = 0; sx < 32; ++sx) { const f32x4 g4 = *(const LAS f32x4*)(g2l + 512 * kh + 16 * sx + 4 * g); const f32x4 y = xa[sx] * g4 * rt;
            int w8 = 0; w8 = __builtin_amdgcn_cvt_pk_fp8_f32(y.x, y.y, w8, false); w8 = __builtin_amdgcn_cvt_pk_fp8_f32(y.z, y.w, w8, true);
            *(int*)(hp + 16 * sx) = w8; }
        if (kh == 0) {
#pragma unroll
            for (int r = 0; r < 4; ++r) {
                const int tk = 4 * g + r;
                const float rr = rsqrtf((SSb[w0 * 16 + tk] + SSb[(w0 + 1) * 16 + tk]) * (1.f / DMODEL) + EPS);
                const float z = (Pb[w0 * 256 + tk * 16 + c16] + Pb[(w0 + 1) * 256 + tk * 16 + c16]) * rr;
                float mx = z;
                mx = fmaxf(mx, __shfl_xor(mx, 1)); mx = fmaxf(mx, __shfl_xor(mx, 2)); mx = fmaxf(mx, __shfl_xor(mx, 4)); mx = fmaxf(mx, __shfl_xor(mx, 8));
                const float ex = expf(z - mx);
                float den = ex;
                den += __shfl_xor(den, 1); den += __shfl_xor(den, 2); den += __shfl_xor(den, 4); den += __shfl_xor(den, 8);
                aff[(size_t)(r0 + tk) * NE + c16] = ex / den;
                slot[(size_t)(r0 + tk) * NE + c16] = -1;
            }
        }
        __syncthreads();
    }
}
__device__ __forceinline__ void p7_topk(const Args& a, Frame& F) {
    LAS unsigned* hist = (LAS unsigned*)(F.lds + RING_OFF);
    LAS unsigned* wsum = hist + 256;
    LAS unsigned* bc = hist + 272;
    const float* aff = (const float*)(a.ws + WS_AFF); int* slot = (int*)(a.ws + WS_SLOT); int* sel_tok = (int*)(a.ws + WS_SELT); float* sel_gate = (float*)(a.ws + WS_SELG);
    const int tid = F.tid, lane = F.lane, w = F.wave;
    for (int be = F.bx; be < NB * NE; be += F.G) {
        const int b = be / NE, e = be % NE;
        unsigned key[4];
#pragma unroll
        for (int j = 0; j < 4; ++j) key[j] = __float_as_uint(aff[(size_t)(b * SEQ + 4 * tid + j) * NE + e]);
        unsigned prefix = 0u, mask = 0u, need = CAP;
#pragma unroll
        for (int pass = 0; pass < 4; ++pass) {
            const int shift = 24 - 8 * pass;
            __syncthreads();
            if (tid < 256) hist[tid] = 0u;
            __syncthreads();
#pragma unroll
            for (int j = 0; j < 4; ++j) if ((key[j] & mask) == prefix) __hip_atomic_fetch_add(&hist[(key[j] >> shift) & 255u], 1u, __ATOMIC_RELAXED, __HIP_MEMORY_SCOPE_WORKGROUP);
            __syncthreads();
            if (w == 0) {
                const unsigned c0 = hist[4 * lane], c1 = hist[4 * lane + 1], c2 = hist[4 * lane + 2], c3 = hist[4 * lane + 3];
                const unsigned sl = c0 + c1 + c2 + c3;
                unsigned inc = sl;
#pragma unroll
                for (int o = 1; o < 64; o <<= 1) { const unsigned v = __shfl_down(inc, o); if (lane + o < 64) inc += v; }
                unsigned run = inc - sl;
                const unsigned cc[4] = {c3, c2, c1, c0};
#pragma unroll
                for (int q = 0; q < 4; ++q) { if (run < need && run + cc[q] >= need) { bc[0] = (unsigned)(4 * lane + 3 - q); bc[1] = need - run; } run += cc[q]; }
            }
            __syncthreads();
            prefix |= bc[0] << shift; mask |= 255u << shift; need = bc[1];
        }
        unsigned loc = 0u; unsigned gtf[4], eqf[4];
#pragma unroll
        for (int j = 0; j < 4; ++j) { gtf[j] = key[j] > prefix ? 1u : 0u; eqf[j] = key[j] == prefix ? 1u : 0u; loc += gtf[j] + (eqf[j] << 16); }
        unsigned inc = loc;
#pragma unroll
        for (int o = 1; o < 64; o <<= 1) { const unsigned v = __shfl_up(inc, o); if (lane >= o) inc += v; }
        if (lane == 63) wsum[w] = inc;
        __syncthreads();
        unsigned base = 0u;
#pragma unroll
        for (int ww = 0; ww < 8; ++ww) if (ww < w) base += wsum[ww];
        unsigned run = base + inc - loc;
#pragma unroll
        for (int j = 0; j < 4; ++j) {
            const unsigned gb = run & 0xffffu, eb = run >> 16;
            const bool sel = gtf[j] || (eqf[j] && eb < need);
            if (sel) { const unsigned sl = gb + (eb < need ? eb : need); const int tok = b * SEQ + 4 * tid + j; const int p = (e * NB + b) * CAP + (int)sl;
                sel_tok[p] = tok; sel_gate[p] = __uint_as_float(key[j]); slot[(size_t)tok * NE + e] = (int)sl; }
            run += gtf[j] + (eqf[j] << 16);
        }
    }
}
__device__ __forceinline__ void p10_final(const Args& a, Frame& F, float* dst) {
    const float* x0 = a.in[0]; const bf16* yo = (const bf16*)(a.ws + WS_YO); const float* gf = a.in[21]; const int* slot = (const int*)(a.ws + WS_SLOT); const bf16* Y = (const bf16*)(a.ws + WS_Y);
    const int lane = F.lane;
    const int rstep = F.G * NWAVES;
    f32x4 nx[4]; unsigned long long ny[4]; int nslot = -1;
    { const int row0 = F.bx * NWAVES + F.wave;
      if (row0 < NT) {
#pragma unroll
        for (int j = 0; j < 4; ++j) { nx[j] = ((const GAS f32x4*)(x0 + (size_t)row0 * DMODEL) + lane)[64 * j]; ny[j] = ((const GAS unsigned long long*)(yo + (size_t)row0 * DMODEL) + lane)[64 * j]; }
        nslot = slot[(size_t)row0 * NE + (lane & 15)]; } }
    for (int row = F.bx * NWAVES + F.wave; row < NT; row += rstep) {
        const int b = row / SEQ;
        f32x4 v[4];
#pragma unroll
        for (int j = 0; j < 4; ++j) { const unsigned lo = (unsigned)ny[j], hi = (unsigned)(ny[j] >> 32);
            v[j] = (f32x4){nx[j].x + __uint_as_float(lo << 16), nx[j].y + __uint_as_float(lo & 0xffff0000u), nx[j].z + __uint_as_float(hi << 16), nx[j].w + __uint_as_float(hi & 0xffff0000u)}; }
        const int myslot = nslot;
        if (row + rstep < NT) {
#pragma unroll
            for (int j = 0; j < 4; ++j) { nx[j] = ((const GAS f32x4*)(x0 + (size_t)(row + rstep) * DMODEL) + lane)[64 * j]; ny[j] = ((const GAS unsigned long long*)(yo + (size_t)(row + rstep) * DMODEL) + lane)[64 * j]; }
            nslot = slot[(size_t)(row + rstep) * NE + (lane & 15)]; }
        unsigned long long msk = __ballot(lane < 16 && myslot >= 0);
        while (msk) {
            unsigned long long y[4][4];
#pragma unroll
            for (int q = 0; q < 4; ++q) {
                const bool ok = msk != 0ull; const int e = ok ? (__ffsll((long long)msk) - 1) : 0; const int sl = __shfl(myslot, e);
                if (ok) { msk &= msk - 1ull; const GAS unsigned long long* yr = (const GAS unsigned long long*)(Y + ((size_t)(e * NB + b) * CAP + sl) * DMODEL) + lane;
#pragma unroll
                    for (int j = 0; j < 4; ++j) y[q][j] = yr[64 * j]; }
                else {
#pragma unroll
                    for (int j = 0; j < 4; ++j) y[q][j] = 0ull; }
            }
#pragma unroll
            for (int q = 0; q < 4; ++q)
#pragma unroll
                for (int j = 0; j < 4; ++j) { const unsigned lo = (unsigned)y[q][j], hi = (unsigned)(y[q][j] >> 32);
                    v[j].x += __uint_as_float(lo << 16); v[j].y += __uint_as_float(lo & 0xffff0000u); v[j].z += __uint_as_float(hi << 16); v[j].w += __uint_as_float(hi & 0xffff0000u); }
        }
        float s = 0.f;
#pragma unroll
        for (int j = 0; j < 4; ++j) s += (v[j].x * v[j].x + v[j].y * v[j].y) + (v[j].z * v[j].z + v[j].w * v[j].w);
        const float r = rsqrtf(wave_sum(s) * (1.f / DMODEL) + EPS);
#pragma unroll
        for (int j = 0; j < 4; ++j) { const f32x4 w = ((const GAS f32x4*)gf)[lane + 64 * j]; ((GAS f32x4*)(dst + (size_t)row * DMODEL) + lane)[64 * j] = (f32x4){v[j].x * r * w.x, v[j].y * r * w.y, v[j].z * r * w.z, v[j].w * r * w.w}; }
    }
}

#ifndef MK_N_LAUNCHES
#define MK_N_LAUNCHES 1
#endif
constexpr int N_PHASES = 11;
__global__ void __launch_bounds__(NTHR, 2) mk_fwd(Args args) {
    extern __shared__ __attribute__((aligned(16))) unsigned char lds[];
    Frame F;
    F.lds = (LAS unsigned char*)lds;
    F.tid = threadIdx.x; F.lane = F.tid & 63; F.wave = __builtin_amdgcn_readfirstlane(F.tid >> 6);
    F.G = gridDim.x; F.bx = blockIdx.x;
    unsigned char* ws = args.ws;
    gu32* ctl = (gu32*)(ws + WS_CTL);
    for (int u = F.tid; u < (LDS_BYTES - LDSCTL_OFF) / 4; u += NTHR) ((LAS unsigned*)(F.lds + LDSCTL_OFF))[u] = 0u;
    __syncthreads();
    volatile LAS unsigned* MISC = (volatile LAS unsigned*)(F.lds + MISC_OFF);
    XcdBarrier bar; bar.bar = (unsigned*)(ctl + CW_BAR) + args.li * XCD_BAR_WORDS; bar.x = 0; bar.st = nullptr;
    if (MK_N_LAUNCHES != N_PHASES) bar = xcd_barrier_post((unsigned*)(ctl + CW_BAR) + args.li * XCD_BAR_WORDS, MISC + 8);
    const int lo = args.ph_lo, hi = args.ph_hi;
#define IN(k) (lo <= (k) && (k) < hi)
#define SEAM(k) do { if (IN(k) && IN((k) + 1)) xcd_barrier(bar); asm volatile("" : "+v"(F.tid)); F.lane = F.tid & 63; } while (0)
#ifndef DUP_PHASE
#define DUP_PHASE -1
#endif
#define DUPBAR(k) if (DUP_PHASE == (k)) xcd_barrier(bar)
#ifndef SPIN_PHASE
#define SPIN_PHASE -1
#endif
    unsigned long long tstamp0 = 0, tstamp1 = 0;
#define STAMP(k) do { if (SPIN_PHASE >= 0) { if ((k) == SPIN_PHASE) tstamp0 = __builtin_amdgcn_s_memrealtime(); if ((k) == SPIN_PHASE + 1) tstamp1 = __builtin_amdgcn_s_memrealtime(); } } while (0)

    STAMP(0);
    if (IN(0)) { p0_prologue(args, F); if (DUP_PHASE == 0) { xcd_barrier(bar); p0_prologue(args, F); } } SEAM(0);
    STAMP(1);
    if (IN(1)) for (int rep = 0; rep < (DUP_PHASE == 1 ? 2 : 1); ++rep) {   if (rep) xcd_barrier(bar);
        pg8::Gemm g{(const pg8::bf16_t*)(ws + WS_XN), (const pg8::bf16_t*)(ws + WS_WIN), NT, DPROJ, DMODEL, nullptr, 0};
        pg8::StaticOrder S; S.init(NT, DPROJ, F.G, F.bx);
        static_assert(WS_KR - WS_QR == WS_VR - WS_KR, "Q, K, V buffers equally spaced");
        pg8::EpiInProj E{(pg8::bf16_t*)(ws + WS_PROJ), DPROJ, (pg8::bf16_t*)(ws + WS_QR), (size_t)(WS_KR - WS_QR) / 2, (const float*)(ws + WS_ROPE)};
        pg8::gemm_phase<pg8::EpiInProj, pg8::StaticOrder, true, true, false>(F.lds + RING_OFF, g, S, E);
    } SEAM(1);
    STAMP(2);
    if (IN(2)) { p2_prep(args, F); if (DUP_PHASE == 2) { xcd_barrier(bar); p2_prep(args, F); } } SEAM(2);
    STAMP(3);
    if (IN(3)) { p3_mlstm(args, F); p3_attn(args, F); if (DUP_PHASE == 3) { xcd_barrier(bar); p3_mlstm(args, F); p3_attn(args, F); } if (DUP_PHASE == 31) { xcd_barrier(bar); p3_mlstm(args, F); } if (DUP_PHASE >= 3100 && DUP_PHASE < 3132) { xcd_barrier(bar); for (int item = F.bx; item < NB * MH * 2; item += F.G) mlstm_item<(DUP_PHASE >= 3100 ? DUP_PHASE - 3100 : 0) | 1>(args, F, item); __syncthreads(); } if (DUP_PHASE == 32) { xcd_barrier(bar); p3_attn(args, F); } if (DUP_PHASE >= 320 && DUP_PHASE < 328) { xcd_barrier(bar); p3_attn_var<DUP_PHASE >= 320 ? (DUP_PHASE - 320) | 4 : 4>(args, F); } } SEAM(3);
    STAMP(4);
    if (IN(4)) { p4_mix(args, F); if (DUP_PHASE == 4) { xcd_barrier(bar); p4_mix(args, F); } } SEAM(4);
    STAMP(5);
    if (IN(5)) for (int rep = 0; rep < (DUP_PHASE == 5 ? 2 : 1); ++rep) {   if (rep) xcd_barrier(bar);
        pg8::Gemm g{(const pg8::bf16_t*)(ws + WS_XN), (const pg8::bf16_t*)(ws + WS_WOUT), NT, DMODEL, DMODEL, nullptr, 0};
        pg8::StaticOrder S; S.init(NT, DMODEL, F.G, F.bx);
        pg8::EpiStoreBf16 E{(pg8::bf16_t*)(ws + WS_YO), DMODEL};
        pg8::gemm_phase<pg8::EpiStoreBf16, pg8::StaticOrder, true, true, false>(F.lds + RING_OFF, g, S, E);
    } SEAM(5);
    STAMP(6);
    if (IN(6)) { p6_router(args, F); if (DUP_PHASE == 6) { xcd_barrier(bar); p6_router(args, F); } } SEAM(6);
    STAMP(7);
    if (IN(7)) { p7_topk(args, F); if (DUP_PHASE == 7) { xcd_barrier(bar); p7_topk(args, F); } cvt_run(args, F, -1, 0u); if (DUP_PHASE == 40) { xcd_barrier(bar); cvt_run(args, F, -1, 0u, -1, 0u, 320); } } SEAM(7);
    STAMP(8);
    if (IN(8)) for (int rep = 0; rep < (DUP_PHASE == 8 ? 2 : 1); ++rep) {   if (rep) xcd_barrier(bar);
        if (F.G == 256) {
            for (int seg = 0; seg < 2; ++seg) {
                pg8::Gemm g{(const pg8::bf16_t*)(ws + WS_XN), (const pg8::bf16_t*)(ws + WS_W13), NPAIR, NE * 2 * DEXP, DMODEL, (const int*)(ws + WS_SELT), 0x7a7a7a7a};
                pg8::MoeUpOrder S; S.init(F.bx, seg);
                pg8::EpiSwiGLU E{ws + WS_H, DEXP, 2 * DEXP / 256};
                pg8::gemm_phase<pg8::EpiSwiGLU, pg8::MoeUpOrder, false, true, true, true>(F.lds + RING_OFF, g, S, E);
            }
        }
    }
    if (DUP_PHASE == 80 || DUP_PHASE == 81) { xcd_barrier(bar);
        for (int seg = 0; seg < 2; ++seg) {
            pg8::Gemm g{(const pg8::bf16_t*)(ws + WS_XN), (const pg8::bf16_t*)(ws + WS_W13), NPAIR, NE * 2 * DEXP, DMODEL, (const int*)(ws + WS_SELT), 0x7a7a7a7a};
            pg8::MoeUpOrder S; S.init(F.bx, seg);
            pg8::EpiNull E{};
            pg8::gemm_phase<pg8::EpiNull, pg8::MoeUpOrder, DUP_PHASE == 80, true, true, true>(F.lds + RING_OFF, g, S, E);
        }
    } SEAM(8);
    STAMP(9);
    if (IN(9)) for (int rep = 0; rep < (DUP_PHASE == 9 ? 2 : 1); ++rep) {   if (rep) xcd_barrier(bar);
        if (F.G == 256) {
            pg8::Gemm g{(const pg8::bf16_t*)(ws + WS_H), (const pg8::bf16_t*)(ws + WS_W2), NPAIR, NE * DMODEL, DEXP, nullptr, 0x79797979};
            pg8::MoeDownOrder S; S.init(F.bx);
            pg8::EpiDown E{(pg8::bf16_t*)(ws + WS_Y), DMODEL, (const float*)(ws + WS_SELG)};
            pg8::gemm_phase<pg8::EpiDown, pg8::MoeDownOrder, true, true, false, true>(F.lds + RING_OFF, g, S, E);
        }
    } SEAM(9);
    STAMP(10);
    if (IN(10)) { if (DUP_PHASE == 10) { p10_final(args, F, (float*)(ws + WS_H)); xcd_barrier(bar); } if (DUP_PHASE == 11) { for (int q = 0; q < 10; ++q) xcd_barrier(bar); } p10_final(args, F, args.out); }
    STAMP(11);
    if (SPIN_PHASE >= 0 && F.bx == 0 && F.tid == 0) { const unsigned long long until = __builtin_amdgcn_s_memrealtime() + 8ull * (tstamp1 - tstamp0); while (__builtin_amdgcn_s_memrealtime() < until) __builtin_amdgcn_s_sleep(8); }
#undef IN
#undef SEAM
}

extern "C" void kernel_launch(void* const* d_in, const int* in_sizes, int n_in, void* d_out, int out_size, void* d_ws, size_t ws_size, hipStream_t stream) {
    static int grid = 0;
    if (grid == 0) {
        if (n_in != 22 || out_size != NT * DMODEL || ws_size < WS_END) { fprintf(stderr, "kernel_launch: unexpected shapes (n_in %d out %d ws %zu need %zu)\n", n_in, out_size, ws_size, (size_t)WS_END); grid = -1; return; }
        int dev = 0, cus = 0, per_cu = 0;
        if (hipGetDevice(&dev) != hipSuccess || hipDeviceGetAttribute(&cus, hipDeviceAttributeMultiprocessorCount, dev) != hipSuccess) { grid = -1; return; }
        if (hipFuncSetAttribute((const void*)mk_fwd, hipFuncAttributeMaxDynamicSharedMemorySize, LDS_BYTES) != hipSuccess) { fprintf(stderr, "kernel_launch: hipFuncSetAttribute failed\n"); grid = -1; return; }
        if (hipOccupancyMaxActiveBlocksPerMultiprocessor(&per_cu, (const void*)mk_fwd, NTHR, LDS_BYTES) != hipSuccess || per_cu < 1) { fprintf(stderr, "kernel_launch: occupancy query says %d blocks per CU\n", per_cu); grid = -1; (void)hipGetLastError(); return; }
        grid = cus;
        if (grid != 256) fprintf(stderr, "kernel_launch: %d CUs: the MoE phases are built for 256\n", grid);
    }
    if (grid < 0) return;
    (void)hipMemsetAsync((char*)d_ws + WS_CTL, 0, CTL_ZERO_BYTES, stream);
    Args a{};
    for (int i = 0; i < 22; ++i) a.in[i] = (const float*)d_in[i];
    a.out = (float*)d_out; a.ws = (unsigned char*)d_ws;
    for (int li = 0; li < MK_N_LAUNCHES; ++li) {
        if (MK_N_LAUNCHES == 1) { a.ph_lo = 0; a.ph_hi = N_PHASES; } else { a.ph_lo = li; a.ph_hi = li + 1; }
        a.li = (MK_N_LAUNCHES == 1) ? 0 : 0;
        hipLaunchKernelGGL(mk_fwd, dim3(grid), dim3(NTHR), LDS_BYTES, stream, a);
    }
}
```

```cpp
#include <hip/hip_runtime.h>
#include <cstdio>
#include <cstdint>
#include <cmath>

namespace pg8 {
#define PG8_LAS __attribute__((address_space(3)))
typedef unsigned short bf16_t;
typedef short bf16x8 __attribute__((ext_vector_type(8)));
typedef float f32x4 __attribute__((ext_vector_type(4)));
typedef float f32x2 __attribute__((ext_vector_type(2)));
typedef unsigned u32x4 __attribute__((ext_vector_type(4)));
constexpr int BM = 256, BK = 64, HALF = 128, HTB = HALF * BK * 2  , STAGE_BYTES = 8 * HTB, NXCD = 8, WGM = 8;

__host__ __device__ __forceinline__ int lds_byte(int r, int c) { const int st = (r >> 4) * 2 + (c >> 5), rr = r & 15, cc = c & 31, ob = rr * 64 + cc * 2; return st * 1024 + (ob ^ (((ob >> 9) & 1) << 5)); }
__host__ __device__ __forceinline__ void stage_rc(int b, int& R, int& C) { const int st = b / 1024, sb = b % 1024, swz = sb ^ (((sb >> 9) & 1) << 5); R = (st >> 1) * 16 + swz / 64; C = (st & 1) * 32 + (swz % 64) / 2; }
__host__ __device__ __forceinline__ int perm32(int rho) { const int n = rho >> 4, i = rho & 15; return 8 * (i >> 2) + 4 * n + (i & 3); }

typedef int v8i_t __attribute__((ext_vector_type(8)));
typedef int v4i_t __attribute__((ext_vector_type(4)));
__device__ __forceinline__ v8i_t cat32(bf16x8 a, bf16x8 b) { const v4i_t x = __builtin_bit_cast(v4i_t, a), y = __builtin_bit_cast(v4i_t, b); return (v8i_t){x[0], x[1], x[2], x[3], y[0], y[1], y[2], y[3]}; }
struct Unit { int pm, pn; };
struct Gemm { const bf16_t* A; const bf16_t* Bt; int M, N, K; const int* rowidx; int wscale; int lda = 0, ldb = 0; };

struct StaticOrder {
    int nM, nN, nwg, G, c;
    __host__ __device__ void init(int M, int N, int G_, int c_) { nM = M / BM; nN = N / BM; nwg = nM * nN; G = G_; c = c_; }
    __host__ __device__ bool next(int i, Unit& u) const {
        const long L = (long)i * G + c; if (L >= nwg) return false;
        int wgid = (int)L; { const int q = nwg / NXCD, r = nwg % NXCD, xcd = wgid % NXCD, off = wgid / NXCD; wgid = (xcd < r ? xcd * (q + 1) : r * (q + 1) + (xcd - r) * q) + off; }
        const int nig = WGM * nN, gid = wgid / nig, fm = gid * WGM, gsz = (nM - fm) < WGM ? (nM - fm) : WGM;
        u.pm = fm + ((wgid % nig) % gsz); u.pn = (wgid % nig) / gsz; return true;
    }
    __device__ __forceinline__ void a_ready(const Unit&) const {}
    __device__ __forceinline__ void done(const Unit&) const {}
};


__device__ __forceinline__ unsigned cvt_pk_bf16(float lo, float hi) { unsigned r; asm volatile("v_cvt_pk_bf16_f32 %0, %1, %2" : "=v"(r) : "v"(lo), "v"(hi)); return r; }
__device__ __forceinline__ float fast_silu(float x) { return x * __builtin_amdgcn_rcpf(1.0f + __builtin_amdgcn_exp2f(-1.4426950408889634f * x)); }

struct EpiStoreBf16 {
    static constexpr bool PERM = true, AFTER_DRAIN = false;
    bf16_t* O; int ldc;
    __device__ __forceinline__ void operator()(const f32x4 (&acc)[2][2][4][2], const Unit& u, int wr, int wc, int fr, int fq) const {
        const int row0 = u.pm * BM + wr * 64 + fr, col0 = u.pn * BM + wc * 32 + 8 * fq;
#pragma unroll
        for (int ai = 0; ai < 2; ++ai)
#pragma unroll
            for (int m = 0; m < 4; ++m) { bf16_t* rowp = O + (size_t)(row0 + ai * HALF + m * 16) * ldc + col0;
#pragma unroll
                for (int bj = 0; bj < 2; ++bj) { const f32x4 v0 = acc[ai][bj][m][0], v1 = acc[ai][bj][m][1];
                    u32x4 w; w.x = cvt_pk_bf16(v0[0], v0[1]); w.y = cvt_pk_bf16(v0[2], v0[3]); w.z = cvt_pk_bf16(v1[0], v1[1]); w.w = cvt_pk_bf16(v1[2], v1[3]);
                    *(u32x4*)(rowp + bj * HALF) = w; } }
    }
};
struct EpiInProj {
    static constexpr bool PERM = true, AFTER_DRAIN = false;
    bf16_t* O; int ldc; bf16_t* QKVo; size_t kind_stride; const float* rope;
    __device__ __forceinline__ void operator()(const f32x4 (&acc)[2][2][4][2], const Unit& u, int wr, int wc, int fr, int fq) const {
        const int row0 = u.pm * BM + wr * 64 + fr;
        if (u.pn < 4) {
            const int col0 = u.pn * BM + wc * 32 + 8 * fq;
#pragma unroll
            for (int ai = 0; ai < 2; ++ai)
#pragma unroll
                for (int m = 0; m < 4; ++m) { bf16_t* rowp = O + (size_t)(row0 + ai * HALF + m * 16) * ldc + col0;
#pragma unroll
                    for (int bj = 0; bj < 2; ++bj) { const f32x4 v0 = acc[ai][bj][m][0], v1 = acc[ai][bj][m][1];
                        u32x4 w; w.x = cvt_pk_bf16(v0[0], v0[1]); w.y = cvt_pk_bf16(v0[2], v0[3]); w.z = cvt_pk_bf16(v1[0], v1[1]); w.w = cvt_pk_bf16(v1[2], v1[3]);
                        *(u32x4*)(rowp + bj * HALF) = w; } }
            return;
        }
        const int kind = (u.pn - 4) >> 1;
        bf16_t* dst = QKVo + (size_t)kind * kind_stride;
        const float scl = kind == 0 ? 0.125f : 1.0f;
        const bool roped = kind < 2 && (wc & 1) == 0;
        const int d0 = 32 * (wc & 1) + 8 * fq;
#pragma unroll
        for (int ai = 0; ai < 2; ++ai)
#pragma unroll
            for (int m = 0; m < 4; ++m) {
                const int row = row0 + ai * HALF + m * 16, b = row >> 11, sq = row & 2047;
                const float sgn = fq == 0 ? -1.f : 1.f;
#pragma unroll
                for (int bj = 0; bj < 2; ++bj) {
                    const int hh = ((u.pn & 1) << 2) + 2 * bj + (wc >> 1);
                    u32x4 w;
#pragma unroll
                    for (int n = 0; n < 2; ++n) {
                        f32x4 v = acc[ai][bj][m][n];
                        if (roped) {
                            f32x4 p;
#pragma unroll
                            for (int i = 0; i < 4; ++i) p[i] = __shfl_xor(v[i], 16);
                            if (fq < 2) { const f32x4 cs = *(const f32x4*)(rope + sq * 16 + 4 * n), sn = *(const f32x4*)(rope + sq * 16 + 8 + 4 * n); v = v * cs + p * (sn * sgn); }
                        }
                        v = v * scl;
                        if (n == 0) { w.x = cvt_pk_bf16(v[0], v[1]); w.y = cvt_pk_bf16(v[2], v[3]); } else { w.z = cvt_pk_bf16(v[0], v[1]); w.w = cvt_pk_bf16(v[2], v[3]); }
                    }
                    *(u32x4*)(dst + (((size_t)b * 8 + hh) * 2048 + sq) * 64 + d0) = w;
                }
                __builtin_amdgcn_sched_barrier(0);
            }
    }
};
struct EpiRes {
    static constexpr bool PERM = false, AFTER_DRAIN = false;
    const float* base; float* out; int ldc;
    __device__ __forceinline__ void operator()(const f32x4 (&acc)[2][2][4][2], const Unit& u, int wr, int wc, int fr, int fq) const {
        const int row0 = u.pm * BM + wr * 64 + fr, col0 = u.pn * BM + wc * 32 + 4 * fq;
#pragma unroll
        for (int ai = 0; ai < 2; ++ai)
#pragma unroll
            for (int m = 0; m < 4; ++m) { const size_t off = (size_t)(row0 + ai * HALF + m * 16) * ldc + col0;
#pragma unroll
                for (int bj = 0; bj < 2; ++bj)
#pragma unroll
                    for (int n = 0; n < 2; ++n) { const f32x4 bs = *(const f32x4*)(base + off + bj * HALF + n * 16); *(f32x4*)(out + off + bj * HALF + n * 16) = bs + acc[ai][bj][m][n]; } }
    }
};
struct EpiSwiGLU {
    static constexpr bool PERM = true, AFTER_DRAIN = false;
    unsigned char* H; int ldc; int tiles_per_expert;
    __device__ __forceinline__ void operator()(const f32x4 (&acc)[2][2][4][2], const Unit& u, int wr, int wc, int fr, int fq) const {
        unsigned char* tb = H + ((size_t)(u.pm * tiles_per_expert + (u.pn % tiles_per_expert)) * 256 + wr * 64 + fr) * 128 + wc * 32 + 8 * fq;
#pragma unroll
        for (int ai = 0; ai < 2; ++ai)
#pragma unroll
            for (int m = 0; m < 4; ++m) { unsigned char* rowp = tb + (size_t)(ai * HALF + m * 16) * 128;
                float h[8];
#pragma unroll
                for (int n = 0; n < 2; ++n)
#pragma unroll
                    for (int i = 0; i < 4; i += 2) {
                        const f32x2 y = {acc[ai][0][m][n][i], acc[ai][0][m][n][i + 1]}, gp = {acc[ai][1][m][n][i], acc[ai][1][m][n][i + 1]};
                        f32x2 d = {__builtin_amdgcn_exp2f(-y[0]), __builtin_amdgcn_exp2f(-y[1])}; d = d + 1.0f;
                        const f32x2 r = {__builtin_amdgcn_rcpf(d[0]), __builtin_amdgcn_rcpf(d[1])};
                        const f32x2 o = (y * gp) * r; h[n * 4 + i] = o[0]; h[n * 4 + i + 1] = o[1]; }
                int w0 = 0, w1 = 0;
                w0 = __builtin_amdgcn_cvt_pk_fp8_f32(h[0], h[1], w0, false); w0 = __builtin_amdgcn_cvt_pk_fp8_f32(h[2], h[3], w0, true);
                w1 = __builtin_amdgcn_cvt_pk_fp8_f32(h[4], h[5], w1, false); w1 = __builtin_amdgcn_cvt_pk_fp8_f32(h[6], h[7], w1, true);
                *(unsigned long long*)rowp = (unsigned long long)(unsigned)w0 | ((unsigned long long)(unsigned)w1 << 32);
                __builtin_amdgcn_sched_barrier(0); }
    }
};
struct EpiNull {
    static constexpr bool PERM = true, AFTER_DRAIN = false;
    __device__ __forceinline__ void operator()(const f32x4 (&acc)[2][2][4][2], const Unit& u, int wr, int wc, int fr, int fq) const {
#pragma unroll
        for (int ai = 0; ai < 2; ++ai)
#pragma unroll
            for (int bj = 0; bj < 2; ++bj)
#pragma unroll
                for (int m = 0; m < 4; ++m) asm volatile("" :: "v"(acc[ai][bj][m][0]), "v"(acc[ai][bj][m][1]));
    }
};
struct EpiDown {
    static constexpr bool PERM = true, AFTER_DRAIN = false;
    unsigned char* Y; int ldc; const float* gate;
    __device__ __forceinline__ void operator()(const f32x4 (&acc)[2][2][4][2], const Unit& u, int wr, int wc, int fr, int fq) const {
        const int row0 = u.pm * BM + wr * 64 + fr, col0 = (u.pn & 3) * BM + wc * 32 + 8 * fq;
#pragma unroll
        for (int ai = 0; ai < 2; ++ai)
#pragma unroll
            for (int m = 0; m < 4; ++m) { const int row = row0 + ai * HALF + m * 16; const float gt = gate[row] * 64.f; unsigned char* rowp = Y + (size_t)row * ldc + col0;
#pragma unroll
                for (int bj = 0; bj < 2; ++bj) { const f32x4 v0 = acc[ai][bj][m][0] * gt, v1 = acc[ai][bj][m][1] * gt;
                    int w0 = 0, w1 = 0;
                    w0 = __builtin_amdgcn_cvt_pk_fp8_f32(v0[0], v0[1], w0, false); w0 = __builtin_amdgcn_cvt_pk_fp8_f32(v0[2], v0[3], w0, true);
                    w1 = __builtin_amdgcn_cvt_pk_fp8_f32(v1[0], v1[1], w1, false); w1 = __builtin_amdgcn_cvt_pk_fp8_f32(v1[2], v1[3], w1, true);
                    *(unsigned long long*)(rowp + bj * HALF) = (unsigned long long)(unsigned)w0 | ((unsigned long long)(unsigned)w1 << 32); }
                asm volatile("" ::: "memory"); }
    }
};
struct MoeUpOrder {
    int x, lc, seg, i0, n;
    __device__ void init(int c, int seg_) { x = c & 7; lc = c >> 3; seg = seg_; const int n0 = lc < 16 ? 6 : 5; i0 = seg ? n0 : 0; n = seg ? 11 - n0 : n0; }
    __device__ bool next(int i, Unit& u) const { if (i >= n) return false; const int L = (i0 + i) * 32 + lc, e = 2 * x + L / 176, w = L % 176; u.pm = e * 8 + (w & 7); u.pn = e * 22 + (w >> 3); return true; }
    __device__ __forceinline__ void a_ready(const Unit&) const {}
    __device__ __forceinline__ void done(const Unit&) const {}
};
struct MoeDownOrder {
    int x, lc;
    __device__ void init(int c) { x = c & 7; lc = c >> 3; }
    __device__ bool next(int i, Unit& u) const { if (i >= 2) return false; const int e = 2 * x + i; u.pm = e * 8 + (lc & 7); u.pn = e * 4 + (lc >> 3); return true; }
    __device__ __forceinline__ void a_ready(const Unit&) const {}
    __device__ __forceinline__ void done(const Unit&) const {}
};

template <bool F8> struct Frag;
template <> struct Frag<false> { bf16x8 k[2]; };
template <> struct Frag<true> { v8i_t v; };
template <class Epi, class Sched, bool ALIGN_EPI = false, bool SP2 = true, bool GATHER = false, bool F8 = false>
__device__ __forceinline__ void gemm_phase(PG8_LAS unsigned char* lds, const Gemm g, const Sched& S, const Epi& E) {
    int tid_ = threadIdx.x; asm volatile("" : "+v"(tid_));
    const int tid = tid_, wid = __builtin_amdgcn_readfirstlane(tid >> 6), lane = tid & 63, wr = wid >> 2, wc = wid & 3, fr = lane & 15, fq = lane >> 4;
    const int K = g.K, KB = F8 ? K : 2 * K  , nt = KB / (BK * 2);
    const int ldA = g.lda ? g.lda : KB, ldB = g.ldb ? g.ldb : KB;
    unsigned voffA[2], voffB[2]; int RA[2]; unsigned CA2[2];
    unsigned gc[2][2];
#pragma unroll
    for (int i = 0; i < 2; ++i) { int R, C; stage_rc(tid * 16 + i * 8192, R, C); const int Rb = Epi::PERM ? ((R & ~31) + perm32(R & 31)) : R;
        voffA[i] = (unsigned)(R * ldA + C * 2); voffB[i] = (unsigned)(Rb * ldB + C * 2); RA[i] = R; CA2[i] = (unsigned)C * 2u; }
    const size_t kstepA = g.lda ? (size_t)BM * g.lda : (size_t)(BK * 2), kstepB = g.ldb ? (size_t)BM * g.ldb : (size_t)(BK * 2);
    const size_t hstepB = (size_t)HALF * ldB;
    const size_t hstepA = GATHER ? (size_t)0 : (size_t)HALF * ldA;
    const size_t tstep = (size_t)BM * KB;
    const unsigned ldsw = (unsigned)wid * 1024u;
    const int aoff = lds_byte(wr * 64 + fr, fq * 8), boff = lds_byte(wc * 32 + fr, fq * 8);
    PG8_LAS unsigned char* ldsAr = lds + aoff; PG8_LAS unsigned char* ldsBr = lds + 4 * HTB + boff;
    asm volatile("" : "+v"(ldsAr), "+v"(ldsBr));
#define PG8_SA(b, h) (((b) * 2 + (h)) * HTB)
#define PG8_SB(b, h) ((4 + (b) * 2 + (h)) * HTB)
#define PG8_STAGE(bufoff, gbase, voff) do { _Pragma("unroll") for (int _i = 0; _i < 2; ++_i) \
        __builtin_amdgcn_global_load_lds((const unsigned*)((const char*)(gbase) + (voff)[_i]), (PG8_LAS unsigned*)(lds + (bufoff) + ldsw + _i * 8192), 16, 0, 0); } while (0)
#define PG8_GLOAD(dst, u) do { _Pragma("unroll") for (int _h = 0; _h < 2; ++_h) _Pragma("unroll") for (int _i = 0; _i < 2; ++_i) \
        dst[_h][_i] = (unsigned)g.rowidx[(u).pm * BM + _h * HALF + RA[_i]] * (unsigned)KB + CA2[_i]; } while (0)
#define PG8_STAGE_A(bufoff, aptr, h, usenext) do { if constexpr (GATHER) { PG8_STAGE(bufoff, aptr, gc[h]); } \
        else { PG8_STAGE(bufoff, (aptr) + (h) * hstepA, voffA); } } while (0)
#define PG8_LD1(d, p) do { if constexpr (F8) { (d).v = cat32(*(const PG8_LAS bf16x8*)(p), *(const PG8_LAS bf16x8*)((p) + 1024)); } else { (d).k[0] = *(const PG8_LAS bf16x8*)(p); (d).k[1] = *(const PG8_LAS bf16x8*)((p) + 1024); } } while (0)
#define PG8_LDA(dst, b, h) do { _Pragma("unroll") for (int m = 0; m < 4; ++m) PG8_LD1(dst[m], ldsAr + PG8_SA(b, h) + m * 2048); } while (0)
#define PG8_LDB(dst, b, h) do { _Pragma("unroll") for (int n = 0; n < 2; ++n) PG8_LD1(dst[n], ldsBr + ((b) * 2 + (h)) * HTB + n * 2048); } while (0)
#define PG8_SUB(v, o) ((f32x4){(v)[(o)], (v)[(o) + 1], (v)[(o) + 2], (v)[(o) + 3]})
#define PG8_INS(v, r, o) do { (v)[(o)] = (r)[0]; (v)[(o) + 1] = (r)[1]; (v)[(o) + 2] = (r)[2]; (v)[(o) + 3] = (r)[3]; } while (0)
#define PG8_MMA(ai, bj, At, Bt) do { __builtin_amdgcn_s_setprio(1); \
        _Pragma("unroll") for (int m = 0; m < 4; ++m) _Pragma("unroll") for (int n = 0; n < 2; ++n) { \
            f32x4 c_ = PG8_SUB(accq[ai][bj][m >> 1], 8 * (m & 1) + 4 * n); \
            if constexpr (F8) { c_ = __builtin_amdgcn_mfma_scale_f32_16x16x128_f8f6f4(Bt[n].v, At[m].v, c_, 0, 0, 0, g.wscale, 0, 0x7f7f7f7f); } \
            else { _Pragma("unroll") for (int k = 0; k < 2; ++k) c_ = __builtin_amdgcn_mfma_f32_16x16x32_bf16(Bt[n].k[k], At[m].k[k], c_, 0, 0, 0); } \
            PG8_INS(accq[ai][bj][m >> 1], c_, 8 * (m & 1) + 4 * n); } \
        __builtin_amdgcn_s_setprio(0); } while (0)
#define PG8_WAIT_V(n) asm volatile("s_waitcnt vmcnt(" #n ")" ::: "memory")
#define PG8_WAIT_L(n) asm volatile("s_waitcnt lgkmcnt(" #n ")" ::: "memory")
#define PG8_BAR __builtin_amdgcn_s_barrier()
#define PG8_SCHED __builtin_amdgcn_sched_barrier(0)
    Unit cur, nxt; int ui = 0;
    if (!S.next(0, cur)) return;
    typedef float f32x16_t __attribute__((ext_vector_type(16)));
    f32x16_t accq[2][2][2];
    Frag<F8> At[4], B0[2], B1[2];
    const char* cA = GATHER ? (const char*)g.A : (const char*)g.A + (size_t)cur.pm * tstep; const char* cB = (const char*)g.Bt + (size_t)cur.pn * tstep;
    if constexpr (GATHER) { PG8_GLOAD(gc, cur); asm volatile("s_waitcnt vmcnt(0)" ::: "memory"); }
    S.a_ready(cur);
    if constexpr (SP2) {
        PG8_STAGE(PG8_SB(0, 0), cB, voffB); PG8_STAGE(PG8_SB(0, 1), cB + hstepB, voffB); PG8_STAGE_A(PG8_SA(0, 0), cA, 0, false); PG8_STAGE_A(PG8_SA(0, 1), cA, 1, false);
        if (wr == 1) PG8_BAR;
        PG8_WAIT_V(2); PG8_BAR;
        PG8_STAGE(PG8_SB(1, 0), cB + kstepB, voffB); PG8_STAGE_A(PG8_SA(1, 0), cA + kstepA, 0, false); PG8_STAGE(PG8_SB(1, 1), cB + hstepB + kstepB, voffB);
        PG8_WAIT_V(6); PG8_BAR;
    } else {
        PG8_STAGE(PG8_SB(0, 0), cB, voffB); PG8_STAGE(PG8_SA(0, 0), cA, voffA); PG8_STAGE(PG8_SB(0, 1), cB + hstepB, voffB); PG8_STAGE(PG8_SA(0, 1), cA + hstepB, voffA);
        if (wr == 1) PG8_BAR;
        PG8_WAIT_V(4); PG8_BAR;
        PG8_STAGE(PG8_SB(1, 0), cB + kstepB, voffB); PG8_STAGE(PG8_SA(1, 0), cA + kstepA, voffA); PG8_STAGE(PG8_SB(1, 1), cB + hstepB + kstepB, voffB);
        PG8_WAIT_V(6); PG8_BAR;
    }
    PG8_SCHED;
#pragma unroll
    for (int a = 0; a < 2; ++a)
#pragma unroll
        for (int b = 0; b < 2; ++b)
#pragma unroll
            for (int m = 0; m < 2; ++m)
#pragma unroll
                for (int i = 0; i < 16; ++i) accq[a][b][m][i] = 0.f;
    for (;;) {
        const bool has_next = S.next(ui + 1, nxt);
        const char* nA = GATHER ? (const char*)g.A : (has_next ? (const char*)g.A + (size_t)nxt.pm * tstep : cA); const char* nB = has_next ? (const char*)g.Bt + (size_t)nxt.pn * tstep : cB;
#pragma unroll 1
        for (int t = 0; t < nt; t += 2) {
            const bool last = (t == nt - 2);
            const char* a1 = cA + (size_t)(t + 1) * kstepA;
            const char* a2 = last ? nA : cA + (size_t)(t + 2) * kstepA; const char* b2 = last ? nB : cB + (size_t)(t + 2) * kstepB;
            const char* a3 = a2 + kstepA; const char* b3 = b2 + kstepB;
            if (last && has_next) S.a_ready(nxt);
            if constexpr (SP2) {
            PG8_LDB(B0, 0, 0); PG8_LDB(B1, 0, 1); PG8_SCHED; PG8_LDA(At, 0, 0); PG8_STAGE_A(PG8_SA(1, 1), a1, 1, false);
            PG8_WAIT_V(8); PG8_WAIT_L(0); PG8_BAR; PG8_MMA(0, 0, At, B0); PG8_MMA(0, 1, At, B1); PG8_BAR; PG8_SCHED;
            PG8_LDA(At, 0, 1); PG8_STAGE(PG8_SB(0, 0), b2, voffB); PG8_STAGE(PG8_SB(0, 1), b2 + hstepB, voffB); PG8_STAGE_A(PG8_SA(0, 0), a2, 0, last);
            PG8_WAIT_V(8); PG8_WAIT_L(0); PG8_BAR; PG8_MMA(1, 0, At, B0); PG8_MMA(1, 1, At, B1); PG8_BAR; PG8_SCHED;
            PG8_LDB(B0, 1, 0); PG8_LDB(B1, 1, 1); PG8_SCHED; PG8_LDA(At, 1, 0); PG8_STAGE_A(PG8_SA(0, 1), a2, 1, last);
            PG8_WAIT_V(8); PG8_WAIT_L(0); PG8_BAR; PG8_MMA(0, 0, At, B0); PG8_MMA(0, 1, At, B1); PG8_BAR; PG8_SCHED;
            PG8_LDA(At, 1, 1); PG8_STAGE(PG8_SB(1, 0), b3, voffB); PG8_STAGE(PG8_SB(1, 1), b3 + hstepB, voffB); PG8_STAGE_A(PG8_SA(1, 0), a3, 0, last);
            PG8_WAIT_V(8); PG8_WAIT_L(0); PG8_BAR; PG8_MMA(1, 0, At, B0); PG8_MMA(1, 1, At, B1); PG8_BAR; PG8_SCHED;
            } else {
            PG8_LDB(B0, 0, 0); PG8_SCHED; PG8_LDA(At, 0, 0); PG8_STAGE(PG8_SA(1, 1), a1 + hstepB, voffA);
            PG8_WAIT_L(8); PG8_BAR; PG8_WAIT_L(0); PG8_MMA(0, 0, At, B0); PG8_BAR; PG8_SCHED;
            PG8_LDB(B1, 0, 1); PG8_STAGE(PG8_SB(0, 0), b2, voffB);
            PG8_BAR; PG8_WAIT_L(0); PG8_MMA(0, 1, At, B1); PG8_BAR;
            PG8_LDA(At, 0, 1); PG8_STAGE(PG8_SA(0, 0), a2, voffA);
            PG8_BAR; PG8_WAIT_L(0); PG8_MMA(1, 0, At, B0); PG8_BAR; PG8_SCHED;
            PG8_STAGE(PG8_SB(0, 1), b2 + hstepB, voffB);
            PG8_WAIT_V(6); PG8_BAR; PG8_MMA(1, 1, At, B1); PG8_BAR;
            PG8_LDB(B0, 1, 0); PG8_SCHED; PG8_LDA(At, 1, 0); PG8_STAGE(PG8_SA(0, 1), a2 + hstepB, voffA);
            PG8_WAIT_L(8); PG8_BAR; PG8_WAIT_L(0); PG8_MMA(0, 0, At, B0); PG8_BAR; PG8_SCHED;
            PG8_LDB(B1, 1, 1); PG8_STAGE(PG8_SB(1, 0), b3, voffB);
            PG8_BAR; PG8_WAIT_L(0); PG8_MMA(0, 1, At, B1); PG8_BAR;
            PG8_LDA(At, 1, 1); PG8_STAGE(PG8_SA(1, 0), a3, voffA);
            PG8_BAR; PG8_WAIT_L(0); PG8_MMA(1, 0, At, B0); PG8_BAR; PG8_SCHED;
            PG8_STAGE(PG8_SB(1, 1), b3 + hstepB, voffB);
            PG8_WAIT_V(6); PG8_BAR; PG8_MMA(1, 1, At, B1); PG8_BAR;
            }
        }
        if constexpr (ALIGN_EPI) { if (wr == 0) PG8_BAR; }
        if constexpr (!Epi::AFTER_DRAIN) { f32x4 acc[2][2][4][2];
            _Pragma("unroll") for (int a = 0; a < 2; ++a) _Pragma("unroll") for (int b = 0; b < 2; ++b) _Pragma("unroll") for (int m = 0; m < 4; ++m) _Pragma("unroll") for (int n = 0; n < 2; ++n) acc[a][b][m][n] = PG8_SUB(accq[a][b][m >> 1], 8 * (m & 1) + 4 * n);
            E(acc, cur, wr, wc, fr, fq); S.done(cur); }
        if (!has_next) break;
#pragma unroll
        for (int a = 0; a < 2; ++a)
#pragma unroll
            for (int b = 0; b < 2; ++b)
#pragma unroll
                for (int m = 0; m < 2; ++m)
#pragma unroll
                    for (int i = 0; i < 16; ++i) accq[a][b][m][i] = 0.f;
        cur = nxt; cA = nA; cB = nB; ++ui;
        if constexpr (ALIGN_EPI) { if (wr == 1) PG8_BAR; }
    }
    PG8_WAIT_V(0);
    if constexpr (!ALIGN_EPI) { if (wr == 0) PG8_BAR; }
    PG8_BAR;

#undef PG8_SA
#undef PG8_SB
#undef PG8_STAGE
#undef PG8_GLOAD
#undef PG8_STAGE_A
#undef PG8_LD1
#undef PG8_LDA
#undef PG8_LDB
#undef PG8_SUB
#undef PG8_INS
#undef PG8_MMA
#undef PG8_WAIT_V
#undef PG8_WAIT_L
#undef PG8_BAR
#undef PG8_SCHED
}
}


constexpr int NB = 8, SEQ = 2048, DMODEL = 1024, NT = NB * SEQ;
constexpr int DML = 512, DAT = 512, DPROJ = 2560, PROJ_LD = 1024;
constexpr int MH = 4, MDH = 128, AH = 8, ADH = 64;
constexpr int NE = 16, CAP = 256, DEXP = 2816, NPAIR = NE * NB * CAP;
constexpr float EPS = 1e-6f;
constexpr int NWAVES = 8, NTHR = 512;

constexpr size_t MiB = 1u << 20;
constexpr size_t WS_CTL = 0, CTL_ZERO_BYTES = 32768;
constexpr size_t WS_WIN = 1 * MiB;
constexpr size_t WS_WOUT = WS_WIN + (size_t)DPROJ * DMODEL * 2;
constexpr size_t WS_W13 = WS_WOUT + (size_t)DMODEL * DMODEL * 2;
constexpr size_t WS_W2 = WS_W13 + (size_t)NE * 2 * DEXP * DMODEL;
constexpr size_t WS_XN = WS_W2 + (size_t)NE * DMODEL * DEXP;
constexpr size_t WS_PROJ = WS_XN + (size_t)NT * DMODEL * 2;
constexpr size_t WS_AFF = WS_PROJ + (size_t)NT * DPROJ * 2;
constexpr size_t WS_SLOT = WS_AFF + (size_t)NT * NE * 4;
constexpr size_t WS_SELT = WS_SLOT + (size_t)NT * NE * 4;
constexpr size_t WS_SELG = WS_SELT + (size_t)NPAIR * 4;
constexpr size_t WS_GI = WS_SELG + (size_t)NPAIR * 4;
constexpr size_t WS_GF = WS_GI + (size_t)2 * NB * MH * SEQ * 4;
constexpr size_t WS_ROPE = WS_GF + (size_t)2 * NB * MH * SEQ * 4;
constexpr size_t WS_WT = WS_ROPE + (size_t)SEQ * 16 * 4;
constexpr size_t WS_MIX0 = WS_WT + 65536;
constexpr size_t WS_XC = WS_MIX0;
constexpr size_t WS_QM = WS_XC + (size_t)NT * DML * 2;
constexpr size_t WS_KM = WS_QM + (size_t)NT * DML * 2;
constexpr size_t WS_VM = WS_KM + (size_t)NT * DML * 2;
constexpr size_t WS_QR = WS_VM + (size_t)NT * DML * 2;
constexpr size_t WS_KR = WS_QR + (size_t)NT * DAT * 2;
constexpr size_t WS_VR = WS_KR + (size_t)NT * DAT * 2;
constexpr size_t WS_HFB = WS_VR + (size_t)NT * DAT * 2;
constexpr size_t WS_OPART = WS_HFB + (size_t)2 * NT * DML * 4;
constexpr size_t WS_OSTAT = WS_OPART + (size_t)3 * NT * DAT * 2;
constexpr size_t WS_MIX1 = WS_OSTAT + (size_t)3 * NT * AH * 2 * 4;
constexpr size_t WS_MIXED = WS_MIX1;
constexpr size_t WS_H2 = WS_MIXED + (size_t)NT * DMODEL * 2;
constexpr size_t WS_XR = WS_H2 + (size_t)NT * DMODEL;
constexpr size_t WS_MIX2 = WS_XR + (size_t)NT * 4;
constexpr size_t WS_YO = WS_HFB;
constexpr size_t WS_H = WS_MIX0;
constexpr size_t WS_Y = WS_PROJ;
constexpr size_t WS_END = (WS_MIX2 > WS_H + (size_t)NPAIR * DEXP) ? WS_MIX2 : WS_H + (size_t)NPAIR * DEXP;
static_assert((size_t)NPAIR * DMODEL * 2 <= (size_t)NT * DPROJ * 2, "Y fits in proj");
static_assert(WS_H + (size_t)NPAIR * DEXP <= WS_HFB && (size_t)NT * DMODEL * 2 <= (size_t)2 * NT * DML * 4, "y lives in hfb, clear of H");
static_assert(WS_END <= (size_t)736 * MiB, "d_ws map must stay below 4x the largest input");
constexpr int CW_TMO = 0, CW_QHEAD = 64, CW_MDONE = 128, CW_P1DONE = 192, CW_ADONE = 256, CW_BAR = 4096;
static_assert((CW_BAR + 3456) * 4 <= (int)CTL_ZERO_BYTES, "control words inside the per-call memset");
constexpr int CVT_EARLY = (DMODEL / 64) * (DPROJ / 64) + (DMODEL / 64) * (DMODEL / 64);
constexpr int CVT_MOE = NE * (2 * (DMODEL / 64) * (DEXP / 64) + (DEXP / 64) * (DMODEL / 64)), CVT_BATCH = 8, CVT_NBATCH = CVT_MOE / CVT_BATCH;
static_assert(CVT_MOE % CVT_BATCH == 0, "conversion batches");

constexpr int RING_OFF = 0, RING_BYTES = 155648;
constexpr int LDSCTL_OFF = RING_BYTES, MISC_OFF = LDSCTL_OFF + 320;
constexpr int LDS_BYTES = 160 * 1024;

#define GAS __attribute__((address_space(1)))
#define LAS __attribute__((address_space(3)))
typedef unsigned short bf16;
typedef unsigned v4u __attribute__((ext_vector_type(4)));
typedef float f32x4 __attribute__((ext_vector_type(4)));
typedef short bf16x8 __attribute__((ext_vector_type(8)));
typedef GAS unsigned gu32;
typedef GAS unsigned long long gu64;
#define RLX_AGENT __ATOMIC_RELAXED, __HIP_MEMORY_SCOPE_AGENT
#define LDS_WAIT() asm volatile("s_waitcnt lgkmcnt(0)" ::: "memory")
#define VM_WAIT() asm volatile("s_waitcnt vmcnt(0)" ::: "memory")
__device__ __forceinline__ unsigned long long rt() { return __builtin_amdgcn_s_memrealtime(); }
__device__ __forceinline__ unsigned f2bf(float f) { unsigned u = __builtin_bit_cast(unsigned, f); return (u + 0x7fffu + ((u >> 16) & 1u)) >> 16; }
__device__ __forceinline__ unsigned pk2(float lo, float hi) { return f2bf(lo) | (f2bf(hi) << 16); }

#define XB_TMO      128
#define XB_XCNT(j)  (256  + 64 * (j))
#define XB_XSUB(j)  (1280 + 64 * (j))
#define XB_XGEN(j)  (2304 + 64 * (j))
#define XB_TOP      3328
#define XB_TOPGEN   3392
#define XCD_BAR_WORDS 3456
#define XB_SPIN_CAP (1u << 18)

__device__ __forceinline__ unsigned xb_ld(unsigned* p)              { return __hip_atomic_load(p, __ATOMIC_RELAXED, __HIP_MEMORY_SCOPE_AGENT); }
__device__ __forceinline__ unsigned xb_add(unsigned* p, unsigned v) { return __hip_atomic_fetch_add(p, v, __ATOMIC_RELAXED, __HIP_MEMORY_SCOPE_AGENT); }
__device__ __forceinline__ unsigned xb_xcc_id() { return (unsigned)__builtin_amdgcn_s_getreg((3 << 11) | 20) & 0xFu; }
#define XB_SPIN(cond, bar) do { unsigned _sp = 0; while (cond) { __builtin_amdgcn_s_sleep(1); \
    if ((++_sp & 255u) == 0u) { if (xb_ld(&(bar)[XB_TMO])) break; if (_sp > XB_SPIN_CAP) { atomicAdd(&(bar)[XB_TMO], 1u); break; } } } } while (0)

struct XcdBarrier {
    unsigned* bar; unsigned x;
    volatile LAS unsigned* st;
};

__device__ __forceinline__ XcdBarrier xcd_barrier_post(unsigned* bar, volatile LAS unsigned* st) {
    XcdBarrier b; b.bar = bar; b.x = xb_xcc_id(); b.st = st;
    if (threadIdx.x == 0) (void)xb_add(&bar[XB_XCNT(b.x)], 1u);
    return b;
}
__device__ __forceinline__ void xcd_barrier_complete(unsigned* bar, unsigned x, unsigned& nloc, unsigned& nx) {
    const unsigned G = gridDim.x * gridDim.y * gridDim.z;
    unsigned sum, cnt, mine, sp = 0u;
    for (;;) {
        sum = 0u; cnt = 0u; mine = 0u;
#pragma unroll
        for (unsigned j = 0; j < 16; ++j) { const unsigned c = xb_ld(&bar[XB_XCNT(j)]); sum += c; cnt += (c > 0u) ? 1u : 0u; mine = (j == x) ? c : mine; }
        if (sum == G) break;
        __builtin_amdgcn_s_sleep(1);
        if ((++sp & 255u) == 0u) { if (xb_ld(&bar[XB_TMO])) break; if (sp > XB_SPIN_CAP) { atomicAdd(&bar[XB_TMO], 1u); break; } }
    }
    nloc = mine > 0u ? mine : 1u; nx = cnt > 0u ? cnt : 1u;
}

__device__ __forceinline__ void xcd_barrier(const XcdBarrier& b) {
    asm volatile("s_waitcnt vmcnt(0)" ::: "memory");
    __syncthreads();
    if (threadIdx.x == 0) {
        unsigned* bar = b.bar;
        __builtin_amdgcn_s_waitcnt(0);
        unsigned nloc = b.st[0], nx = b.st[1];
        if (nloc == 0u) { xcd_barrier_complete(bar, b.x, nloc, nx); b.st[0] = nloc; b.st[1] = nx; }
        const unsigned old = xb_add(&bar[XB_XSUB(b.x)], 1u);
        const unsigned gen = old / nloc;
        if (old + 1u == (gen + 1u) * nloc) {
            __builtin_amdgcn_fence(__ATOMIC_RELEASE, "agent");
            asm volatile("s_waitcnt vmcnt(0)" ::: "memory");
            const unsigned og = xb_add(&bar[XB_TOP], 1u);
            const unsigned tg = og / nx;
            if (og + 1u == (tg + 1u) * nx) xb_add(&bar[XB_TOPGEN], 1u);
            else XB_SPIN(xb_ld(&bar[XB_TOPGEN]) == tg, bar);
            __builtin_amdgcn_fence(__ATOMIC_ACQUIRE, "agent");
            xb_add(&bar[XB_XGEN(b.x)], 1u);
            asm volatile("s_waitcnt vmcnt(0)" ::: "memory");
        } else {
            XB_SPIN(xb_ld(&bar[XB_XGEN(b.x)]) == gen, bar);
            __builtin_amdgcn_fence(__ATOMIC_ACQUIRE, "agent");
            asm volatile("s_waitcnt vmcnt(0)" ::: "memory");
        }
    }
    __syncthreads();
}


__device__ __forceinline__ float bf2f(unsigned short u) { return __uint_as_float((unsigned)u << 16); }
__device__ __forceinline__ float wave_sum(float v) {
#pragma unroll
    for (int o = 1; o < 64; o <<= 1) v += __shfl_xor(v, o);
    return v;
}
__device__ __forceinline__ float siluf(float x) { return x / (1.f + expf(-x)); }
__device__ __forceinline__ float logsigf(float x) { return fminf(x, 0.f) - log1pf(expf(-fabsf(x))); }

struct Args {
    const float* in[22]; float* out; unsigned char* ws; int ph_lo, ph_hi, li, pad;
};
struct Frame { LAS unsigned char* lds; int tid, lane, wave, G, bx; };

__device__ __forceinline__ void cvt_load(const float* W, int ldw, int k0, int n0, int lane, f32x4 (&r)[16]) {
    const int n4 = lane & 15, rp = lane >> 4;
#pragma unroll
    for (int it = 0; it < 8; ++it) {
        const float* p = W + (size_t)(k0 + 8 * it + 2 * rp) * ldw + n0 + 4 * n4;
        r[2 * it] = __builtin_nontemporal_load((const GAS f32x4*)p); r[2 * it + 1] = __builtin_nontemporal_load((const GAS f32x4*)(p + ldw));
    }
}
__device__ __forceinline__ void cvt_store(const f32x4 (&r)[16], unsigned char* dst  , int ldd  , LAS unsigned* scr, int lane) {
    const int n4 = lane & 15, rp = lane >> 4;
#pragma unroll
    for (int it = 0; it < 8; ++it) {
        const int kp = 4 * it + rp;
#pragma unroll
        for (int i = 0; i < 4; ++i) { const int n = 4 * n4 + i; scr[n * 32 + (((kp >> 2) ^ (n4 & 7)) << 2) + (kp & 3)] = pk2(r[2 * it][i], r[2 * it + 1][i]); }
    }
    LDS_WAIT(); asm volatile("" ::: "memory");
    const int c = lane & 7;
#pragma unroll
    for (int it = 0; it < 8; ++it) {
        const int n = 8 * it + (lane >> 3);
        const v4u o = *(const LAS v4u*)(scr + n * 32 + ((c ^ ((n >> 2) & 7)) << 2));
        *(GAS v4u*)(dst + (size_t)n * ldd + 16 * c) = o;
    }
    LDS_WAIT(); asm volatile("" ::: "memory");
}
__device__ __forceinline__ void cvt8_load(const float* W, int ldw, int k0, int n0, int lane, f32x4 (&r)[16]) {
    const int n4 = lane & 15, rp = lane >> 4;
#pragma unroll
    for (int it = 0; it < 4; ++it) {
        const float* p = W + (size_t)(k0 + 16 * it + 4 * rp) * ldw + n0 + 4 * n4;
#pragma unroll
        for (int q = 0; q < 4; ++q) r[4 * it + q] = __builtin_nontemporal_load((const GAS f32x4*)(p + (size_t)q * ldw));
    }
}
__device__ __forceinline__ void cvt8_store(const f32x4 (&r)[16], unsigned char* dst, int ldd, LAS unsigned* scr, int lane, float sc) {
    const int n4 = lane & 15, rp = lane >> 4;
#pragma unroll
    for (int it = 0; it < 4; ++it) {
        const int kq = 4 * it + rp;
#pragma unroll
        for (int i = 0; i < 4; ++i) { int w = 0; w = __builtin_amdgcn_cvt_pk_fp8_f32(r[4 * it][i] * sc, r[4 * it + 1][i] * sc, w, false); w = __builtin_amdgcn_cvt_pk_fp8_f32(r[4 * it + 2][i] * sc, r[4 * it + 3][i] * sc, w, true);
            scr[(4 * n4 + i) * 17 + kq] = (unsigned)w; }
    }
    LDS_WAIT(); asm volatile("" ::: "memory");
    const int c = lane & 3;
#pragma unroll
    for (int j = 0; j < 4; ++j) {
        const int n = 16 * j + (lane >> 2);
        const v4u o = {scr[n * 17 + 4 * c], scr[n * 17 + 4 * c + 1], scr[n * 17 + 4 * c + 2], scr[n * 17 + 4 * c + 3]};
        *(GAS v4u*)(dst + (size_t)n * ldd + 16 * c) = o;
    }
    LDS_WAIT(); asm volatile("" ::: "memory");
}
struct CvtItem { const float* W; int ldw, k0, n0; unsigned char* dst; int ldd; int f8; float sc; };
__device__ __forceinline__ bool cvt_item(const Args& a, int it, CvtItem& c) {
    unsigned char* ws = a.ws;
    constexpr int I_IN = (DMODEL / 64) * (DPROJ / 64), I_OUT = (DMODEL / 64) * (DMODEL / 64), I_W1 = (DMODEL / 64) * (DEXP / 64), I_W2 = (DEXP / 64) * (DMODEL / 64);
    constexpr int NITEMS = I_IN + I_OUT + NE * (2 * I_W1 + I_W2);
    if (it >= NITEMS) return false;
    if (it < I_IN) { const int nb = DPROJ / 64, kb = it / nb, n0 = (it % nb) * 64; c = {a.in[2], DPROJ, kb * 64, n0, ws + WS_WIN + ((size_t)n0 * DMODEL + kb * 64) * 2, DMODEL * 2, 0, 1.f}; return true; }
    it -= I_IN;
    if (it < I_OUT) { const int nb = DMODEL / 64, kb = it / nb, n0 = (it % nb) * 64; c = {a.in[15], DMODEL, kb * 64, n0, ws + WS_WOUT + ((size_t)n0 * DMODEL + kb * 64) * 2, DMODEL * 2, 0, 1.f}; return true; }
    it -= I_OUT;
    const int per_e = 2 * I_W1 + I_W2, e = it / per_e; it %= per_e;
    if (it < 2 * I_W1) { const int which = it / I_W1; it %= I_W1; const int nb = DEXP / 64, kb = it / nb, n0 = (it % nb) * 64;
        const float* W = a.in[which ? 19 : 18] + (size_t)e * DMODEL * DEXP;
        const size_t drow = (size_t)e * 2 * DEXP + (size_t)(n0 / 128) * 256 + (n0 % 128) + (which ? 128 : 0);
        c = {W, DEXP, kb * 64, n0, ws + WS_W13 + drow * DMODEL + kb * 64, DMODEL, 1, which ? 32.f * 0.6931471805599453f : 32.f * 1.4426950408889634f}; return true; }
    it -= 2 * I_W1;
    { const int nb = DMODEL / 64, kb = it / nb, n0 = (it % nb) * 64; const float* W = a.in[20] + (size_t)e * DEXP * DMODEL;
      c = {W, DMODEL, kb * 64, n0, ws + WS_W2 + ((size_t)e * DMODEL + n0) * DEXP + kb * 64, DEXP, 1, 64.f}; return true; }
}
__device__ __forceinline__ void p0_prologue(const Args& a, Frame& F) {
    LAS unsigned* scr = (LAS unsigned*)(F.lds + RING_OFF + F.wave * 8192);
    const int gw = F.bx * NWAVES + F.wave, NGW = F.G * NWAVES;
    {
        const float* x = a.in[0]; const float* g1 = a.in[1]; bf16* XN = (bf16*)(a.ws + WS_XN);
        f32x4 gq[4];
#pragma unroll
        for (int j = 0; j < 4; ++j) gq[j] = ((const GAS f32x4*)g1)[F.lane + 64 * j];
        f32x4 nx[4], nx2[4];
        if (gw < NT) {
#pragma unroll
            for (int j = 0; j < 4; ++j) nx[j] = __builtin_nontemporal_load(((const GAS f32x4*)(x + (size_t)gw * DMODEL) + F.lane) + 64 * j); }
        if (gw + NGW < NT) {
#pragma unroll
            for (int j = 0; j < 4; ++j) nx2[j] = __builtin_nontemporal_load(((const GAS f32x4*)(x + (size_t)(gw + NGW) * DMODEL) + F.lane) + 64 * j); }
        for (int m = gw; m < NT; m += NGW) {
            f32x4 v[4]; float s = 0.f;
#pragma unroll
            for (int j = 0; j < 4; ++j) { v[j] = nx[j]; nx[j] = nx2[j]; }
            if (m + 2 * NGW < NT) {
#pragma unroll
                for (int j = 0; j < 4; ++j) nx2[j] = __builtin_nontemporal_load(((const GAS f32x4*)(x + (size_t)(m + 2 * NGW) * DMODEL) + F.lane) + 64 * j); }
#pragma unroll
            for (int j = 0; j < 4; ++j) s += (v[j].x * v[j].x + v[j].y * v[j].y) + (v[j].z * v[j].z + v[j].w * v[j].w);
            const float r = rsqrtf(wave_sum(s) * (1.f / DMODEL) + EPS);
            if (F.lane == 0) ((float*)(a.ws + WS_XR))[m] = 1.f / r;
            GAS unsigned long long* o8 = (GAS unsigned long long*)(XN + (size_t)m * DMODEL) + F.lane;
#pragma unroll
            for (int j = 0; j < 4; ++j) { const f32x4 w = gq[j];
                o8[64 * j] = (unsigned long long)pk2(v[j].x * r * w.x, v[j].y * r * w.y) | ((unsigned long long)pk2(v[j].z * r * w.z, v[j].w * r * w.w) << 32); }
        }
    }
    { float* rope = (float*)(a.ws + WS_ROPE);
      for (int i = F.bx + F.G * F.tid; i < SEQ * 8; i += F.G * NTHR) { const int sidx = i >> 3, k = i & 7; const float ang = (float)sidx * powf(500000.0f, -2.0f * (float)k / 16.0f); rope[sidx * 16 + k] = cosf(ang); rope[sidx * 16 + 8 + k] = sinf(ang); } }
    { unsigned char* img = a.ws + WS_WT; const float* wf = a.in[8]; const float* wb = a.in[10];
      for (int i = F.bx + F.G * F.tid; i < 16 * 1536; i += F.G * NTHR) { const int n = i / 1536, k = i % 1536; *(bf16*)(img + n * 3088 + k * 2) = (bf16)f2bf(n < 8 ? wf[(size_t)k * 8 + n] : wb[(size_t)k * 8 + n - 8]); } }
    CvtItem cur, nxt; f32x4 ra[16], rb[16];
#define CVT_LOAD(c, r) do { if ((c).f8) cvt8_load((c).W, (c).ldw, (c).k0, (c).n0, F.lane, r); else cvt_load((c).W, (c).ldw, (c).k0, (c).n0, F.lane, r); } while (0)
#define CVT_STORE(c, r) do { if ((c).f8) cvt8_store(r, (c).dst, (c).ldd, scr, F.lane, (c).sc); else cvt_store(r, (c).dst, (c).ldd, scr, F.lane); } while (0)
    int it = F.bx + F.G * F.wave; bool have = it < CVT_EARLY && cvt_item(a, it, cur);
    if (have) CVT_LOAD(cur, ra);
    while (have) {
        const bool hn = (it + NGW < CVT_EARLY) && cvt_item(a, it + NGW, nxt);
        if (hn) CVT_LOAD(nxt, rb);
        CVT_STORE(cur, ra);
        it += NGW; have = hn; if (!have) break;
        cur = nxt;
        const bool hn2 = (it + NGW < CVT_EARLY) && cvt_item(a, it + NGW, nxt);
        if (hn2) CVT_LOAD(nxt, ra);
        CVT_STORE(cur, rb);
        it += NGW; have = hn2; cur = nxt;
    }
}
__device__ __forceinline__ void cvt_pair_item(const Args& a, int batch, int wave, CvtItem& c) {
    unsigned char* ws = a.ws;
    constexpr int B13 = (DMODEL / 128) * (DEXP / 256), B2 = (DEXP / 128) * (DMODEL / 256), PER_E = 2 * B13 + B2;
    static_assert(NE * PER_E == CVT_NBATCH && DEXP % 256 == 0 && DMODEL % 256 == 0, "pair batches");
    const int e = batch / PER_E; int r = batch % PER_E;
    if (r < 2 * B13) { const int which = r / B13; r %= B13; const int ng = DEXP / 256, kb2 = r / ng, n0 = (4 * (r % ng) + (wave >> 1)) * 64;
        const float* W = a.in[which ? 19 : 18] + (size_t)e * DMODEL * DEXP;
        const size_t drow = (size_t)e * 2 * DEXP + (size_t)(n0 / 128) * 256 + (n0 % 128) + (which ? 128 : 0);
        c = {W, DEXP, (2 * kb2 + (wave & 1)) * 64, n0, ws + WS_W13 + drow * DMODEL + kb2 * 128, DMODEL, 1, which ? 32.f * 0.6931471805599453f : 32.f * 1.4426950408889634f}; }
    else { r -= 2 * B13; const int ng = DMODEL / 256, kb2 = r / ng, n0 = (4 * (r % ng) + (wave >> 1)) * 64; const float* W = a.in[20] + (size_t)e * DEXP * DMODEL;
        c = {W, DMODEL, (2 * kb2 + (wave & 1)) * 64, n0, ws + WS_W2 + ((size_t)e * DMODEL + n0) * DEXP + kb2 * 128, DEXP, 1, 64.f}; }
}
__device__ __forceinline__ void cvt8p_write(const f32x4 (&r)[16], int half, LAS unsigned* tile, int lane, float sc) {
    const int n4 = lane & 15, rp = lane >> 4;
#pragma unroll
    for (int it = 0; it < 4; ++it) {
        const int kq = 16 * half + 4 * it + rp;
#pragma unroll
        for (int i = 0; i < 4; ++i) { int w = 0; w = __builtin_amdgcn_cvt_pk_fp8_f32(r[4 * it][i] * sc, r[4 * it + 1][i] * sc, w, false); w = __builtin_amdgcn_cvt_pk_fp8_f32(r[4 * it + 2][i] * sc, r[4 * it + 3][i] * sc, w, true);
            tile[(4 * n4 + i) * 32 + (kq ^ ((n4 & 7) << 2))] = (unsigned)w; }
    }
}
__device__ __forceinline__ void cvt8p_store(int half, unsigned char* dst, int ldd, const LAS unsigned* tile, int lane) {
    const int c = lane & 7;
#pragma unroll
    for (int j = 0; j < 4; ++j) {
        const int n = 32 * half + 8 * j + (lane >> 3);
        const v4u o = *(const LAS v4u*)(tile + n * 32 + ((c ^ ((n >> 2) & 7)) << 2));
        __builtin_nontemporal_store(o, (GAS v4u*)(dst + (size_t)n * ldd + 16 * c));
    }
    LDS_WAIT(); asm volatile("" ::: "memory");
}
__device__ __forceinline__ bool cvt_batch(const Args& a, Frame& F, int stop_word, unsigned stop_target, int stop_word2 = -1, unsigned stop_target2 = 0u, int qword = CW_QHEAD) {
    gu32* ctl = (gu32*)(a.ws + WS_CTL);
    volatile LAS unsigned* bq = (volatile LAS unsigned*)(F.lds + LDSCTL_OFF + 64);
    LAS unsigned* scr = (LAS unsigned*)(F.lds + RING_OFF + F.wave * 8192);
    __syncthreads();
    if (F.tid == 0) {
        unsigned v = 0xffffffffu;
        bool stop = stop_word >= 0 && __hip_atomic_load(ctl + stop_word, RLX_AGENT) >= stop_target;
        if (stop && stop_word2 >= 0) stop = __hip_atomic_load(ctl + stop_word2, RLX_AGENT) >= stop_target2;
        if (!stop) v = __hip_atomic_fetch_add(ctl + qword, 1u, RLX_AGENT);
        bq[0] = v;
    }
    __syncthreads();
    const unsigned batch = bq[0];
    if (batch >= (unsigned)CVT_NBATCH) return false;
    CvtItem c0; f32x4 ra[16];
    cvt_pair_item(a, (int)batch, F.wave, c0);
    cvt8_load(c0.W, c0.ldw, c0.k0, c0.n0, F.lane, ra);
    LAS unsigned* tile = (LAS unsigned*)(F.lds + RING_OFF + (F.wave >> 1) * 16384);
    cvt8p_write(ra, F.wave & 1, tile, F.lane, c0.sc);
    LDS_WAIT(); __syncthreads();
    cvt8p_store(F.wave & 1, c0.dst, c0.ldd, tile, F.lane);
    return true;
}
#ifndef NATT
#define NATT 192
#endif
__device__ __forceinline__ void cvt_stream(const Args& a, Frame& F, int stop_word, unsigned stop_target, int stop_word2 = -1, unsigned stop_target2 = 0u, int qword = CW_QHEAD) {
    gu32* ctl = (gu32*)(a.ws + WS_CTL);
    volatile LAS unsigned* bq = (volatile LAS unsigned*)(F.lds + LDSCTL_OFF + 64);
    LAS unsigned* scr = (LAS unsigned*)(F.lds + RING_OFF + F.wave * 8192);
    unsigned vq = 0xffffffffu, f1 = 0u, f2 = 0u;
#define CVT_FETCH() do { bool stop_ = stop_word >= 0 && f1 >= stop_target && (stop_word2 < 0 || f2 >= stop_target2); \
        vq = stop_ ? 0xffffffffu : __hip_atomic_fetch_add(ctl + qword, 1u, RLX_AGENT); \
        if (stop_word >= 0) f1 = __hip_atomic_load(ctl + stop_word, RLX_AGENT); if (stop_word2 >= 0) f2 = __hip_atomic_load(ctl + stop_word2, RLX_AGENT); } while (0)
    __syncthreads();
    if (F.tid == 0) { CVT_FETCH(); bq[0] = vq; CVT_FETCH(); }
    __syncthreads();
    CvtItem ca, cb; f32x4 ra[16], rb[16];
    const unsigned b0 = bq[0];
    if (b0 >= (unsigned)CVT_NBATCH) return;
    cvt_item(a, CVT_EARLY + (int)b0 * CVT_BATCH + F.wave, ca); CVT_LOAD(ca, ra);
    for (;;) {
        if (F.tid == 0) { bq[1] = vq; CVT_FETCH(); }
        __syncthreads();
        const unsigned b1 = bq[1]; const bool h1 = b1 < (unsigned)CVT_NBATCH;
        if (h1) { cvt_item(a, CVT_EARLY + (int)b1 * CVT_BATCH + F.wave, cb); CVT_LOAD(cb, rb); }
        CVT_STORE(ca, ra);
        if (!h1) break;
        if (F.tid == 0) { bq[0] = vq; CVT_FETCH(); }
        __syncthreads();
        const unsigned b2 = bq[0]; const bool h2 = b2 < (unsigned)CVT_NBATCH;
        if (h2) { cvt_item(a, CVT_EARLY + (int)b2 * CVT_BATCH + F.wave, ca); CVT_LOAD(ca, ra); }
        CVT_STORE(cb, rb);
        if (!h2) break;
    }
#undef CVT_FETCH
}
#ifndef CVT_PIPE
#define CVT_PIPE 0
#endif
__device__ __forceinline__ void cvt_run(const Args& a, Frame& F, int stop_word, unsigned stop_target, int stop_word2 = -1, unsigned stop_target2 = 0u, int qword = CW_QHEAD) {
    if (CVT_PIPE) cvt_stream(a, F, stop_word, stop_target, stop_word2, stop_target2, qword);
    else { while (cvt_batch(a, F, stop_word, stop_target, stop_word2, stop_target2, qword)) {} }
}
#undef CVT_LOAD
#undef CVT_STORE

constexpr int P2_STR = 3088;
constexpr int P2_WT = 0, P2_TILE = 16 * P2_STR, P2_PART = 32 * P2_STR, P2_WQKV = P2_PART + 8192, P2_CONV = P2_WQKV + 3 * 2048 * 4;
static_assert(P2_CONV + 6 * 512 * 4 <= RING_BYTES, "prep LDS map");
__device__ __forceinline__ float bflo(unsigned u) { return __uint_as_float(u << 16); }
__device__ __forceinline__ float bfhi(unsigned u) { return __uint_as_float(u & 0xffff0000u); }
__device__ __forceinline__ void p2_prep(const Args& a, Frame& F) {
    LAS unsigned char* L = F.lds + RING_OFF;
    const bf16* proj = (const bf16*)(a.ws + WS_PROJ);
    const float* conv_w = a.in[3]; const float* conv_b = a.in[4]; const float* wq = a.in[5]; const float* wk = a.in[6]; const float* wv = a.in[7];
    const float* wif_f = a.in[8]; const float* bif_f = a.in[9]; const float* wif_b = a.in[10]; const float* bif_b = a.in[11];
    bf16* xc = (bf16*)(a.ws + WS_XC); bf16* qm = (bf16*)(a.ws + WS_QM); bf16* km = (bf16*)(a.ws + WS_KM); bf16* vm = (bf16*)(a.ws + WS_VM);
    float* gI = (float*)(a.ws + WS_GI); float* gF = (float*)(a.ws + WS_GF); const float* rope = (const float*)(a.ws + WS_ROPE);
    bf16* qr = (bf16*)(a.ws + WS_QR); bf16* kr = (bf16*)(a.ws + WS_KR); bf16* vr = (bf16*)(a.ws + WS_VR);
    const int tid = F.tid, lane = F.lane, w = F.wave, c0 = 8 * lane, c16 = lane & 15, g = lane >> 4;
    LAS float* wqkv = (LAS float*)(L + P2_WQKV); LAS float* convl = (LAS float*)(L + P2_CONV); LAS float* part = (LAS float*)(L + P2_PART);
    __syncthreads();
    {
        const v4u* img = (const v4u*)(a.ws + WS_WT);
        v4u wi[7]; f32x4 wa[3], wb2[3], wc[3], cv[2];
#pragma unroll
        for (int i = 0; i < 7; ++i) { const int idx = tid + NTHR * i; wi[i] = idx < 16 * P2_STR / 16 ? img[idx] : (v4u){0u, 0u, 0u, 0u}; }
        wa[0] = ((const f32x4*)wq)[tid]; wb2[0] = ((const f32x4*)wk)[tid]; wc[0] = ((const f32x4*)wv)[tid];
        cv[0] = ((const f32x4*)conv_w)[tid]; cv[1] = tid < 128 ? ((const f32x4*)conv_w)[512 + tid] : ((const f32x4*)conv_b)[(tid - 128) & 127];
#pragma unroll
        for (int i = 0; i < 7; ++i) { const int idx = tid + NTHR * i; if (idx < 16 * P2_STR / 16) *(LAS v4u*)(L + P2_WT + idx * 16) = wi[i]; }
        ((LAS f32x4*)wqkv)[tid] = wa[0]; ((LAS f32x4*)wqkv)[512 + tid] = wb2[0] * 0.08838834764831845f; ((LAS f32x4*)wqkv)[1024 + tid] = wc[0];
        ((LAS f32x4*)convl)[tid] = cv[0];
        if (tid < 128) ((LAS f32x4*)convl)[512 + tid] = cv[1]; else if (tid < 256) ((LAS f32x4*)convl)[640 + tid - 128] = cv[1];
    }
    __syncthreads();
    float cw[5][8], cb[8];
#pragma unroll
    for (int t5 = 0; t5 < 5; ++t5) { const f32x4 x0 = *(const LAS f32x4*)(convl + t5 * 512 + c0), x1 = *(const LAS f32x4*)(convl + t5 * 512 + c0 + 4);
#pragma unroll
        for (int i = 0; i < 4; ++i) { cw[t5][i] = x0[i]; cw[t5][4 + i] = x1[i]; } }
    { const f32x4 x0 = *(const LAS f32x4*)(convl + 2560 + c0), x1 = *(const LAS f32x4*)(convl + 2560 + c0 + 4);
#pragma unroll
      for (int i = 0; i < 4; ++i) { cb[i] = x0[i]; cb[4 + i] = x1[i]; } }
    for (int tile = F.bx; tile < NT / 64; tile += F.G) {
        const int t0 = tile * 64, b = t0 / SEQ, s0 = t0 % SEQ;
        v4u xr[12];
#pragma unroll
        for (int i = 0; i < 12; ++i) { const int sx = s0 + 8 * w - 2 + i; xr[i] = (sx >= 0 && sx < SEQ) ? *(const v4u*)(proj + (size_t)(b * SEQ + sx) * PROJ_LD + c0) : (v4u){0u, 0u, 0u, 0u}; }
#pragma unroll
        for (int rnd = 0; rnd < 4; ++rnd) {
#pragma unroll
            for (int tt = 0; tt < 2; ++tt) {
                const int ti = 2 * rnd + tt;
                float xcv[8], xmv[8];
#pragma unroll
                for (int i = 0; i < 4; ++i) {
                    float a0 = cb[2 * i], a1 = cb[2 * i + 1];
#pragma unroll
                    for (int t5 = 0; t5 < 5; ++t5) { a0 += cw[t5][2 * i] * bflo(xr[ti + t5][i]); a1 += cw[t5][2 * i + 1] * bfhi(xr[ti + t5][i]); }
                    xcv[2 * i] = a0 * __builtin_amdgcn_rcpf(1.f + __expf(-a0)); xcv[2 * i + 1] = a1 * __builtin_amdgcn_rcpf(1.f + __expf(-a1));
                    xmv[2 * i] = bflo(xr[ti + 2][i]); xmv[2 * i + 1] = bfhi(xr[ti + 2][i]);
                }
                float qv[8], kv[8], vv[8];
#pragma unroll
                for (int grp = 0; grp < 2; ++grp) {
                    const LAS f32x4* wp = (const LAS f32x4*)(wqkv + (2 * lane + grp) * 16);
                    f32x4 q4 = {0.f, 0.f, 0.f, 0.f}, k4 = q4, v4 = q4;
#pragma unroll
                    for (int i = 0; i < 4; ++i) { q4 += wp[i] * xcv[4 * grp + i]; k4 += wp[512 + i] * xcv[4 * grp + i]; v4 += wp[1024 + i] * xmv[4 * grp + i]; }
#pragma unroll
                    for (int o = 0; o < 4; ++o) { qv[4 * grp + o] = q4[o]; kv[4 * grp + o] = k4[o]; vv[4 * grp + o] = v4[o]; }
                }
                const v4u xcp = {pk2(xcv[0], xcv[1]), pk2(xcv[2], xcv[3]), pk2(xcv[4], xcv[5]), pk2(xcv[6], xcv[7])};
                const v4u qp = {pk2(qv[0], qv[1]), pk2(qv[2], qv[3]), pk2(qv[4], qv[5]), pk2(qv[6], qv[7])};
                const v4u kp = {pk2(kv[0], kv[1]), pk2(kv[2], kv[3]), pk2(kv[4], kv[5]), pk2(kv[6], kv[7])};
                const v4u vp = {pk2(vv[0], vv[1]), pk2(vv[2], vv[3]), pk2(vv[4], vv[5]), pk2(vv[6], vv[7])};
                const size_t go = (size_t)(t0 + 8 * w + ti) * DML + c0;
                __builtin_nontemporal_store(xcp, (GAS v4u*)(xc + go)); *(v4u*)(qm + go) = qp; *(v4u*)(km + go) = kp; *(v4u*)(vm + go) = vp;
                LAS unsigned char* tr = L + P2_TILE + (2 * w + tt) * P2_STR + c0 * 2;
                *(LAS v4u*)tr = qp; *(LAS v4u*)(tr + 1024) = kp; *(LAS v4u*)(tr + 2048) = vp;
            }
            __syncthreads();
            f32x4 D = {0.f, 0.f, 0.f, 0.f};
#pragma unroll
            for (int kk = 0; kk < 6; ++kk) { const int ks = 6 * w + kk;
                const bf16x8 A = *(const LAS bf16x8*)(L + P2_TILE + c16 * P2_STR + (32 * ks + 8 * g) * 2);
                const bf16x8 B = *(const LAS bf16x8*)(L + P2_WT + c16 * P2_STR + (32 * ks + 8 * g) * 2);
                D = __builtin_amdgcn_mfma_f32_16x16x32_bf16(A, B, D, 0, 0, 0); }
#pragma unroll
            for (int r = 0; r < 4; ++r) part[w * 256 + (4 * g + r) * 16 + c16] = D[r];
            __syncthreads();
            if (tid < 256) {
                const int row = tid >> 4, n = tid & 15;
                float sm = 0.f;
#pragma unroll
                for (int ww = 0; ww < 8; ++ww) sm += part[ww * 256 + tid];
                const int dirn = n >> 3, j = n & 7, hh = j & 3;
                sm += dirn ? bif_b[j] : bif_f[j];
                const int sx = s0 + 8 * (row >> 1) + 2 * rnd + (row & 1);
                const size_t off = ((size_t)(dirn * NB + b) * MH + hh) * SEQ + sx;
                if (j < 4) gI[off] = sm; else gF[off] = logsigf(sm);
            }
        }
    }
}

typedef short s16x4 __attribute__((ext_vector_type(4)));
typedef short v4i16_t __attribute__((ext_vector_type(4)));
constexpr int ML_STR = 288, ML_TILE = 64 * ML_STR, ML_WSTR = 144;
constexpr int ML_Q = 0, ML_K = ML_TILE, ML_V = 2 * ML_TILE, ML_W = 3 * ML_TILE, ML_PSUM = ML_W + 64 * ML_WSTR, ML_QN = ML_PSUM + 1024, ML_NBUF = ML_QN + 256, ML_SCR = ML_NBUF + 1024;
static_assert(ML_SCR + 8 * 1024 <= RING_BYTES, "mlstm LDS map");
__device__ __forceinline__ unsigned cvtpk2(float lo, float hi) { unsigned r; asm volatile("v_cvt_pk_bf16_f32 %0, %1, %2" : "=v"(r) : "v"(lo), "v"(hi)); return r; }
__device__ __forceinline__ s16x4 trr(LAS unsigned char* p) { return __builtin_bit_cast(s16x4, __builtin_amdgcn_ds_read_tr16_b64_v4i16((LAS v4i16_t*)p)); }
__device__ __forceinline__ bf16x8 cat8(s16x4 a, s16x4 b) { return (bf16x8){a[0], a[1], a[2], a[3], b[0], b[1], b[2], b[3]}; }
__device__ __forceinline__ float scan_add(float x, int lane) {
#pragma unroll
    for (int o = 1; o < 64; o <<= 1) { const float v = __shfl_up(x, o); if (lane >= o) x += v; }
    return x;
}
__device__ __forceinline__ float scan_max(float x, int lane) {
#pragma unroll
    for (int o = 1; o < 64; o <<= 1) { const float v = __shfl_up(x, o); if (lane >= o) x = fmaxf(x, v); }
    return x;
}
constexpr int ML_SCAL = ML_SCR + 8 * 1024;
constexpr int ML_CH = ML_SCAL + 4 * 2048 * 4;
static_assert(ML_CH + 4 * 32 * 4 <= RING_BYTES, "mlstm LDS map 2");
template <int MLV>
__device__ __forceinline__ void mlstm_item(const Args& a, Frame& F, int item) {
    const int dir = item & 1, h = (item >> 1) & 3, b = item >> 3;
    LAS unsigned char* L = F.lds + RING_OFF;
    const int tid = F.tid, w = F.wave; int lane = F.lane, c16 = lane & 15, g = lane >> 4;
    const bf16* qm = (const bf16*)(a.ws + WS_QM); const bf16* km = (const bf16*)(a.ws + WS_KM); const bf16* vm = (const bf16*)(a.ws + WS_VM);
    const float* gi = (const float*)(a.ws + WS_GI) + ((size_t)(dir * NB + b) * MH + h) * SEQ;
    const float* gf = (const float*)(a.ws + WS_GF) + ((size_t)(dir * NB + b) * MH + h) * SEQ;
    bf16* hout = (bf16*)(a.ws + WS_HFB) + (size_t)dir * NT * DML;
    LAS float* scr = (LAS float*)(L + ML_SCR + w * 1024);
    LAS float* Psum = (LAS float*)(L + ML_PSUM); LAS float* qn = (LAS float*)(L + ML_QN); LAS float* nbuf = (LAS float*)(L + ML_NBUF);
    LAS float* s_isc = (LAS float*)(L + ML_SCAL); LAS float* s_rt = s_isc + 2048; LAS float* s_u = s_isc + 4096; LAS float* s_emt = s_isc + 6144;
    LAS float* c_decay = (LAS float*)(L + ML_CH); LAS float* c_f = c_decay + 32; LAS float* c_cref = c_decay + 64; LAS float* c_gtot = c_decay + 96;
    int srow = tid >> 3, spart = tid & 7;
#define hoff ((size_t)h * MDH + 16 * spart)
    f32x4 Cacc[8];
#pragma unroll
    for (int te = 0; te < 8; ++te) Cacc[te] = (f32x4){0.f, 0.f, 0.f, 0.f};
    v4u rq[2], rk[2], rv[2];
    __syncthreads();
    { const int pos = dir ? (SEQ - 1 - srow) : srow; const size_t ro = (size_t)(b * SEQ + pos) * DML + hoff;
      rq[0] = *(const v4u*)(qm + ro); rq[1] = *(const v4u*)(qm + ro + 8); rk[0] = *(const v4u*)(km + ro); rk[1] = *(const v4u*)(km + ro + 8); rv[0] = *(const v4u*)(vm + ro); rv[1] = *(const v4u*)(vm + ro + 8); }
#pragma unroll
    for (int q = 0; q < 4; ++q) {
        const int cc = 4 * w + q, j = cc * 64 + lane, pos = dir ? (SEQ - 1 - j) : j;
        const float ig = gi[pos], lf = gf[pos];
        const float bb = scan_add(lf, lane), x = ig - bb, pm = scan_max(x, lane);
        s_emt[j] = bb; s_u[j] = x; s_rt[j] = pm;
        if (lane == 63) { c_cref[cc] = pm; c_gtot[cc] = bb; }
    }
    if (tid < 256) nbuf[tid] = 0.f;
    __syncthreads();
    {
        float m_prev = 0.f, mp0 = 0.f, mp1 = 0.f, mp2 = 0.f, mp3 = 0.f;
#pragma unroll 1
        for (int cc = 0; cc < 32; ++cc) {
            const float cr = c_cref[cc], gt = c_gtot[cc];
            const int q = cc - 4 * w;
            mp0 = (q == 0) ? m_prev : mp0; mp1 = (q == 1) ? m_prev : mp1; mp2 = (q == 2) ? m_prev : mp2; mp3 = (q == 3) ? m_prev : mp3;
            m_prev = gt + fmaxf(m_prev, cr);
        }
        const float mp[4] = {mp0, mp1, mp2, mp3};
#pragma unroll
        for (int q = 0; q < 4; ++q) {
            const int cc = 4 * w + q, j = cc * 64 + lane;
            const float bb = s_emt[j], x = s_u[j], pm = s_rt[j], cr = c_cref[cc];
            const float mx = fmaxf(mp[q], pm);
            s_isc[j] = expf(mp[q] - mx); s_rt[j] = expf(cr - mx); s_u[j] = expf(x - cr); s_emt[j] = expf(-(bb + mx));
            if (lane == 0) { const float M = fmaxf(mp[q], cr); c_decay[cc] = expf(mp[q] - M); c_f[cc] = expf(cr - M); }
        }
    }
    __syncthreads();
#define ML_STAGE(ccn) do { const float us = s_u[(ccn) * 64 + srow]; \
        _Pragma("unroll") for (int i = 0; i < 2; ++i) { \
            *(LAS v4u*)(L + ML_Q + srow * ML_STR + spart * 32 + 16 * i) = rq[i]; *(LAS v4u*)(L + ML_V + srow * ML_STR + spart * 32 + 16 * i) = rv[i]; \
            v4u o; _Pragma("unroll") for (int j = 0; j < 4; ++j) o[j] = cvtpk2(__uint_as_float(rk[i][j] << 16) * us, __uint_as_float(rk[i][j] & 0xffff0000u) * us); \
            *(LAS v4u*)(L + ML_K + srow * ML_STR + spart * 32 + 16 * i) = o; } } while (0)
    ML_STAGE(0);
    { const int j = 64 + srow, pos = dir ? (SEQ - 1 - j) : j; const size_t ro = (size_t)(b * SEQ + pos) * DML + hoff;
      rq[0] = *(const v4u*)(qm + ro); rq[1] = *(const v4u*)(qm + ro + 8); rk[0] = *(const v4u*)(km + ro); rk[1] = *(const v4u*)(km + ro + 8); rv[0] = *(const v4u*)(vm + ro); rv[1] = *(const v4u*)(vm + ro + 8); }
    __syncthreads();
    for (int cc = 0; cc < SEQ / 64; ++cc) {
        asm volatile("" : "+v"(lane), "+v"(c16), "+v"(g), "+v"(srow), "+v"(spart));
        const int p = cc & 1;
        const bool more = (cc + 1 < SEQ / 64);
        const float decay = c_decay[cc], ff = c_f[cc];
        f32x4 O[4];
#pragma unroll
        for (int ti = 0; ti < 4; ++ti) O[ti] = (f32x4){0.f, 0.f, 0.f, 0.f};
        if constexpr (!(MLV & 8)) {
            bf16x8 Cb[4];
#pragma unroll
            for (int ks = 0; ks < 4; ++ks) { v4u t; t.x = cvtpk2(Cacc[2 * ks][0], Cacc[2 * ks][1]); t.y = cvtpk2(Cacc[2 * ks][2], Cacc[2 * ks][3]); t.z = cvtpk2(Cacc[2 * ks + 1][0], Cacc[2 * ks + 1][1]); t.w = cvtpk2(Cacc[2 * ks + 1][2], Cacc[2 * ks + 1][3]); Cb[ks] = __builtin_bit_cast(bf16x8, t); }
            f32x4 IV[4];
#pragma unroll
            for (int kh2 = 0; kh2 < 2; ++kh2) {
                bf16x8 QA[4][2];
#pragma unroll
                for (int ti = 0; ti < 4; ++ti)
#pragma unroll
                    for (int k2 = 0; k2 < 2; ++k2) QA[ti][k2] = *(const LAS bf16x8*)(L + ML_Q + (16 * ti + c16) * ML_STR + (32 * (2 * kh2 + k2) + 8 * g) * 2);
                __builtin_amdgcn_sched_barrier(0);
#pragma unroll
                for (int k2 = 0; k2 < 2; ++k2)
#pragma unroll
                    for (int ti = 0; ti < 4; ++ti) O[ti] = __builtin_amdgcn_mfma_f32_16x16x32_bf16(QA[ti][k2], Cb[2 * kh2 + k2], O[ti], 0, 0, 0);
                __builtin_amdgcn_sched_barrier(0);
            }
#pragma unroll
            for (int ti = 0; ti < 4; ++ti) IV[ti] = *(const LAS f32x4*)(s_isc + cc * 64 + 16 * ti + 4 * g);
#pragma unroll
            for (int ti = 0; ti < 4; ++ti) O[ti] = O[ti] * IV[ti];
            __builtin_amdgcn_sched_barrier(0);
        }
        if constexpr (!(MLV & 2)) {
            const int ti = w >> 1, t = 16 * ti + c16; const float rtv = s_rt[cc * 64 + t];
            const int si0 = 2 * (w & 1);
            bf16x8 KA[2][4], QB[4];
#pragma unroll
            for (int ks = 0; ks < 4; ++ks) { QB[ks] = *(const LAS bf16x8*)(L + ML_Q + (16 * ti + c16) * ML_STR + (32 * ks + 8 * g) * 2);
#pragma unroll
                for (int sj = 0; sj < 2; ++sj) KA[sj][ks] = *(const LAS bf16x8*)(L + ML_K + (16 * (si0 + sj) + c16) * ML_STR + (32 * ks + 8 * g) * 2); }
            __builtin_amdgcn_sched_barrier(0);
            f32x4 Dt[2] = {{0.f, 0.f, 0.f, 0.f}, {0.f, 0.f, 0.f, 0.f}};
#pragma unroll
            for (int ks = 0; ks < 4; ++ks)
#pragma unroll
                for (int sj = 0; sj < 2; ++sj) Dt[sj] = __builtin_amdgcn_mfma_f32_16x16x32_bf16(KA[sj][ks], QB[ks], Dt[sj], 0, 0, 0);
#pragma unroll
            for (int sj = 0; sj < 2; ++sj) {
                const int si = si0 + sj;
                f32x4 D = Dt[sj]; float ps = 0.f;
#pragma unroll
                for (int r = 0; r < 4; ++r) { const int sx = 16 * si + 4 * g + r; const float v = (si <= ti && sx <= t) ? D[r] : 0.f; D[r] = v; ps += v; }
                *(LAS unsigned long long*)(L + ML_W + t * ML_WSTR + (16 * si + 4 * g) * 2) = (unsigned long long)cvtpk2(D[0] * rtv, D[1] * rtv) | ((unsigned long long)cvtpk2(D[2] * rtv, D[3] * rtv) << 32);
                ps += __shfl_xor(ps, 16); ps += __shfl_xor(ps, 32);
                if (g == 0) Psum[t * 4 + si] = ps;
            }
            __builtin_amdgcn_sched_barrier(0);
        }
        {
            const LAS unsigned char* qp = L + ML_Q + srow * ML_STR + spart * 32;
            const v4u q0 = *(const LAS v4u*)qp, q1 = *(const LAS v4u*)(qp + 16);
            const LAS f32x4* np = (const LAS f32x4*)(nbuf + p * 128 + 16 * spart);
            const f32x4 n0 = np[0], n1 = np[1], n2 = np[2], n3 = np[3];
            float d = 0.f;
            d += __uint_as_float(q0[0] << 16) * n0[0] + __uint_as_float(q0[0] & 0xffff0000u) * n0[1] + __uint_as_float(q0[1] << 16) * n0[2] + __uint_as_float(q0[1] & 0xffff0000u) * n0[3];
            d += __uint_as_float(q0[2] << 16) * n1[0] + __uint_as_float(q0[2] & 0xffff0000u) * n1[1] + __uint_as_float(q0[3] << 16) * n1[2] + __uint_as_float(q0[3] & 0xffff0000u) * n1[3];
            d += __uint_as_float(q1[0] << 16) * n2[0] + __uint_as_float(q1[0] & 0xffff0000u) * n2[1] + __uint_as_float(q1[1] << 16) * n2[2] + __uint_as_float(q1[1] & 0xffff0000u) * n2[3];
            d += __uint_as_float(q1[2] << 16) * n3[0] + __uint_as_float(q1[2] & 0xffff0000u) * n3[1] + __uint_as_float(q1[3] << 16) * n3[2] + __uint_as_float(q1[3] & 0xffff0000u) * n3[3];
            d += __shfl_xor(d, 1); d += __shfl_xor(d, 2); d += __shfl_xor(d, 4);
            if (spart == 0) qn[srow] = d;
        }
        bf16x8 Vf[2];
        {
            const int q4 = c16 >> 2, p4 = c16 & 3;
#pragma unroll
            for (int ks = 0; ks < 2; ++ks) {
                LAS unsigned char* vp = L + ML_V + (32 * ks + 4 * g + q4) * ML_STR + (16 * w + 4 * p4) * 2;
                Vf[ks] = cat8(trr(vp), trr(vp + 16 * ML_STR));
            }
            f32x4 dn = {0.f, 0.f, 0.f, 0.f};
            { unsigned one2 = 0x3F803F80u; asm volatile("" : "+v"(one2)); const bf16x8 ones = __builtin_bit_cast(bf16x8, (v4u){one2, one2, one2, one2});
              LAS unsigned char* kw = L + ML_K + (4 * g + q4) * ML_STR + (32 * (w >> 1) + 8 * p4 + 4 * (w & 1)) * 2;
              const bf16x8 A0 = cat8(trr(kw), trr(kw + 16 * ML_STR)), A1 = cat8(trr(kw + 32 * ML_STR), trr(kw + 48 * ML_STR));
              dn = __builtin_amdgcn_mfma_f32_16x16x32_bf16(A0, ones, dn, 0, 0, 0); dn = __builtin_amdgcn_mfma_f32_16x16x32_bf16(A1, ones, dn, 0, 0, 0); }
            if constexpr (!(MLV & 4))
#pragma unroll
            for (int th = 0; th < 4; ++th) {
                bf16x8 KT[2][2];
#pragma unroll
                for (int t2 = 0; t2 < 2; ++t2)
#pragma unroll
                    for (int ks = 0; ks < 2; ++ks) { const int te = 2 * th + t2; LAS unsigned char* kp = L + ML_K + (32 * ks + 4 * g + q4) * ML_STR + (32 * (te >> 1) + 8 * p4 + 4 * (te & 1)) * 2; KT[t2][ks] = cat8(trr(kp), trr(kp + 16 * ML_STR)); }
                __builtin_amdgcn_sched_barrier(0);
                f32x4 dC[2];
#pragma unroll
                for (int t2 = 0; t2 < 2; ++t2) dC[t2] = __builtin_amdgcn_mfma_f32_16x16x32_bf16(KT[t2][0], Vf[0], (f32x4){0.f, 0.f, 0.f, 0.f}, 0, 0, 0);
#pragma unroll
                for (int t2 = 0; t2 < 2; ++t2) dC[t2] = __builtin_amdgcn_mfma_f32_16x16x32_bf16(KT[t2][1], Vf[1], dC[t2], 0, 0, 0);
#pragma unroll
                for (int t2 = 0; t2 < 2; ++t2) Cacc[2 * th + t2] = Cacc[2 * th + t2] * decay + dC[t2] * ff;
            }
            __builtin_amdgcn_sched_barrier(0);
            if (c16 == 0) { const int ne = 32 * (w >> 1) + 8 * g + 4 * (w & 1); const f32x4 nold = *(const LAS f32x4*)(nbuf + p * 128 + ne); *(LAS f32x4*)(nbuf + (p ^ 1) * 128 + ne) = nold * decay + dn * ff; }
        }
        __syncthreads();
        {
            bf16x8 WA[4][2];
#pragma unroll
            for (int ti = 0; ti < 4; ++ti)
#pragma unroll
                for (int ks = 0; ks < 2; ++ks) if (ks <= (ti >> 1)) { const LAS unsigned char* wp = L + ML_W + (16 * ti + c16) * ML_WSTR + (32 * ks + 4 * g) * 2; WA[ti][ks] = cat8(*(const LAS s16x4*)wp, *(const LAS s16x4*)(wp + 32)); }
            __builtin_amdgcn_sched_barrier(0);
#pragma unroll
            for (int ks = 0; ks < 2; ++ks)
#pragma unroll
                for (int ti = 0; ti < 4; ++ti) if (ks <= (ti >> 1)) O[ti] = __builtin_amdgcn_mfma_f32_16x16x32_bf16(WA[ti][ks], Vf[ks], O[ti], 0, 0, 0);
        }
        {
            const f32x4 pv = *(const LAS f32x4*)(Psum + 4 * lane);
            const float den = s_rt[cc * 64 + lane] * ((pv[0] + pv[1]) + (pv[2] + pv[3])) + s_isc[cc * 64 + lane] * qn[lane];
            scr[lane] = 1.f / fmaxf(fabsf(den), s_emt[cc * 64 + lane]);
#pragma unroll
            for (int ti = 0; ti < 4; ++ti) {
                const f32x4 rd = *(const LAS f32x4*)(scr + 16 * ti + 4 * g);
#pragma unroll
                for (int r = 0; r < 4; ++r) { const int j = cc * 64 + 16 * ti + 4 * g + r, pos = dir ? (SEQ - 1 - j) : j;
                    if constexpr (MLV & 1) { asm volatile("" :: "v"(O[ti][r] * rd[r])); } else hout[(size_t)(b * SEQ + pos) * DML + h * MDH + 16 * w + c16] = (bf16)f2bf(O[ti][r] * rd[r]); }
            }
        }
        if (more) { ML_STAGE(cc + 1); }
        if (cc + 2 < SEQ / 64) { const int j = (cc + 2) * 64 + srow, pos = dir ? (SEQ - 1 - j) : j; const size_t ro = (size_t)(b * SEQ + pos) * DML + hoff;
            rq[0] = *(const v4u*)(qm + ro); rq[1] = *(const v4u*)(qm + ro + 8); rk[0] = *(const v4u*)(km + ro); rk[1] = *(const v4u*)(km + ro + 8); rv[0] = *(const v4u*)(vm + ro); rv[1] = *(const v4u*)(vm + ro + 8); }
        __syncthreads();
    }
#undef ML_STAGE
#undef hoff
}
__device__ __forceinline__ void p3_mlstm(const Args& a, Frame& F) {
    bool any = false;
    for (int item = F.bx; item < NB * MH * 2; item += F.G) { mlstm_item<0>(a, F, item); any = true;
        __syncthreads();
        if (F.tid == 0) __hip_atomic_fetch_add((gu32*)(a.ws + WS_CTL) + CW_MDONE, 1u, RLX_AGENT); }
    if (any && F.G == 256) cvt_run(a, F, CW_MDONE, (unsigned)(NB * MH * 2), CW_ADONE, (unsigned)NATT);
    __syncthreads();
}
typedef float f32x16 __attribute__((ext_vector_type(16)));
__device__ __forceinline__ unsigned cvtpk(float lo, float hi) { unsigned r; asm volatile("v_cvt_pk_bf16_f32 %0, %1, %2" : "=v"(r) : "v"(lo), "v"(hi)); return r; }
#ifndef ATT_VAR
#define ATT_VAR 0
#endif
__device__ __forceinline__ size_t op_row(int br, int b, int hh, int s) { const int dsh = 2 * br; return ((size_t)((br * NB + b) * AH + hh) * SEQ) + (size_t)(((s & ((1 << dsh) - 1)) << (11 - dsh)) + (s >> dsh)); }
static_assert(SEQ == 2048, "op_row assumes SEQ = 2^11");
template <int VAR>
__device__ __forceinline__ void attn_task(const bf16* __restrict__ Qa, const bf16* __restrict__ Ka, const bf16* __restrict__ Va, bf16* __restrict__ opart, float* __restrict__ ostat,
                                          int task, LAS unsigned char* vl  , int lane) {
    const int bh = task / 192, rem = task % 192, br = rem >> 6, tt = rem & 63;
    const int dsh = 2 * br, dil = 1 << dsh;
    const int Lb = 64 >> dsh;
    const int r = tt / Lb, gq = tt % Lb;
    const int r32 = lane & 31, h = lane >> 5;
    const size_t base = (size_t)bh * SEQ * ADH;
    const int qtok = r + dil * (32 * gq + r32);
    bf16x8 qf[4];
#pragma unroll
    for (int sx = 0; sx < 4; ++sx) qf[sx] = *(const bf16x8*)(Qa + base + (size_t)qtok * ADH + 16 * sx + 8 * h);
    f32x16 sacc[5]; v4u vreg[5][4]; bool valid[5];
#pragma unroll
    for (int kb = 0; kb < 5; ++kb) {
        const int jb = gq - 2 + kb; valid[kb] = (jb >= 0 && jb < Lb);
#pragma unroll
        for (int i = 0; i < 16; ++i) sacc[kb][i] = 0.f;
        if (valid[kb]) {
            const int ktok = r + dil * (32 * jb + r32);
            bf16x8 kf[4];
#pragma unroll
            for (int sx = 0; sx < 4; ++sx) kf[sx] = *(const bf16x8*)(Ka + base + (size_t)ktok * ADH + 16 * sx + 8 * h);
#pragma unroll
            for (int i = 0; i < 4; ++i) { const int vtok = r + dil * (32 * jb + 8 * i + (lane >> 3)); if constexpr (!(VAR & 1)) vreg[kb][i] = *(const v4u*)(Va + base + (size_t)vtok * ADH + 8 * (lane & 7)); else vreg[kb][i] = (v4u){0u, 0u, 0u, 0u}; }
#pragma unroll
            for (int sx = 0; sx < 4; ++sx) sacc[kb] = __builtin_amdgcn_mfma_f32_32x32x16_bf16(kf[sx], qf[sx], sacc[kb], 0, 0, 0);
        }
    }
    float m = -INFINITY;
#pragma unroll
    for (int kb = 0; kb < 5; ++kb) if (valid[kb]) {
#pragma unroll
        for (int rg = 0; rg < 16; ++rg) {
            const int kk = (rg & 3) + 8 * (rg >> 2) + 4 * h;
            float sv = sacc[kb][rg];
            if (kb == 0) sv = (kk >= r32) ? sv : -INFINITY;
            if (kb == 4) sv = (kk <= r32) ? sv : -INFINITY;
            sacc[kb][rg] = sv; m = fmaxf(m, sv);
        }
    }
    m = fmaxf(m, __shfl_xor(m, 32));
    float l = 0.f; const float mb = m * 1.4426950408889634f;
    bf16x8 pf[5][2];
#pragma unroll
    for (int kb = 0; kb < 5; ++kb) if (valid[kb]) {
        float p[16];
#pragma unroll
        for (int rg = 0; rg < 16; ++rg) { if constexpr (VAR & 2) p[rg] = sacc[kb][rg] * 1.4426950408889634f - mb; else p[rg] = __builtin_amdgcn_exp2f(sacc[kb][rg] * 1.4426950408889634f - mb); l += p[rg]; }
#pragma unroll
        for (int sp = 0; sp < 2; ++sp) { v4u w; w.x = cvtpk(p[8 * sp], p[8 * sp + 1]); w.y = cvtpk(p[8 * sp + 2], p[8 * sp + 3]); w.z = cvtpk(p[8 * sp + 4], p[8 * sp + 5]); w.w = cvtpk(p[8 * sp + 6], p[8 * sp + 7]); pf[kb][sp] = __builtin_bit_cast(bf16x8, w); }
    }
    l += __shfl_xor(l, 32);
    f32x16 o0, o1;
#pragma unroll
    for (int i = 0; i < 16; ++i) { o0[i] = 0.f; o1[i] = 0.f; }
    const int row0 = lane >> 3, ch16 = lane & 7;
    const int woff = row0 * 128 + (((ch16 >> 1) ^ (((row0 >> 1) & 1) << 1)) * 32) + (ch16 & 1) * 16;
    const int q4 = (lane & 15) >> 2, sw = (q4 >> 1) & 1, dhalf = (lane >> 4) & 1;
    const int rb = (4 * h + q4) * 128 + dhalf * 32 + (lane & 3) * 8;
    const int rb0 = rb + (sw ? 64 : 0), rb1 = rb + (sw ? 0 : 64);
#pragma unroll
    for (int kb = 0; kb < 5; ++kb) if (valid[kb] && !(VAR & 1)) {
#pragma unroll
        for (int i = 0; i < 4; ++i) *(LAS v4u*)(vl + woff + 1024 * i) = vreg[kb][i];
#pragma unroll
        for (int sp = 0; sp < 2; ++sp) {
            const s16x4 a00 = __builtin_bit_cast(s16x4, __builtin_amdgcn_ds_read_tr16_b64_v4i16((LAS v4i16_t*)(vl + rb0 + (16 * sp) * 128)));
            const s16x4 a01 = __builtin_bit_cast(s16x4, __builtin_amdgcn_ds_read_tr16_b64_v4i16((LAS v4i16_t*)(vl + rb0 + (16 * sp + 8) * 128)));
            const s16x4 a10 = __builtin_bit_cast(s16x4, __builtin_amdgcn_ds_read_tr16_b64_v4i16((LAS v4i16_t*)(vl + rb1 + (16 * sp) * 128)));
            const s16x4 a11 = __builtin_bit_cast(s16x4, __builtin_amdgcn_ds_read_tr16_b64_v4i16((LAS v4i16_t*)(vl + rb1 + (16 * sp + 8) * 128)));
            const bf16x8 A0 = {a00[0], a00[1], a00[2], a00[3], a01[0], a01[1], a01[2], a01[3]};
            const bf16x8 A1 = {a10[0], a10[1], a10[2], a10[3], a11[0], a11[1], a11[2], a11[3]};
            o0 = __builtin_amdgcn_mfma_f32_32x32x16_bf16(A0, pf[kb][sp], o0, 0, 0, 0);
            o1 = __builtin_amdgcn_mfma_f32_32x32x16_bf16(A1, pf[kb][sp], o1, 0, 0, 0);
        }
        asm volatile("s_waitcnt lgkmcnt(0)" ::: "memory");
    }
    if constexpr (VAR & 1) { asm volatile("" :: "v"(pf[0][0]), "v"(pf[1][1]), "v"(pf[2][0]), "v"(pf[3][1]), "v"(pf[4][0])); }
    if constexpr (VAR & 4) { asm volatile("" :: "v"(o0), "v"(o1), "v"(l), "v"(m)); return; }
    const float inv = 1.f / l;
    const int b = bh / AH, hh = bh % AH;
    const size_t tok = (size_t)b * SEQ + qtok;
    {
        LAS unsigned char* ol = vl + r32 * 72 + 4 * h; const float i16 = inv * 16.f;
#pragma unroll
        for (int g4 = 0; g4 < 4; ++g4) {
            int wa = 0, wb = 0;
            wa = __builtin_amdgcn_cvt_pk_fp8_f32(o0[4 * g4] * i16, o0[4 * g4 + 1] * i16, wa, false); wa = __builtin_amdgcn_cvt_pk_fp8_f32(o0[4 * g4 + 2] * i16, o0[4 * g4 + 3] * i16, wa, true);
            wb = __builtin_amdgcn_cvt_pk_fp8_f32(o1[4 * g4] * i16, o1[4 * g4 + 1] * i16, wb, false); wb = __builtin_amdgcn_cvt_pk_fp8_f32(o1[4 * g4 + 2] * i16, o1[4 * g4 + 3] * i16, wb, true);
            *(LAS unsigned*)(ol + 8 * g4) = (unsigned)wa; *(LAS unsigned*)(ol + 32 + 8 * g4) = (unsigned)wb;
        }
        const int qrow = lane >> 1, half = lane & 1;
        const int qtok2 = r + dil * (32 * gq + qrow);
        unsigned char* op = (unsigned char*)opart + op_row(br, b, hh, qtok2) * 64 + 32 * half;
        { const LAS unsigned long long* ip = (const LAS unsigned long long*)(vl + qrow * 72 + 32 * half); const unsigned long long x0 = ip[0], x1 = ip[1], x2 = ip[2], x3 = ip[3];
          *(v4u*)op = (v4u){(unsigned)x0, (unsigned)(x0 >> 32), (unsigned)x1, (unsigned)(x1 >> 32)}; *(v4u*)(op + 16) = (v4u){(unsigned)x2, (unsigned)(x2 >> 32), (unsigned)x3, (unsigned)(x3 >> 32)}; }
        asm volatile("s_waitcnt lgkmcnt(0)" ::: "memory");
    }
    if (h == 0) { float* st = ostat + op_row(br, b, hh, qtok) * 2; st[0] = m; st[1] = l; }
}
constexpr int AT_K = 0, AT_V = 49152, AT_O = 98304, AT_OSZ = 4608;
static_assert(AT_O + 8 * AT_OSZ <= RING_BYTES, "attention LDS map");
struct AtGeo { int bh, br, dsh, Lb, jbs, nblk, resb, gq0, jsh, jmk; };
__device__ __forceinline__ AtGeo at_geo(int it) {
    AtGeo g; g.bh = it / 24; const int rem = it % 24; g.br = rem >> 3; const int sub = rem & 7; g.dsh = 2 * g.br; g.Lb = 64 >> g.dsh;
    g.gq0 = (g.br == 0) ? 8 * sub : (g.br == 1 ? 8 * (sub & 1) : 0);
    g.resb = (g.br == 0) ? 0 : (g.br == 1 ? (sub >> 1) : 2 * sub);
    g.jsh = (g.br == 2) ? 2 : 4; g.jmk = (g.br == 2) ? 3 : 15;
    const int lo = g.gq0 - 2 < 0 ? 0 : g.gq0 - 2, hi = g.gq0 + 10 > g.Lb ? g.Lb : g.gq0 + 10;
    g.jbs = (g.br == 2) ? 0 : lo; g.nblk = (g.br == 2) ? 8 : hi - lo;
    return g;
}
__device__ __forceinline__ void at_load_q(const AtGeo& g, const bf16* __restrict__ Qa, int w, int lane, bf16x8 (&qf)[4]) {
    const int r32 = lane & 31, h = lane >> 5;
    const int qtok = g.resb + (w >> g.jsh) + ((32 * (g.gq0 + (w & g.jmk)) + r32) << g.dsh);
    const bf16* qp = Qa + (size_t)g.bh * SEQ * ADH + (size_t)qtok * ADH + 8 * h;
#pragma unroll
    for (int sx = 0; sx < 4; ++sx) qf[sx] = *(const bf16x8*)(qp + 16 * sx);
}
__device__ __forceinline__ void at_load_kv(const AtGeo& g, const bf16* __restrict__ Ka, const bf16* __restrict__ Va, int tid, v4u (&kr)[6], v4u (&vr)[6]) {
    const size_t base = (size_t)g.bh * SEQ * ADH;
    const int rrow = tid >> 3, ch = tid & 7, last = 32 * g.nblk - 1;
#pragma unroll
    for (int i = 0; i < 6; ++i) { int row = rrow + 64 * i; row = row > last ? last : row;
        const int sl = row >> 5;
        const int tok = g.resb + (sl >> g.jsh) + ((32 * (g.jbs + (sl & g.jmk)) + (row & 31)) << g.dsh);
        const size_t off = base + (size_t)tok * ADH + 8 * ch; kr[i] = *(const v4u*)(Ka + off); vr[i] = *(const v4u*)(Va + off); }
}
__device__ __forceinline__ void at_stage(LAS unsigned char* L, int tid, const v4u (&kr)[6], const v4u (&vr)[6]) {
    const int rrow = tid >> 3, ch = tid & 7, r32 = rrow & 31;
    LAS unsigned char* kp = L + AT_K + rrow * 128 + ((ch ^ ((rrow >> 1) & 7)) << 4);
    LAS unsigned char* vp = L + AT_V + (rrow >> 5) * 4096 + r32 * 128 + (((ch >> 1) ^ (((r32 >> 1) & 1) << 1)) * 32) + (ch & 1) * 16;
#pragma unroll
    for (int i = 0; i < 6; ++i) { *(LAS v4u*)(kp + 8192 * i) = kr[i]; *(LAS v4u*)(vp + 8192 * i) = vr[i]; }
}
__device__ __forceinline__ void at_compute(const AtGeo& g, const AtGeo& gn, const bf16* __restrict__ Qa, LAS unsigned char* L, bf16x8 (&qf)[4], bf16* __restrict__ opart, float* __restrict__ ostat, int w, int lane) {
    const int r32 = lane & 31, h = lane >> 5;
    const int res = g.resb + (w >> g.jsh), gq = g.gq0 + (w & g.jmk);
    f32x16 sacc[5]; bool valid[5]; int slot[5];
#pragma unroll
    for (int kb = 0; kb < 5; ++kb) {
        const int jb = gq - 2 + kb; valid[kb] = (jb >= 0 && jb < g.Lb);
        const int jbc = jb < 0 ? 0 : (jb >= g.Lb ? g.Lb - 1 : jb);
        slot[kb] = ((w >> g.jsh) << 2) + jbc - g.jbs;
#pragma unroll
        for (int i = 0; i < 16; ++i) sacc[kb][i] = 0.f;
        const LAS unsigned char* kp = L + AT_K + slot[kb] * 4096 + r32 * 128;
#pragma unroll
        for (int sx = 0; sx < 4; ++sx) { const bf16x8 kf = *(const LAS bf16x8*)(kp + (((2 * sx + h) ^ ((r32 >> 1) & 7)) << 4)); sacc[kb] = __builtin_amdgcn_mfma_f32_32x32x16_bf16(kf, qf[sx], sacc[kb], 0, 0, 0); }
    }
    __builtin_amdgcn_sched_barrier(0);
    at_load_q(gn, Qa, w, lane, qf);
    __builtin_amdgcn_sched_barrier(0);
    float m = -INFINITY;
#pragma unroll
    for (int kb = 0; kb < 5; ++kb) {
#pragma unroll
        for (int rg = 0; rg < 16; ++rg) {
            const int kk = (rg & 3) + 8 * (rg >> 2) + 4 * h;
            float sv = valid[kb] ? sacc[kb][rg] : -INFINITY;
            if (kb == 0) sv = (kk >= r32) ? sv : -INFINITY;
            if (kb == 4) sv = (kk <= r32) ? sv : -INFINITY;
            sacc[kb][rg] = sv; m = fmaxf(m, sv);
        }
    }
    m = fmaxf(m, __shfl_xor(m, 32));
    float l = 0.f; const float mb = m * 1.4426950408889634f;
    bf16x8 pf[5][2];
#pragma unroll
    for (int kb = 0; kb < 5; ++kb) {
        float p[16];
#pragma unroll
        for (int rg = 0; rg < 16; ++rg) { p[rg] = __builtin_amdgcn_exp2f(sacc[kb][rg] * 1.4426950408889634f - mb); l += p[rg]; }
#pragma unroll
        for (int sp = 0; sp < 2; ++sp) { v4u wv; wv.x = cvtpk(p[8 * sp], p[8 * sp + 1]); wv.y = cvtpk(p[8 * sp + 2], p[8 * sp + 3]); wv.z = cvtpk(p[8 * sp + 4], p[8 * sp + 5]); wv.w = cvtpk(p[8 * sp + 6], p[8 * sp + 7]); pf[kb][sp] = __builtin_bit_cast(bf16x8, wv); }
    }
    l += __shfl_xor(l, 32);
    f32x16 o0, o1;
#pragma unroll
    for (int i = 0; i < 16; ++i) { o0[i] = 0.f; o1[i] = 0.f; }
    int lane2 = lane; asm volatile("" : "+v"(lane2));
    const int q4 = (lane2 & 15) >> 2, sw = (q4 >> 1) & 1, dhalf = (lane2 >> 4) & 1;
    const int rb = (4 * (lane2 >> 5) + q4) * 128 + dhalf * 32 + (lane2 & 3) * 8;
    const int rb0 = rb + (sw ? 64 : 0), rb1 = rb + (sw ? 0 : 64);
#pragma unroll
    for (int kb = 0; kb < 5; ++kb) {
        LAS unsigned char* vb = L + AT_V + slot[kb] * 4096;
#pragma unroll
        for (int sp = 0; sp < 2; ++sp) {
            const s16x4 a00 = __builtin_bit_cast(s16x4, __builtin_amdgcn_ds_read_tr16_b64_v4i16((LAS v4i16_t*)(vb + rb0 + (16 * sp) * 128)));
            const s16x4 a01 = __builtin_bit_cast(s16x4, __builtin_amdgcn_ds_read_tr16_b64_v4i16((LAS v4i16_t*)(vb + rb0 + (16 * sp + 8) * 128)));
            const s16x4 a10 = __builtin_bit_cast(s16x4, __builtin_amdgcn_ds_read_tr16_b64_v4i16((LAS v4i16_t*)(vb + rb1 + (16 * sp) * 128)));
            const s16x4 a11 = __builtin_bit_cast(s16x4, __builtin_amdgcn_ds_read_tr16_b64_v4i16((LAS v4i16_t*)(vb + rb1 + (16 * sp + 8) * 128)));
            const bf16x8 A0 = {a00[0], a00[1], a00[2], a00[3], a01[0], a01[1], a01[2], a01[3]};
            const bf16x8 A1 = {a10[0], a10[1], a10[2], a10[3], a11[0], a11[1], a11[2], a11[3]};
            o0 = __builtin_amdgcn_mfma_f32_32x32x16_bf16(A0, pf[kb][sp], o0, 0, 0, 0);
            o1 = __builtin_amdgcn_mfma_f32_32x32x16_bf16(A1, pf[kb][sp], o1, 0, 0, 0);
        }
    }
    const float inv = 1.f / l;
    const int b = g.bh / AH, hh = g.bh % AH;
    LAS unsigned char* vl = L + AT_O + w * AT_OSZ;
    {
        LAS unsigned char* ol = vl + r32 * 72 + 4 * h; const float i16 = inv * 16.f;
#pragma unroll
        for (int g4 = 0; g4 < 4; ++g4) {
            int wa = 0, wb = 0;
            wa = __builtin_amdgcn_cvt_pk_fp8_f32(o0[4 * g4] * i16, o0[4 * g4 + 1] * i16, wa, false); wa = __builtin_amdgcn_cvt_pk_fp8_f32(o0[4 * g4 + 2] * i16, o0[4 * g4 + 3] * i16, wa, true);
            wb = __builtin_amdgcn_cvt_pk_fp8_f32(o1[4 * g4] * i16, o1[4 * g4 + 1] * i16, wb, false); wb = __builtin_amdgcn_cvt_pk_fp8_f32(o1[4 * g4 + 2] * i16, o1[4 * g4 + 3] * i16, wb, true);
            *(LAS unsigned*)(ol + 8 * g4) = (unsigned)wa; *(LAS unsigned*)(ol + 32 + 8 * g4) = (unsigned)wb;
        }
        const int qrow = lane >> 1, half = lane & 1;
        const int qtok2 = res + ((32 * gq + qrow) << g.dsh);
        unsigned char* op = (unsigned char*)opart + op_row(g.br, b, hh, qtok2) * 64 + 32 * half;
        { const LAS unsigned long long* ip = (const LAS unsigned long long*)(vl + qrow * 72 + 32 * half); const unsigned long long x0 = ip[0], x1 = ip[1], x2 = ip[2], x3 = ip[3];
          *(v4u*)op = (v4u){(unsigned)x0, (unsigned)(x0 >> 32), (unsigned)x1, (unsigned)(x1 >> 32)}; *(v4u*)(op + 16) = (v4u){(unsigned)x2, (unsigned)(x2 >> 32), (unsigned)x3, (unsigned)(x3 >> 32)}; }
    }
    if (h == 0) { float* st = ostat + op_row(g.br, b, hh, res + ((32 * gq + r32) << g.dsh)) * 2; st[0] = m; st[1] = l; }
}
__device__ __forceinline__ void p3_attn_coop(const Args& a, Frame& F, int abx, int aG) {
    const bf16* qr = (const bf16*)(a.ws + WS_QR); const bf16* kr = (const bf16*)(a.ws + WS_KR); const bf16* vr = (const bf16*)(a.ws + WS_VR);
    bf16* opart = (bf16*)(a.ws + WS_OPART); float* ostat = (float*)(a.ws + WS_OSTAT);
    LAS unsigned char* L = F.lds + RING_OFF;
    constexpr int NITEM = NB * AH * 24;
    v4u kreg[6], vreg[6]; bf16x8 qf[4];
    int it = abx;
    if (it >= NITEM) return;
    AtGeo g = at_geo(it);
    at_load_q(g, qr, F.wave, F.lane, qf);
    at_load_kv(g, kr, vr, F.tid, kreg, vreg);
    __syncthreads();
    for (;;) {
        int tid = F.tid; asm volatile("" : "+v"(tid));
        at_stage(L, tid, kreg, vreg);
        __syncthreads();
        const int itn = it + aG; const bool more = itn < NITEM;
        const AtGeo gn = at_geo(more ? itn : it);
        at_load_kv(gn, kr, vr, tid, kreg, vreg);
        __builtin_amdgcn_sched_barrier(0);
        at_compute(g, gn, qr, L, qf, opart, ostat, F.wave, tid & 63);
        __syncthreads();
        if (!more) break;
        it = itn; g = gn;
    }
}
template <int VAR>
__device__ __forceinline__ void p3_attn_var(const Args& a, Frame& F) {
    const bf16* qr = (const bf16*)(a.ws + WS_QR); const bf16* kr = (const bf16*)(a.ws + WS_KR); const bf16* vr = (const bf16*)(a.ws + WS_VR);
    bf16* opart = (bf16*)(a.ws + WS_OPART); float* ostat = (float*)(a.ws + WS_OSTAT);
    LAS unsigned char* vl = F.lds + RING_OFF + F.wave * 8192;
    const int abx = (F.G == 256) ? F.bx - 64 : F.bx, aG = (F.G == 256) ? 192 : F.G;
    if (abx < 0) return;
    for (int task = abx * NWAVES + F.wave; task < NB * AH * 192; task += aG * NWAVES) attn_task<VAR>(qr, kr, vr, opart, ostat, task, vl, F.lane);
}
__device__ __forceinline__ void p3_attn(const Args& a, Frame& F) {
    const bf16* qr = (const bf16*)(a.ws + WS_QR); const bf16* kr = (const bf16*)(a.ws + WS_KR); const bf16* vr = (const bf16*)(a.ws + WS_VR);
    bf16* opart = (bf16*)(a.ws + WS_OPART); float* ostat = (float*)(a.ws + WS_OSTAT);
    LAS unsigned char* vl = F.lds + RING_OFF + F.wave * 8192;
    const int abx = (F.G == 256) ? F.bx - 64 : F.bx, aG = (F.G == 256) ? NATT : F.G;
    if (abx < 0) return;
    if (F.G == 256) { if (abx < NATT) { p3_attn_coop(a, F, abx, aG); __syncthreads(); if (F.tid == 0) __hip_atomic_fetch_add((gu32*)(a.ws + WS_CTL) + CW_ADONE, 1u, RLX_AGENT); } }
    else for (int task = abx * NWAVES + F.wave; task < NB * AH * 192; task += aG * NWAVES) attn_task<0>(qr, kr, vr, opart, ostat, task, vl, F.lane);
    if (F.G == 256) cvt_run(a, F, CW_MDONE, (unsigned)(NB * MH * 2), CW_ADONE, (unsigned)NATT);
}
__device__ __forceinline__ float fp8at(unsigned long long v, int i) {
    const int wd = (int)(unsigned)(v >> (32 * (i >> 2)));
    const auto pr = ((i >> 1) & 1) ? __builtin_amdgcn_cvt_pk_f32_fp8(wd, true) : __builtin_amdgcn_cvt_pk_f32_fp8(wd, false);
    return pr[i & 1];
}
struct MixIn { v4u fp, bp; v4u xcp, zp; unsigned long long op[3]; float mm[3], ll[3]; };
__device__ __forceinline__ MixIn mix_load(const bf16* hfb, const bf16* xc, const bf16* proj, const bf16* opart, const float* ostat, int t, int c0, int hh) {
    MixIn r;
    r.fp = __builtin_nontemporal_load((const GAS v4u*)(hfb + (size_t)t * DML + c0)); r.bp = __builtin_nontemporal_load((const GAS v4u*)(hfb + ((size_t)NT + t) * DML + c0));
    r.xcp = __builtin_nontemporal_load((const GAS v4u*)(xc + (size_t)t * DML + c0)); r.zp = __builtin_nontemporal_load((const GAS v4u*)(proj + (size_t)t * PROJ_LD + 512 + c0));
#pragma unroll
    for (int br = 0; br < 3; ++br) { const size_t row = op_row(br, t >> 11, hh, t & (SEQ - 1)); r.op[br] = *(const unsigned long long*)((const unsigned char*)opart + row * 64 + (c0 & 63)); const float* st = ostat + row * 2; r.mm[br] = st[0]; r.ll[br] = st[1]; }
    return r;
}
__device__ __forceinline__ void p4_mix(const Args& a, Frame& F) {
    const bf16* hfb = (const bf16*)(a.ws + WS_HFB); const bf16* xc = (const bf16*)(a.ws + WS_XC); const bf16* proj = (const bf16*)(a.ws + WS_PROJ);
    const bf16* opart = (const bf16*)(a.ws + WS_OPART); const float* ostat = (const float*)(a.ws + WS_OSTAT);
    const float* mnorm_g = a.in[12]; const float* mskip = a.in[13]; const float* anorm_g = a.in[14];
    bf16* mixed = (bf16*)(a.ws + WS_MIXED);
    const int lane = F.lane, c0 = 8 * lane, hh = lane >> 3;
    float mg[8], sk[8], ag[8];
#pragma unroll
    for (int i = 0; i < 8; ++i) { mg[i] = mnorm_g[c0 + i]; sk[i] = mskip[c0 + i]; ag[i] = anorm_g[c0 + i]; }
    const int tstep = F.G * NWAVES;
    MixIn cur = mix_load(hfb, xc, proj, opart, ostat, F.bx * NWAVES + F.wave, c0, hh);
    for (int t = F.bx * NWAVES + F.wave; t < NT; t += tstep) {
        const MixIn in = cur;
        if (t + tstep < NT) cur = mix_load(hfb, xc, proj, opart, ostat, t + tstep, c0, hh);
        const v4u fp = in.fp, bp = in.bp; const v4u xcp = in.xcp, zp = in.zp;
        unsigned long long op[3]; float mm[3], ll[3];
#pragma unroll
        for (int br = 0; br < 3; ++br) { op[br] = in.op[br]; mm[br] = in.mm[br]; ll[br] = in.ll[br]; }
        float hs[8];
#pragma unroll
        for (int i = 0; i < 4; ++i) { hs[2 * i] = bflo(fp[i]) + bflo(bp[i]); hs[2 * i + 1] = bfhi(fp[i]) + bfhi(bp[i]); }
        float ss = 0.f;
#pragma unroll
        for (int i = 0; i < 8; ++i) ss += hs[i] * hs[i];
        ss += __shfl_xor(ss, 1); ss += __shfl_xor(ss, 2); ss += __shfl_xor(ss, 4); ss += __shfl_xor(ss, 8);
        const float rn = rsqrtf(ss * (1.f / MDH) + EPS);
        float ym[8];
#pragma unroll
        for (int i = 0; i < 8; ++i) {
            const float xcv = (i & 1) ? bfhi(xcp[i >> 1]) : bflo(xcp[i >> 1]), z = (i & 1) ? bfhi(zp[i >> 1]) : bflo(zp[i >> 1]);
            ym[i] = (hs[i] * rn * mg[i] + sk[i] * xcv) * (z / (1.f + __expf(-z)));
        }
        *(v4u*)(mixed + (size_t)t * DMODEL + c0) = (v4u){pk2(ym[0], ym[1]), pk2(ym[2], ym[3]), pk2(ym[4], ym[5]), pk2(ym[6], ym[7])};
        const float M = fmaxf(mm[0], fmaxf(mm[1], mm[2]));
        const float w0 = __expf(mm[0] - M) * ll[0], w1 = __expf(mm[1] - M) * ll[1], w2 = __expf(mm[2] - M) * ll[2];
        const float rden = 1.f / (w0 + w1 + w2);
        float av[8]; float s2 = 0.f;
#pragma unroll
        for (int i = 0; i < 8; ++i) {
            const float o0 = fp8at(op[0], i), o1 = fp8at(op[1], i), o2 = fp8at(op[2], i);
            av[i] = (w0 * o0 + w1 * o1 + w2 * o2) * (rden * 0.0625f); s2 += av[i] * av[i];
        }
        s2 = wave_sum(s2);
        const float ra = rsqrtf(s2 * (1.f / DAT) + EPS);
        *(v4u*)(mixed + (size_t)t * DMODEL + 512 + c0) = (v4u){pk2(av[0] * ra * ag[0], av[1] * ra * ag[1]), pk2(av[2] * ra * ag[2], av[3] * ra * ag[3]), pk2(av[4] * ra * ag[4], av[5] * ra * ag[5]), pk2(av[6] * ra * ag[6], av[7] * ra * ag[7])};
    }
}
constexpr int RT_STR = 1040;
constexpr int RT_W = 0, RT_G2 = 16 * RT_STR * 4, RT_P = RT_G2 + 4096, RT_SS = RT_P + 8 * 256 * 4;
constexpr int RT_IG1 = RT_SS + 8 * 16 * 4;
static_assert(RT_IG1 + 4096 <= RING_BYTES, "router LDS map");
__device__ __forceinline__ void p6_router(const Args& a, Frame& F) {
    const bf16* xn = (const bf16*)(a.ws + WS_XN); const float* xr = (const float*)(a.ws + WS_XR); const float* g1 = a.in[1];
    const bf16* yo = (const bf16*)(a.ws + WS_YO); const float* g2 = a.in[16]; const float* wr = a.in[17];
    unsigned char* h2 = a.ws + WS_H2; float* aff = (float*)(a.ws + WS_AFF); int* slot = (int*)(a.ws + WS_SLOT);
    LAS unsigned char* L = F.lds + RING_OFF;
    LAS float* Wl = (LAS float*)(L + RT_W); LAS float* g2l = (LAS float*)(L + RT_G2); LAS float* Pb = (LAS float*)(L + RT_P); LAS float* SSb = (LAS float*)(L + RT_SS); LAS float* ig1l = (LAS float*)(L + RT_IG1);
    int tid_ = F.tid; asm volatile("" : "+v"(tid_));
    const int tid = tid_, lane = F.lane, w = F.wave, c16 = lane & 15, g = lane >> 4;
    __syncthreads();
    { f32x4 wv8[8]; float gk8[8];
#pragma unroll
      for (int i = 0; i < 8; ++i) { const int idx = tid + NTHR * i; wv8[i] = ((const GAS f32x4*)wr)[idx]; gk8[i] = g2[idx >> 2]; }
#pragma unroll
      for (int i = 0; i < 8; ++i) { const int idx = tid + NTHR * i, k = idx >> 2, e0 = (idx & 3) * 4;
#pragma unroll
          for (int j = 0; j < 4; ++j) Wl[(e0 + j) * RT_STR + k] = wv8[i][j] * gk8[i]; }
      g2l[2 * tid] = g2[2 * tid]; g2l[2 * tid + 1] = g2[2 * tid + 1]; ig1l[2 * tid] = 1.f / g1[2 * tid]; ig1l[2 * tid + 1] = 1.f / g1[2 * tid + 1]; }
    __syncthreads();
    const int tl = w >> 1, kh = w & 1;
    for (int t64 = F.bx; t64 < NT / 64; t64 += F.G) {
        const int r0 = t64 * 64 + 16 * tl;
        const bf16* xp = xn + (size_t)(r0 + c16) * DMODEL + 512 * kh + 4 * g;
        const bf16* yp = yo + (size_t)(r0 + c16) * DMODEL + 512 * kh + 4 * g;
        const float sr = xr[r0 + c16];
        f32x4 xa[32]; unsigned long long xv[32];
#pragma unroll
        for (int sx = 0; sx < 32; ++sx) xv[sx] = *(const unsigned long long*)(xp + 16 * sx);
#pragma unroll
        for (int blk = 0; blk < 4; ++blk) {
            unsigned long long yv[8];
#pragma unroll
            for (int i = 0; i < 8; ++i) yv[i] = *(const unsigned long long*)(yp + 16 * (8 * blk + i));
#pragma unroll
            for (int i = 0; i < 8; ++i) { const unsigned lo = (unsigned)yv[i], hi = (unsigned)(yv[i] >> 32); const unsigned xl = (unsigned)xv[8 * blk + i], xh = (unsigned)(xv[8 * blk + i] >> 32);
                const f32x4 ig = *(const LAS f32x4*)(ig1l + 512 * kh + 16 * (8 * blk + i) + 4 * g) * sr;
                xa[8 * blk + i] = (f32x4){__uint_as_float(xl << 16), __uint_as_float(xl & 0xffff0000u), __uint_as_float(xh << 16), __uint_as_float(xh & 0xffff0000u)} * ig
                                + (f32x4){__uint_as_float(lo << 16), __uint_as_float(lo & 0xffff0000u), __uint_as_float(hi << 16), __uint_as_float(hi & 0xffff0000u)}; }
            __builtin_amdgcn_sched_barrier(0);
        }
        float ss = 0.f; f32x4 D = {0.f, 0.f, 0.f, 0.f};
        const LAS float* wrow = Wl + c16 * RT_STR + 512 * kh + 4 * g;
#pragma unroll
        for (int sx = 0; sx < 32; ++sx) {
            const f32x4 wb = *(const LAS f32x4*)(wrow + 16 * sx);
#pragma unroll
            for (int i = 0; i < 4; ++i) { D = __builtin_amdgcn_mfma_f32_16x16x4f32(xa[sx][i], wb[i], D, 0, 0, 0); ss += xa[sx][i] * xa[sx][i]; }
        }
        ss += __shfl_xor(ss, 16); ss += __shfl_xor(ss, 32);
#pragma unroll
        for (int r = 0; r < 4; ++r) Pb[w * 256 + (4 * g + r) * 16 + c16] = D[r];
        if (g == 0) SSb[w * 16 + c16] = ss;
        __syncthreads();
        const int w0 = w & ~1;
        const float rt = rsqrtf((SSb[w0 * 16 + c16] + SSb[(w0 + 1) * 16 + c16]) * (1.f / DMODEL) + EPS);
        unsigned char* hp = h2 + (size_t)(r0 + c16) * DMODEL + 512 * kh + 4 * g;
#pragma unroll
        for (int sx = 0; sx < 32; ++sx) { const f32x4 g4 = *(const LAS f32x4*)(g2l + 512 * kh + 16 * sx + 4 * g); const f32x4 y = xa[sx] * g4 * rt;
            int w8 = 0; w8 = __builtin_amdgcn_cvt_pk_fp8_f32(y.x, y.y, w8, false); w8 = __builtin_amdgcn_cvt_pk_fp8_f32(y.z, y.w, w8, true);
            *(int*)(hp + 16 * sx) = w8; }
        if (kh == 0) {
#pragma unroll
            for (int r = 0; r < 4; ++r) {
                const int tk = 4 * g + r;
                const float rr = rsqrtf((SSb[w0 * 16 + tk] + SSb[(w0 + 1) * 16 + tk]) * (1.f / DMODEL) + EPS);
                const float z = (Pb[w0 * 256 + tk * 16 + c16] + Pb[(w0 + 1) * 256 + tk * 16 + c16]) * rr;
                float mx = z;
                mx = fmaxf(mx, __shfl_xor(mx, 1)); mx = fmaxf(mx, __shfl_xor(mx, 2)); mx = fmaxf(mx, __shfl_xor(mx, 4)); mx = fmaxf(mx, __shfl_xor(mx, 8));
                const float ex = expf(z - mx);
                float den = ex;
                den += __shfl_xor(den, 1); den += __shfl_xor(den, 2); den += __shfl_xor(den, 4); den += __shfl_xor(den, 8);
                aff[(size_t)(r0 + tk) * NE + c16] = ex / den;
                slot[(size_t)(r0 + tk) * NE + c16] = -1;
            }
        }
        __syncthreads();
    }
}
__device__ __forceinline__ void p7_topk(const Args& a, Frame& F) {
    LAS unsigned* hist = (LAS unsigned*)(F.lds + RING_OFF);
    LAS unsigned* wsum = hist + 256;
    LAS unsigned* bc = hist + 272;
    const float* aff = (const float*)(a.ws + WS_AFF); int* slot = (int*)(a.ws + WS_SLOT); int* sel_tok = (int*)(a.ws + WS_SELT); float* sel_gate = (float*)(a.ws + WS_SELG);
    const int tid = F.tid, lane = F.lane, w = F.wave;
    for (int be = F.bx; be < NB * NE; be += F.G) {
        const int b = be / NE, e = be % NE;
        unsigned key[4];
#pragma unroll
        for (int j = 0; j < 4; ++j) key[j] = __float_as_uint(aff[(size_t)(b * SEQ + 4 * tid + j) * NE + e]);
        unsigned prefix = 0u, mask = 0u, need = CAP;
#pragma unroll
        for (int pass = 0; pass < 4; ++pass) {
            const int shift = 24 - 8 * pass;
            __syncthreads();
            if (tid < 256) hist[tid] = 0u;
            __syncthreads();
#pragma unroll
            for (int j = 0; j < 4; ++j) if ((key[j] & mask) == prefix) __hip_atomic_fetch_add(&hist[(key[j] >> shift) & 255u], 1u, __ATOMIC_RELAXED, __HIP_MEMORY_SCOPE_WORKGROUP);
            __syncthreads();
            if (w == 0) {
                const unsigned c0 = hist[4 * lane], c1 = hist[4 * lane + 1], c2 = hist[4 * lane + 2], c3 = hist[4 * lane + 3];
                const unsigned sl = c0 + c1 + c2 + c3;
                unsigned inc = sl;
#pragma unroll
                for (int o = 1; o < 64; o <<= 1) { const unsigned v = __shfl_down(inc, o); if (lane + o < 64) inc += v; }
                unsigned run = inc - sl;
                const unsigned cc[4] = {c3, c2, c1, c0};
#pragma unroll
                for (int q = 0; q < 4; ++q) { if (run < need && run + cc[q] >= need) { bc[0] = (unsigned)(4 * lane + 3 - q); bc[1] = need - run; } run += cc[q]; }
            }
            __syncthreads();
            prefix |= bc[0] << shift; mask |= 255u << shift; need = bc[1];
        }
        unsigned loc = 0u; unsigned gtf[4], eqf[4];
#pragma unroll
        for (int j = 0; j < 4; ++j) { gtf[j] = key[j] > prefix ? 1u : 0u; eqf[j] = key[j] == prefix ? 1u : 0u; loc += gtf[j] + (eqf[j] << 16); }
        unsigned inc = loc;
#pragma unroll
        for (int o = 1; o < 64; o <<= 1) { const unsigned v = __shfl_up(inc, o); if (lane >= o) inc += v; }
        if (lane == 63) wsum[w] = inc;
        __syncthreads();
        unsigned base = 0u;
#pragma unroll
        for (int ww = 0; ww < 8; ++ww) if (ww < w) base += wsum[ww];
        unsigned run = base + inc - loc;
#pragma unroll
        for (int j = 0; j < 4; ++j) {
            const unsigned gb = run & 0xffffu, eb = run >> 16;
            const bool sel = gtf[j] || (eqf[j] && eb < need);
            if (sel) { const unsigned sl = gb + (eb < need ? eb : need); const int tok = b * SEQ + 4 * tid + j; const int p = (e * NB + b) * CAP + (int)sl;
                sel_tok[p] = tok; sel_gate[p] = __uint_as_float(key[j]); slot[(size_t)tok * NE + e] = (int)sl; }
            run += gtf[j] + (eqf[j] << 16);
        }
    }
}
__device__ __forceinline__ void p10_final(const Args& a, Frame& F, float* dst) {
    const bf16* xn = (const bf16*)(a.ws + WS_XN); const float* xr = (const float*)(a.ws + WS_XR);
    const bf16* yo = (const bf16*)(a.ws + WS_YO); const float* gf = a.in[21]; const int* slot = (const int*)(a.ws + WS_SLOT); const unsigned char* Y = a.ws + WS_Y;
    const int lane = F.lane;
    const int rstep = F.G * NWAVES;
    f32x4 ig[4];
#pragma unroll
    for (int j = 0; j < 4; ++j) { const f32x4 g4 = ((const GAS f32x4*)a.in[1])[lane + 64 * j]; ig[j] = (f32x4){1.f / g4.x, 1.f / g4.y, 1.f / g4.z, 1.f / g4.w}; }
    unsigned long long nx[4], ny[4]; float nsr = 0.f; int nslot = -1;
    { const int row0 = F.bx * NWAVES + F.wave;
      if (row0 < NT) {
#pragma unroll
        for (int j = 0; j < 4; ++j) { nx[j] = ((const GAS unsigned long long*)(xn + (size_t)row0 * DMODEL) + lane)[64 * j]; ny[j] = ((const GAS unsigned long long*)(yo + (size_t)row0 * DMODEL) + lane)[64 * j]; }
        nsr = xr[row0]; nslot = slot[(size_t)row0 * NE + (lane & 15)]; } }
    for (int row = F.bx * NWAVES + F.wave; row < NT; row += rstep) {
        const int b = row / SEQ;
        f32x4 v[4];
#pragma unroll
        for (int j = 0; j < 4; ++j) { const unsigned lo = (unsigned)ny[j], hi = (unsigned)(ny[j] >> 32); const unsigned xl = (unsigned)nx[j], xh = (unsigned)(nx[j] >> 32);
            v[j] = (f32x4){__uint_as_float(xl << 16), __uint_as_float(xl & 0xffff0000u), __uint_as_float(xh << 16), __uint_as_float(xh & 0xffff0000u)} * (ig[j] * nsr)
                 + (f32x4){__uint_as_float(lo << 16), __uint_as_float(lo & 0xffff0000u), __uint_as_float(hi << 16), __uint_as_float(hi & 0xffff0000u)}; }
        const int myslot = nslot;
        if (row + rstep < NT) {
#pragma unroll
            for (int j = 0; j < 4; ++j) { nx[j] = ((const GAS unsigned long long*)(xn + (size_t)(row + rstep) * DMODEL) + lane)[64 * j]; ny[j] = ((const GAS unsigned long long*)(yo + (size_t)(row + rstep) * DMODEL) + lane)[64 * j]; }
            nsr = xr[row + rstep]; nslot = slot[(size_t)(row + rstep) * NE + (lane & 15)]; }
        unsigned long long msk = __ballot(lane < 16 && myslot >= 0);
        f32x4 mo[4];
#pragma unroll
        for (int j = 0; j < 4; ++j) mo[j] = (f32x4){0.f, 0.f, 0.f, 0.f};
        while (msk) {
            unsigned y[4][4];
#pragma unroll
            for (int q = 0; q < 4; ++q) {
                const bool ok = msk != 0ull; const int e = ok ? (__ffsll((long long)msk) - 1) : 0; const int sl = __shfl(myslot, e);
                if (ok) { msk &= msk - 1ull; const GAS unsigned* yr = (const GAS unsigned*)(Y + ((size_t)(e * NB + b) * CAP + sl) * DMODEL) + lane;
#pragma unroll
                    for (int j = 0; j < 4; ++j) y[q][j] = yr[64 * j]; }
                else {
#pragma unroll
                    for (int j = 0; j < 4; ++j) y[q][j] = 0u; }
            }
#pragma unroll
            for (int q = 0; q < 4; ++q)
#pragma unroll
                for (int j = 0; j < 4; ++j) { const auto lo = __builtin_amdgcn_cvt_pk_f32_fp8((int)y[q][j], false); const auto hi = __builtin_amdgcn_cvt_pk_f32_fp8((int)y[q][j], true);
                    mo[j].x += lo[0]; mo[j].y += lo[1]; mo[j].z += hi[0]; mo[j].w += hi[1]; }
        }
#pragma unroll
        for (int j = 0; j < 4; ++j) v[j] += mo[j] * (1.f / 64.f);
        float s = 0.f;
#pragma unroll
        for (int j = 0; j < 4; ++j) s += (v[j].x * v[j].x + v[j].y * v[j].y) + (v[j].z * v[j].z + v[j].w * v[j].w);
        const float r = rsqrtf(wave_sum(s) * (1.f / DMODEL) + EPS);
#pragma unroll
        for (int j = 0; j < 4; ++j) { const f32x4 w = ((const GAS f32x4*)gf)[lane + 64 * j]; __builtin_nontemporal_store((f32x4){v[j].x * r * w.x, v[j].y * r * w.y, v[j].z * r * w.z, v[j].w * r * w.w}, ((GAS f32x4*)(dst + (size_t)row * DMODEL) + lane) + 64 * j); }
    }
}

#ifndef MK_N_LAUNCHES
#define MK_N_LAUNCHES 1
#endif
constexpr int N_PHASES = 11;
__global__ void __launch_bounds__(NTHR, 2) mk_fwd(Args args) {
    extern __shared__ __attribute__((aligned(16))) unsigned char lds[];
    Frame F;
    F.lds = (LAS unsigned char*)lds;
    F.tid = threadIdx.x; F.lane = F.tid & 63; F.wave = __builtin_amdgcn_readfirstlane(F.tid >> 6);
    F.G = gridDim.x; F.bx = blockIdx.x;
    unsigned char* ws = args.ws;
    gu32* ctl = (gu32*)(ws + WS_CTL);
    for (int u = F.tid; u < (LDS_BYTES - LDSCTL_OFF) / 4; u += NTHR) ((LAS unsigned*)(F.lds + LDSCTL_OFF))[u] = 0u;
    __syncthreads();
    volatile LAS unsigned* MISC = (volatile LAS unsigned*)(F.lds + MISC_OFF);
    XcdBarrier bar; bar.bar = (unsigned*)(ctl + CW_BAR) + args.li * XCD_BAR_WORDS; bar.x = 0; bar.st = nullptr;
    if (MK_N_LAUNCHES != N_PHASES) bar = xcd_barrier_post((unsigned*)(ctl + CW_BAR) + args.li * XCD_BAR_WORDS, MISC + 8);
    const int lo = args.ph_lo, hi = args.ph_hi;
#define IN(k) (lo <= (k) && (k) < hi)
#define SEAM(k) do { if (IN(k) && IN((k) + 1)) xcd_barrier(bar); asm volatile("" : "+v"(F.tid)); F.lane = F.tid & 63; } while (0)
#ifndef DUP_PHASE
#define DUP_PHASE -1
#endif
#define DUPBAR(k) if (DUP_PHASE == (k)) xcd_barrier(bar)
#ifndef SPIN_PHASE
#define SPIN_PHASE -1
#endif
    unsigned long long tstamp0 = 0, tstamp1 = 0;
#define STAMP(k) do { if (SPIN_PHASE >= 0) { if ((k) == SPIN_PHASE) tstamp0 = __builtin_amdgcn_s_memrealtime(); if ((k) == SPIN_PHASE + 1) tstamp1 = __builtin_amdgcn_s_memrealtime(); } } while (0)

    STAMP(0);
    if (IN(0)) { p0_prologue(args, F); if (DUP_PHASE == 0) { xcd_barrier(bar); p0_prologue(args, F); } } SEAM(0);
    STAMP(1);
    if (IN(1)) for (int rep = 0; rep < (DUP_PHASE == 1 ? 2 : 1); ++rep) {   if (rep) xcd_barrier(bar);
        for (int d = (F.bx >> 3) & 7; d > 0; --d) __builtin_amdgcn_s_sleep(10);
        pg8::Gemm g{(const pg8::bf16_t*)(ws + WS_XN), (const pg8::bf16_t*)(ws + WS_WIN), NT, DPROJ, DMODEL, nullptr, 0};
        pg8::StaticOrder S; S.init(NT, DPROJ, F.G, F.bx);
        static_assert(WS_KR - WS_QR == WS_VR - WS_KR, "Q, K, V buffers equally spaced");
        pg8::EpiInProj E{(pg8::bf16_t*)(ws + WS_PROJ), PROJ_LD, (pg8::bf16_t*)(ws + WS_QR), (size_t)(WS_KR - WS_QR) / 2, (const float*)(ws + WS_ROPE)};
        pg8::gemm_phase<pg8::EpiInProj, pg8::StaticOrder, true, true, false>(F.lds + RING_OFF, g, S, E);
        if (F.G == 256 && DUP_PHASE != 1) {
            if (F.bx < 128) { __syncthreads(); if (F.tid == 0) __hip_atomic_fetch_add((gu32*)(ws + WS_CTL) + CW_P1DONE, 1u, RLX_AGENT); }
            else { while (cvt_batch(args, F, CW_P1DONE, 8u)) {} }
        }
    } SEAM(1);
    STAMP(2);
    if (IN(2)) { p2_prep(args, F); if (DUP_PHASE == 2) { xcd_barrier(bar); p2_prep(args, F); } } SEAM(2);
    STAMP(3);
    if (IN(3)) { p3_mlstm(args, F); p3_attn(args, F); if (DUP_PHASE == 3) { xcd_barrier(bar); p3_mlstm(args, F); p3_attn(args, F); } if (DUP_PHASE == 31) { xcd_barrier(bar); p3_mlstm(args, F); } if (DUP_PHASE >= 3100 && DUP_PHASE < 3132) { xcd_barrier(bar); for (int item = F.bx; item < NB * MH * 2; item += F.G) mlstm_item<(DUP_PHASE >= 3100 ? DUP_PHASE - 3100 : 0) | 1>(args, F, item); __syncthreads(); } if (DUP_PHASE == 32) { xcd_barrier(bar); p3_attn(args, F); } if (DUP_PHASE >= 320 && DUP_PHASE < 328) { xcd_barrier(bar); p3_attn_var<DUP_PHASE >= 320 ? (DUP_PHASE - 320) | 4 : 4>(args, F); } } SEAM(3);
    STAMP(4);
    if (IN(4)) { p4_mix(args, F); if (DUP_PHASE == 4) { xcd_barrier(bar); p4_mix(args, F); } } SEAM(4);
    STAMP(5);
    if (IN(5)) for (int rep = 0; rep < (DUP_PHASE == 5 ? 2 : 1); ++rep) {   if (rep) xcd_barrier(bar);
        pg8::Gemm g{(const pg8::bf16_t*)(ws + WS_MIXED), (const pg8::bf16_t*)(ws + WS_WOUT), NT, DMODEL, DMODEL, nullptr, 0};
        pg8::StaticOrder S; S.init(NT, DMODEL, F.G, F.bx);
        pg8::EpiStoreBf16 E{(pg8::bf16_t*)(ws + WS_YO), DMODEL};
        pg8::gemm_phase<pg8::EpiStoreBf16, pg8::StaticOrder, true, true, false>(F.lds + RING_OFF, g, S, E);
    } SEAM(5);
    STAMP(6);
    if (IN(6)) { p6_router(args, F); if (DUP_PHASE == 6) { xcd_barrier(bar); p6_router(args, F); } } SEAM(6);
    STAMP(7);
    if (IN(7)) { p7_topk(args, F); if (DUP_PHASE == 7) { xcd_barrier(bar); p7_topk(args, F); } cvt_run(args, F, -1, 0u); if (DUP_PHASE == 40) { xcd_barrier(bar); cvt_run(args, F, -1, 0u, -1, 0u, 320); } } SEAM(7);
    STAMP(8);
    if (IN(8)) for (int rep = 0; rep < (DUP_PHASE == 8 ? 2 : 1); ++rep) {   if (rep) xcd_barrier(bar);
        if (F.G == 256) {
            for (int d = (F.bx >> 3) & 7; d > 0; --d) __builtin_amdgcn_s_sleep(10);
            for (int seg = 0; seg < 2; ++seg) {
                pg8::Gemm g{(const pg8::bf16_t*)(ws + WS_H2), (const pg8::bf16_t*)(ws + WS_W13), NPAIR, NE * 2 * DEXP, DMODEL, (const int*)(ws + WS_SELT), 0x7a7a7a7a};
                pg8::MoeUpOrder S; S.init(F.bx, seg);
                pg8::EpiSwiGLU E{ws + WS_H, DEXP, 2 * DEXP / 256};
                pg8::gemm_phase<pg8::EpiSwiGLU, pg8::MoeUpOrder, true, true, true, true>(F.lds + RING_OFF, g, S, E);
            }
        }
    }
    if (DUP_PHASE == 80 || DUP_PHASE == 81) { xcd_barrier(bar);
        for (int seg = 0; seg < 2; ++seg) {
            pg8::Gemm g{(const pg8::bf16_t*)(ws + WS_H2), (const pg8::bf16_t*)(ws + WS_W13), NPAIR, NE * 2 * DEXP, DMODEL, (const int*)(ws + WS_SELT), 0x7a7a7a7a};
            pg8::MoeUpOrder S; S.init(F.bx, seg);
            pg8::EpiNull E{};
            pg8::gemm_phase<pg8::EpiNull, pg8::MoeUpOrder, DUP_PHASE == 80, true, true, true>(F.lds + RING_OFF, g, S, E);
        }
    } SEAM(8);
    STAMP(9);
    if (IN(9)) for (int rep = 0; rep < (DUP_PHASE == 9 ? 2 : 1); ++rep) {   if (rep) xcd_barrier(bar);
        if (F.G == 256) {
            for (int d = (F.bx >> 3) & 7; d > 0; --d) __builtin_amdgcn_s_sleep(10);
            pg8::Gemm g{(const pg8::bf16_t*)(ws + WS_H), (const pg8::bf16_t*)(ws + WS_W2), NPAIR, NE * DMODEL, DEXP, nullptr, 0x79797979, 128, 0};
            pg8::MoeDownOrder S; S.init(F.bx);
            pg8::EpiDown E{ws + WS_Y, DMODEL, (const float*)(ws + WS_SELG)};
            pg8::gemm_phase<pg8::EpiDown, pg8::MoeDownOrder, true, true, false, true>(F.lds + RING_OFF, g, S, E);
        }
    } SEAM(9);
    STAMP(10);
    if (IN(10)) { if (DUP_PHASE == 10) { p10_final(args, F, (float*)(ws + WS_H)); xcd_barrier(bar); } if (DUP_PHASE == 11) { for (int q = 0; q < 10; ++q) xcd_barrier(bar); } p10_final(args, F, args.out); }
    STAMP(11);
    if (SPIN_PHASE >= 0 && F.bx == 0 && F.tid == 0) { const unsigned long long until = __builtin_amdgcn_s_memrealtime() + 8ull * (tstamp1 - tstamp0); while (__builtin_amdgcn_s_memrealtime() < until) __builtin_amdgcn_s_sleep(8); }
#undef IN
#undef SEAM
}

extern "C" void kernel_launch(void* const* d_in, const int* in_sizes, int n_in, void* d_out, int out_size, void* d_ws, size_t ws_size, hipStream_t stream) {
    static int grid = 0;
    if (grid == 0) {
        if (n_in != 22 || out_size != NT * DMODEL || ws_size < WS_END) { fprintf(stderr, "kernel_launch: unexpected shapes (n_in %d out %d ws %zu need %zu)\n", n_in, out_size, ws_size, (size_t)WS_END); grid = -1; return; }
        int dev = 0, cus = 0, per_cu = 0;
        if (hipGetDevice(&dev) != hipSuccess || hipDeviceGetAttribute(&cus, hipDeviceAttributeMultiprocessorCount, dev) != hipSuccess) { grid = -1; return; }
        if (hipFuncSetAttribute((const void*)mk_fwd, hipFuncAttributeMaxDynamicSharedMemorySize, LDS_BYTES) != hipSuccess) { fprintf(stderr, "kernel_launch: hipFuncSetAttribute failed\n"); grid = -1; return; }
        if (hipOccupancyMaxActiveBlocksPerMultiprocessor(&per_cu, (const void*)mk_fwd, NTHR, LDS_BYTES) != hipSuccess || per_cu < 1) { fprintf(stderr, "kernel_launch: occupancy query says %d blocks per CU\n", per_cu); grid = -1; (void)hipGetLastError(); return; }
        grid = cus;
        if (grid != 256) fprintf(stderr, "kernel_launch: %d CUs: the MoE phases are built for 256\n", grid);
    }
    if (grid < 0) return;
    (void)hipMemsetAsync((char*)d_ws + WS_CTL, 0, CTL_ZERO_BYTES, stream);
    Args a{};
    for (int i = 0; i < 22; ++i) a.in[i] = (const float*)d_in[i];
    a.out = (float*)d_out; a.ws = (unsigned char*)d_ws;
    for (int li = 0; li < MK_N_LAUNCHES; ++li) {
        if (MK_N_LAUNCHES == 1) { a.ph_lo = 0; a.ph_hi = N_PHASES; } else { a.ph_lo = li; a.ph_hi = li + 1; }
        a.li = (MK_N_LAUNCHES == 1) ? 0 : 0;
        hipLaunchKernelGGL(mk_fwd, dim3(grid), dim3(NTHR), LDS_BYTES, stream, a);
    }
}
```
